# Optimizing an MI355X kernel written in HIP

```python
import jax, jax.numpy as jnp
from jax import lax
import numpy as np

D_MODEL = 1024
BATCH = 4
SEQ = 4096
DEPTH = 2
DEC_BATCH = 128
DEC_SEQ = 1
PAST_LEN = 16384
PAGE_SIZE = 128

HEAD_DIM = 64
ATTN_WIDTH = D_MODEL // 2
N_HEADS = ATTN_WIDTH // HEAD_DIM
N_KV_HEADS = N_HEADS // 4
GQA_GROUP = N_HEADS // N_KV_HEADS
KV_WIDTH = N_KV_HEADS * HEAD_DIM
WINDOW = 128
ATTN_BLOCK = WINDOW
LRU_WIDTH = D_MODEL // 4
LRU_BLOCKS = 4
LRU_BLOCK_W = LRU_WIDTH // LRU_BLOCKS
LRU_C = 8.0
CONV_W = 4
POOL_WINDOWS = (2, 4, 8, 16)
POOL_WIDTH = D_MODEL // 4
POOL_GROUPS = len(POOL_WINDOWS)
POOL_GROUP_W = POOL_WIDTH // POOL_GROUPS
POOL_CTX = max(POOL_WINDOWS) - 1
MIX_WIDTH = ATTN_WIDTH + LRU_WIDTH + POOL_WIDTH
IN_WIDTH = ATTN_WIDTH + 2 * KV_WIDTH + 2 * LRU_WIDTH + POOL_WIDTH
SPLIT_POINTS = (ATTN_WIDTH, ATTN_WIDTH + KV_WIDTH, ATTN_WIDTH + 2 * KV_WIDTH,
                ATTN_WIDTH + 2 * KV_WIDTH + LRU_WIDTH, ATTN_WIDTH + 2 * KV_WIDTH + 2 * LRU_WIDTH)
D_FF = 4 * D_MODEL
LN_EPS = 1e-5
NEG_INF = -1e30

kernel_name = 'hybrid_swa_rglru_pool_deepnorm_step'


def layer_norm(x, g, b):
    xf = x.astype(jnp.float32)
    mu = jnp.mean(xf, axis=-1, keepdims=True)
    xc = xf - mu
    var = jnp.mean(jnp.square(xc), axis=-1, keepdims=True)
    return (xc * lax.rsqrt(var + LN_EPS) * g.astype(jnp.float32) + b.astype(jnp.float32)).astype(x.dtype)


def alibi_slopes():
    return jnp.exp2(-8.0 * (jnp.arange(N_HEADS, dtype=jnp.float32) + 1.0) / N_HEADS)


def window_attention(q, k, v, q_pos, k_pos, sinks):
    scores = jnp.einsum('...qkgd,...skd->...kgqs', q, k).astype(jnp.float32) * (HEAD_DIM ** -0.5)
    delta = q_pos[..., :, None] - k_pos[..., None, :]
    mask = (delta >= 0) & (delta <= WINDOW) & (k_pos[..., None, :] >= 0)
    slopes = alibi_slopes().reshape(N_KV_HEADS, GQA_GROUP, 1, 1)
    scores = scores - slopes * delta[..., None, None, :, :].astype(jnp.float32)
    scores = jnp.where(mask[..., None, None, :, :], scores, NEG_INF)
    sink = jnp.broadcast_to(sinks.astype(jnp.float32).reshape(N_KV_HEADS, GQA_GROUP, 1, 1),
                            scores.shape[:-1] + (1,))
    probs = jax.nn.softmax(jnp.concatenate([scores, sink], axis=-1), axis=-1)[..., :-1]
    return jnp.einsum('...kgqs,...skd->...qkgd', probs.astype(v.dtype), v)


def attention_prompt(q, k, v, sinks):
    B, L = q.shape[:2]
    nblk = L // ATTN_BLOCK
    qb = q.reshape(B, nblk, ATTN_BLOCK, N_KV_HEADS, GQA_GROUP, HEAD_DIM)

    def band(t):
        tp = jnp.concatenate([jnp.zeros((B, WINDOW) + t.shape[2:], t.dtype), t], axis=1)
        tp = tp.reshape(B, nblk + 1, ATTN_BLOCK, N_KV_HEADS, HEAD_DIM)
        return jnp.concatenate([tp[:, :-1], tp[:, 1:]], axis=2)

    q_pos = jnp.arange(L).reshape(nblk, ATTN_BLOCK)
    k_pos = (jnp.arange(nblk) * ATTN_BLOCK - WINDOW)[:, None] + jnp.arange(2 * ATTN_BLOCK)[None, :]
    out = window_attention(qb, band(k), band(v), q_pos, k_pos, sinks)
    return out.reshape(B, L, ATTN_WIDTH), k[:, -WINDOW:], v[:, -WINDOW:]


def attention_sample(q, k, v, k_buf, v_buf, sinks, pos0):
    B, L = q.shape[:2]
    qg = q.reshape(B, L, N_KV_HEADS, GQA_GROUP, HEAD_DIM)
    k_all = jnp.concatenate([k_buf.astype(k.dtype), k], axis=1)
    v_all = jnp.concatenate([v_buf.astype(v.dtype), v], axis=1)
    q_pos = pos0 + jnp.arange(L)
    k_pos = pos0 - WINDOW + jnp.arange(WINDOW + L)
    out = window_attention(qg, k_all, v_all, q_pos, k_pos, sinks)
    return out.reshape(B, L, ATTN_WIDTH), k_all[:, -WINDOW:], v_all[:, -WINDOW:]


def recurrent_branch(xr, gr, conv_ctx, h0, lp):
    B, L, _ = xr.shape
    x_ext = jnp.concatenate([conv_ctx.astype(xr.dtype), xr], axis=1)
    xc = lp['conv_b']
    for tap in range(CONV_W):
        xc = xc + x_ext[:, tap:tap + L] * lp['conv_w'][tap]
    xb = xc.reshape(B, L, LRU_BLOCKS, LRU_BLOCK_W)
    r = jax.nn.sigmoid(jnp.einsum('blnc,ncd->blnd', xb, lp['gate_a_w']).reshape(B, L, LRU_WIDTH) + lp['gate_a_b'])
    i = jax.nn.sigmoid(jnp.einsum('blnc,ncd->blnd', xb, lp['gate_x_w']).reshape(B, L, LRU_WIDTH) + lp['gate_x_b'])
    log_a = (-LRU_C * r.astype(jnp.float32)) * jax.nn.softplus(-lp['lru_lambda'].astype(jnp.float32))
    a = jnp.exp(log_a)
    b = jnp.sqrt(-jnp.expm1(2.0 * log_a)) * (i * xc).astype(jnp.float32)

    def step(h, ab):
        h = ab[0] * h + ab[1]
        return h, h

    h_last, hs = lax.scan(step, h0.astype(jnp.float32), (jnp.swapaxes(a, 0, 1), jnp.swapaxes(b, 0, 1)))
    out = jnp.swapaxes(hs, 0, 1).astype(xr.dtype) * jax.nn.gelu(gr)
    return out, h_last.astype(h0.dtype), x_ext[:, -(CONV_W - 1):]


def pool_branch(zp, pool_ctx, pos0, lp):
    B, L, _ = zp.shape
    z_ext = jnp.concatenate([pool_ctx.astype(zp.dtype), zp], axis=1)
    cs = jnp.cumsum(z_ext.astype(jnp.float32), axis=1)
    cs = jnp.concatenate([jnp.zeros((B, 1, POOL_WIDTH), jnp.float32), cs], axis=1)
    pos = (pos0 + jnp.arange(L)).astype(jnp.float32)
    means = []
    for g, w in enumerate(POOL_WINDOWS):
        ch = slice(g * POOL_GROUP_W, (g + 1) * POOL_GROUP_W)
        win_sum = cs[:, POOL_CTX + 1:POOL_CTX + 1 + L, ch] - cs[:, POOL_CTX + 1 - w:POOL_CTX + 1 - w + L, ch]
        count = jnp.minimum(pos + 1.0, float(w))
        means.append(win_sum / count[None, :, None])
    diff = (jnp.concatenate(means, axis=-1) - zp.astype(jnp.float32)).astype(zp.dtype)
    diff = diff.reshape(B, L, POOL_GROUPS, POOL_GROUP_W)
    out = jnp.einsum('blgc,gcd->blgd', diff, lp['pool_w']).reshape(B, L, POOL_WIDTH) * lp['pool_scale']
    return out, z_ext[:, -POOL_CTX:]


def trunk_layer(x, pos0, state, lp, alpha):
    B, L, _ = x.shape
    u = x @ lp['w_in']
    q, k, v, xr, gr, zp = jnp.split(u, SPLIT_POINTS, axis=-1)
    k = k.reshape(B, L, N_KV_HEADS, HEAD_DIM)
    v = v.reshape(B, L, N_KV_HEADS, HEAD_DIM)
    if state is None:
        attn, k_new, v_new = attention_prompt(q, k, v, lp['attn_sinks'])
        h0 = jnp.zeros((B, LRU_WIDTH), x.dtype)
        conv_ctx = jnp.zeros((B, CONV_W - 1, LRU_WIDTH), x.dtype)
        pool_ctx = jnp.zeros((B, POOL_CTX, POOL_WIDTH), x.dtype)
    else:
        k_buf, v_buf, h0, conv_ctx, pool_ctx = state
        attn, k_new, v_new = attention_sample(q, k, v, k_buf, v_buf, lp['attn_sinks'], pos0)
    rec, h_last, conv_new = recurrent_branch(xr, gr, conv_ctx, h0, lp)
    pool, pool_new = pool_branch(zp, pool_ctx, pos0, lp)
    mix = jnp.concatenate([attn, rec, pool], axis=-1) @ lp['w_out']
    x = layer_norm(alpha * x + mix, lp['ln1_g'], lp['ln1_b'])
    hid = jnp.square(jax.nn.relu(x @ lp['w_ff1']))
    x = layer_norm(alpha * x + hid @ lp['w_ff2'], lp['ln2_g'], lp['ln2_b'])
    return x, (k_new, v_new, h_last, conv_new, pool_new)


def setup_inputs(seed: int = 0) -> dict:
    key = jax.random.key(seed)
    ks = iter(jax.random.split(key, 40))
    f32 = jnp.float32

    def nrm(shape, scale):
        return scale * jax.random.normal(next(ks), shape, f32)

    beta = (8.0 * DEPTH) ** -0.25
    a0 = jax.random.uniform(next(ks), (DEPTH, LRU_WIDTH), f32, minval=0.9, maxval=0.999)
    return {
        'x_prompt': nrm((BATCH, SEQ, D_MODEL), 1.0),
        'x_sample': nrm((DEC_BATCH, DEC_SEQ, D_MODEL), 1.0),
        'cache_k': nrm((DEPTH, DEC_BATCH, WINDOW, N_KV_HEADS, HEAD_DIM), 1.0),
        'cache_v': nrm((DEPTH, DEC_BATCH, WINDOW, N_KV_HEADS, HEAD_DIM), 1.0),
        'state_h': nrm((DEPTH, DEC_BATCH, LRU_WIDTH), 0.5),
        'state_conv': nrm((DEPTH, DEC_BATCH, CONV_W - 1, LRU_WIDTH), 1.0),
        'state_pool': nrm((DEPTH, DEC_BATCH, POOL_CTX, POOL_WIDTH), 1.0),
        'w_in': nrm((DEPTH, D_MODEL, IN_WIDTH), D_MODEL ** -0.5),
        'attn_sinks': nrm((DEPTH, N_HEADS), 1.0),
        'conv_w': nrm((DEPTH, CONV_W, LRU_WIDTH), CONV_W ** -0.5),
        'conv_b': nrm((DEPTH, LRU_WIDTH), 0.02),
        'gate_a_w': nrm((DEPTH, LRU_BLOCKS, LRU_BLOCK_W, LRU_BLOCK_W), LRU_BLOCK_W ** -0.5),
        'gate_a_b': nrm((DEPTH, LRU_WIDTH), 0.02),
        'gate_x_w': nrm((DEPTH, LRU_BLOCKS, LRU_BLOCK_W, LRU_BLOCK_W), LRU_BLOCK_W ** -0.5),
        'gate_x_b': nrm((DEPTH, LRU_WIDTH), 0.02),
        'lru_lambda': jnp.log(a0) - jnp.log1p(-a0),
        'pool_w': nrm((DEPTH, POOL_GROUPS, POOL_GROUP_W, POOL_GROUP_W), POOL_GROUP_W ** -0.5),
        'pool_scale': 1.0 + nrm((DEPTH, POOL_WIDTH), 0.1),
        'w_out': nrm((DEPTH, MIX_WIDTH, D_MODEL), beta * MIX_WIDTH ** -0.5),
        'ln1_g': 1.0 + nrm((DEPTH, D_MODEL), 0.05),
        'ln1_b': nrm((DEPTH, D_MODEL), 0.02),
        'w_ff1': nrm((DEPTH, D_MODEL, D_FF), D_MODEL ** -0.5),
        'w_ff2': nrm((DEPTH, D_FF, D_MODEL), beta * D_FF ** -0.5),
        'ln2_g': 1.0 + nrm((DEPTH, D_MODEL), 0.05),
        'ln2_b': nrm((DEPTH, D_MODEL), 0.02),
    }


def reference(x_prompt, x_sample, cache_k, cache_v, state_h, state_conv, state_pool,
              w_in, attn_sinks, conv_w, conv_b, gate_a_w, gate_a_b, gate_x_w, gate_x_b, lru_lambda,
              pool_w, pool_scale, w_out, ln1_g, ln1_b, w_ff1, w_ff2, ln2_g, ln2_b):
    alpha = (2.0 * DEPTH) ** 0.25
    yp, ys = x_prompt, x_sample
    p_k, p_v, p_h, p_conv, p_pool = [], [], [], [], []
    s_k, s_v, s_h, s_conv, s_pool = [], [], [], [], []
    for l in range(DEPTH):
        lp = {
            'w_in': w_in[l], 'attn_sinks': attn_sinks[l], 'conv_w': conv_w[l], 'conv_b': conv_b[l],
            'gate_a_w': gate_a_w[l], 'gate_a_b': gate_a_b[l], 'gate_x_w': gate_x_w[l], 'gate_x_b': gate_x_b[l],
            'lru_lambda': lru_lambda[l], 'pool_w': pool_w[l], 'pool_scale': pool_scale[l], 'w_out': w_out[l],
            'ln1_g': ln1_g[l], 'ln1_b': ln1_b[l], 'w_ff1': w_ff1[l], 'w_ff2': w_ff2[l],
            'ln2_g': ln2_g[l], 'ln2_b': ln2_b[l],
        }
        yp, (k1, v1, h1, c1, q1) = trunk_layer(yp, 0, None, lp, alpha)
        ys, (k2, v2, h2, c2, q2) = trunk_layer(
            ys, PAST_LEN, (cache_k[l], cache_v[l], state_h[l], state_conv[l], state_pool[l]), lp, alpha)
        p_k.append(k1); p_v.append(v1); p_h.append(h1); p_conv.append(c1); p_pool.append(q1)
        s_k.append(k2); s_v.append(v2); s_h.append(h2); s_conv.append(c2); s_pool.append(q2)
    return (yp, ys,
            jnp.stack(p_k), jnp.stack(p_v), jnp.stack(p_h), jnp.stack(p_conv), jnp.stack(p_pool),
            jnp.stack(s_k), jnp.stack(s_v), jnp.stack(s_h), jnp.stack(s_conv), jnp.stack(s_pool))
```

```cpp
#include <hip/hip_runtime.h>
#include <hip/hip_cooperative_groups.h>
#include <cstdio>
namespace cg = cooperative_groups;

#define LAS __attribute__((address_space(3)))
typedef unsigned short bf16_t;
typedef short bf16x8 __attribute__((ext_vector_type(8)));
typedef float f32x4 __attribute__((ext_vector_type(4)));
typedef float f32x2 __attribute__((ext_vector_type(2)));
typedef unsigned u32x4 __attribute__((ext_vector_type(4)));
typedef unsigned u32x2 __attribute__((ext_vector_type(2)));
#define DI __device__ __forceinline__
#ifndef PHOFF
#define PHOFF 0
#endif
#ifndef REP_SYNC
#define REP_SYNC 1
#endif
#ifndef REP_MIX
#define REP_MIX 1
#endif
#ifndef REP_G3
#define REP_G3 1
#endif
#ifndef REP_PREP
#define REP_PREP 1
#endif
#ifndef REP_FIX
#define REP_FIX 1
#endif
#ifndef REP_ATT
#define REP_ATT 1
#endif
#ifndef REP_RG
#define REP_RG 1
#endif
#ifndef REP_POOL
#define REP_POOL 1
#endif
#ifndef REP_SATT
#define REP_SATT 1
#endif
#ifndef REP_G2
#define REP_G2 1
#endif
#ifndef REP_G4
#define REP_G4 1
#endif
#ifndef REP_G1
#define REP_G1 1
#endif
#define GSYNC() do { for (int _r = 0; _r < REP_SYNC; ++_r) { unsigned* _bar = (unsigned*)(kparams().ws + WS_BAR); xcd_barrier(_bar, xst); } } while (0)

constexpr int DM = 1024, TP = 16384, TS = 128, MT = TP + TS, NIN = 1536, DFF = 4096;
constexpr int NTHR = 512;
constexpr float LOG2E = 1.4426950408889634f;
constexpr float ALPHA = 1.4142135623730951f;
constexpr float QSCALE = 0.125f * 1.4426950408889634f;
constexpr float LN_EPS = 1e-5f;
constexpr size_t O_YP = 0, O_YS = 16777216, O_PK = 16908288, O_PV = 17039360, O_PH = 17170432, O_PC = 17172480, O_PP = 17178624,
                 O_SK = 17209344, O_SV = 21403648, O_SH = 25597952, O_SC = 25663488, O_SP = 25860096;
constexpr size_t WS_WIN = 0;
constexpr size_t WS_WOUT = WS_WIN + 2ull * 1536 * 1024 * 2;
constexpr size_t WS_W1 = WS_WOUT + 2ull * 1024 * 1024 * 2;
constexpr size_t WS_W2 = WS_W1 + 2ull * 4096 * 1024 * 2;
constexpr size_t WS_YB = WS_W2 + 2ull * 4096 * 1024 * 2;
constexpr size_t WS_MIX = WS_YB + (size_t)MT * 1024 * 2;
constexpr size_t WS_HID = WS_MIX + (size_t)MT * 1024 * 2;
constexpr size_t WS_QKV = WS_HID;
constexpr size_t WS_U2 = WS_QKV + (size_t)MT * 768 * 2;
constexpr size_t WS_HL = WS_U2 + (size_t)MT * 768 * 4;
constexpr size_t WS_CA = WS_HL + (size_t)TP * 256 * 4;
constexpr size_t WS_ST1 = WS_HID + (size_t)MT * 4096 * 2;
constexpr size_t WS_ST2 = WS_ST1 + (size_t)MT * 32 * 4;
constexpr size_t WS_CSIN = WS_ST2 + (size_t)MT * 32 * 4;
constexpr size_t WS_BWIN = WS_CSIN + 2 * 1536 * 4;
constexpr size_t WS_CS1 = WS_BWIN + 2 * 1536 * 4;
constexpr size_t WS_BW1 = WS_CS1 + 2 * 4096 * 4;
constexpr size_t WS_GAT = WS_BW1 + 2 * 4096 * 4;
constexpr size_t WS_GXT = WS_GAT + 2 * 4 * 64 * 64 * 2;
constexpr size_t WS_PWT = WS_GXT + 2 * 4 * 64 * 64 * 2;
constexpr size_t WS_AGA = WS_PWT + 2 * 4 * 64 * 64 * 2;
constexpr size_t WS_AGB = WS_AGA + 128 * 256 * 4;
constexpr size_t WS_STS1 = WS_AGB + 128 * 256 * 4;
constexpr size_t WS_STS2 = WS_STS1 + 128 * 128 * 4;
constexpr size_t WS_BAR = WS_STS2 + 128 * 128 * 4;
constexpr size_t WS_QCTR = WS_BAR + 3456 * 4;
constexpr size_t WS_END = WS_QCTR + 1024;
static_assert(WS_CA + (size_t)TP * 256 * 4 <= WS_ST1, "alias region overflow");
static_assert(WS_END <= 268435456ull, "workspace budget");
constexpr int LDS_BYTES = 163840;

struct Params {
    const float* xp; const float* xs; const float* ck; const float* cv; const float* sh; const float* sc; const float* spool;
    const float* w_in; const float* sinks; const float* conv_w; const float* conv_b; const float* ga_w; const float* ga_b; const float* gx_w; const float* gx_b; const float* lam;
    const float* pool_w; const float* pool_scale; const float* w_out; const float* ln1_g; const float* ln1_b; const float* w_ff1; const float* w_ff2; const float* ln2_g; const float* ln2_b;
    float* out; unsigned char* ws;
};

DI unsigned pk2(float lo, float hi) { unsigned r; asm volatile("v_cvt_pk_bf16_f32 %0, %1, %2" : "=v"(r) : "v"(lo), "v"(hi)); return r; }
DI float bf2f(bf16_t b) { return __uint_as_float(((unsigned)b) << 16); }
DI float bfround(float x) { return __uint_as_float(pk2(x, 0.f) << 16); }
DI f32x4 mfma16(bf16x8 a, bf16x8 b, f32x4 c) { return __builtin_amdgcn_mfma_f32_16x16x32_bf16(a, b, c, 0, 0, 0); }
DI int launder_v(int x) { asm volatile("" : "+v"(x)); return x; }
DI int launder_i(int x) { asm volatile("" : "+s"(x)); return x; }
#define RELAUNDER() do { tid = launder_v(tid); lane = tid & 63; wid = __builtin_amdgcn_readfirstlane(tid >> 6); } while (0)
DI void lds_wait() { asm volatile("s_waitcnt lgkmcnt(0)" ::: "memory"); }
DI float sigmoidf_(float x) { return 1.0f / (1.0f + __expf(-x)); }
DI float gelu_tanh(float x) { const float u = 0.7978845608028654f * (x + 0.044715f * x * x * x); return 0.5f * x * (1.0f + tanhf(u)); }
DI bf16x8 pack8(f32x4 lo, f32x4 hi) { u32x4 w; w.x = pk2(lo.x, lo.y); w.y = pk2(lo.z, lo.w); w.z = pk2(hi.x, hi.y); w.w = pk2(hi.z, hi.w); return __builtin_bit_cast(bf16x8, w); }
DI f32x4 ld_bf4_nt(const bf16_t* p) { const u32x2 w = __builtin_nontemporal_load((const u32x2*)p); return (f32x4){__uint_as_float(w.x << 16), __uint_as_float(w.x & 0xffff0000u), __uint_as_float(w.y << 16), __uint_as_float(w.y & 0xffff0000u)}; }
DI f32x4 ld_bf4(const bf16_t* p) { const u32x2 w = *(const u32x2*)p; return (f32x4){__uint_as_float(w.x << 16), __uint_as_float(w.x & 0xffff0000u), __uint_as_float(w.y << 16), __uint_as_float(w.y & 0xffff0000u)}; }
DI void st_bf4(bf16_t* dst, f32x4 v) { u32x2 w; w.x = pk2(v.x, v.y); w.y = pk2(v.z, v.w); *(u32x2*)dst = w; }

namespace pg8 {
constexpr int BM = 256, BK = 64, HALF = 128, HTB = HALF * BK * 2, STAGE_BYTES = 8 * HTB, NXCD = 8, WGM = 8;
DI int lds_byte(int r, int c) { const int st = (r >> 4) * 2 + (c >> 5), rr = r & 15, cc = c & 31, ob = rr * 64 + cc * 2; return st * 1024 + (ob ^ (((ob >> 9) & 1) << 5)); }
DI void stage_rc(int b, int& R, int& C) { const int st = b / 1024, sb = b % 1024, swz = sb ^ (((sb >> 9) & 1) << 5); R = (st >> 1) * 16 + swz / 64; C = (st & 1) * 32 + (swz % 64) / 2; }
DI int perm32(int rho) { const int n = rho >> 4, i = rho & 15; return 8 * (i >> 2) + 4 * n + (i & 3); }
struct Unit { int pm, pn; };
struct Gemm { const bf16_t* A; const bf16_t* Bt; int M, N, K; };
struct StaticOrder {
    int nM, nN, nwg, G, c;
    DI void init(int M, int N, int G_, int c_) { nM = M / BM; nN = N / BM; nwg = nM * nN; G = G_; c = c_; }
    DI bool next(int i, Unit& u) const {
        const long L = (long)i * G + c; if (L >= nwg) return false;
        int wgid = (int)L; { const int q = nwg / NXCD, r = nwg % NXCD, xcd = wgid % NXCD, off = wgid / NXCD; wgid = (xcd < r ? xcd * (q + 1) : r * (q + 1) + (xcd - r) * q) + off; }
        const int nig = WGM * nN, gid = wgid / nig, fm = gid * WGM, gsz = (nM - fm) < WGM ? (nM - fm) : WGM;
        u.pm = fm + ((wgid % nig) % gsz); u.pn = (wgid % nig) / gsz; return true;
    }
};

template <class Epi>
DI void gemm_phase(LAS unsigned char* lds, const Gemm g, const StaticOrder& S, const Epi& E, int tid) {
    const int wid = __builtin_amdgcn_readfirstlane(tid >> 6), lane = tid & 63, wr = wid >> 2, wc = wid & 3, fr = lane & 15, fq = lane >> 4;
    const int K = g.K, nt = K / BK;
    unsigned voffA[2], voffB[2];
#pragma unroll
    for (int i = 0; i < 2; ++i) { int R, C; stage_rc(tid * 16 + i * 8192, R, C); const int Rb = (R & ~31) + perm32(R & 31); voffA[i] = (unsigned)(R * K + C) * 2u; voffB[i] = (unsigned)(Rb * K + C) * 2u; }
    const size_t kstep = (size_t)(BK * 2);
    const size_t hstep = (size_t)HALF * K * 2;
    const size_t tstep = 2 * hstep;
    const unsigned ldsw = (unsigned)wid * 1024u;
    const int aoff = lds_byte(wr * 64 + fr, fq * 8), boff = lds_byte(wc * 32 + fr, fq * 8);
#define PG8_SA(b, h) (((b) * 2 + (h)) * HTB)
#define PG8_SB(b, h) ((4 + (b) * 2 + (h)) * HTB)
#define PG8_STAGE(bufoff, gbase, voff) do { _Pragma("unroll") for (int _i = 0; _i < 2; ++_i) \
        __builtin_amdgcn_global_load_lds((const unsigned*)((const char*)(gbase) + (voff)[_i]), (LAS unsigned*)(lds + (bufoff) + ldsw + _i * 8192), 16, 0, 0); } while (0)
#define PG8_LDA(dst, b, h) do { _Pragma("unroll") for (int m = 0; m < 4; ++m) _Pragma("unroll") for (int k = 0; k < 2; ++k) dst[m][k] = *(const LAS bf16x8*)(lds + PG8_SA(b, h) + aoff + m * 2048 + k * 1024); } while (0)
#define PG8_LDB(dst, b, h) do { _Pragma("unroll") for (int n = 0; n < 2; ++n) _Pragma("unroll") for (int k = 0; k < 2; ++k) dst[n][k] = *(const LAS bf16x8*)(lds + PG8_SB(b, h) + boff + n * 2048 + k * 1024); } while (0)
#define PG8_MMA(ai, bj, At, Bt) do { __builtin_amdgcn_s_setprio(1); _Pragma("unroll") for (int m = 0; m < 4; ++m) _Pragma("unroll") for (int n = 0; n < 2; ++n) _Pragma("unroll") for (int k = 0; k < 2; ++k) \
        acc[ai][bj][m][n] = __builtin_amdgcn_mfma_f32_16x16x32_bf16(Bt[n][k], At[m][k], acc[ai][bj][m][n], 0, 0, 0); __builtin_amdgcn_s_setprio(0); } while (0)
#define PG8_WAIT_V(n) asm volatile("s_waitcnt vmcnt(" #n ")" ::: "memory")
#define PG8_WAIT_L(n) asm volatile("s_waitcnt lgkmcnt(" #n ")" ::: "memory")
#define PG8_BAR __builtin_amdgcn_s_barrier()
#define PG8_SCHED __builtin_amdgcn_sched_barrier(0)
    Unit cur, nxt; int ui = 0;
    if (!S.next(0, cur)) return;
    f32x4 acc[2][2][4][2];
#pragma unroll
    for (int a = 0; a < 2; ++a)
#pragma unroll
        for (int b = 0; b < 2; ++b)
#pragma unroll
            for (int m = 0; m < 4; ++m)
#pragma unroll
                for (int n = 0; n < 2; ++n) acc[a][b][m][n] = (f32x4){0.f, 0.f, 0.f, 0.f};
    bf16x8 At[4][2], B0[2][2], B1[2][2];
    const char* cA = (const char*)g.A + (size_t)cur.pm * tstep; const char* cB = (const char*)g.Bt + (size_t)cur.pn * tstep;
    PG8_STAGE(PG8_SB(0, 0), cB, voffB); PG8_STAGE(PG8_SA(0, 0), cA, voffA); PG8_STAGE(PG8_SB(0, 1), cB + hstep, voffB); PG8_STAGE(PG8_SA(0, 1), cA + hstep, voffA);
    if (wr == 1) PG8_BAR;
    PG8_WAIT_V(4); PG8_BAR;
    PG8_STAGE(PG8_SB(1, 0), cB + kstep, voffB); PG8_STAGE(PG8_SA(1, 0), cA + kstep, voffA); PG8_STAGE(PG8_SB(1, 1), cB + hstep + kstep, voffB);
    PG8_WAIT_V(6); PG8_BAR;
    for (;;) {
        const bool has_next = S.next(ui + 1, nxt);
        const char* nA = has_next ? (const char*)g.A + (size_t)nxt.pm * tstep : cA; const char* nB = has_next ? (const char*)g.Bt + (size_t)nxt.pn * tstep : cB;
        for (int t = 0; t < nt; t += 2) {
            const bool last = (t == nt - 2);
            const char* a1 = cA + (size_t)(t + 1) * kstep;
            const char* a2 = last ? nA : cA + (size_t)(t + 2) * kstep; const char* b2 = last ? nB : cB + (size_t)(t + 2) * kstep;
            const char* a3 = a2 + kstep; const char* b3 = b2 + kstep;
            PG8_LDB(B0, 0, 0); PG8_SCHED; PG8_LDA(At, 0, 0); PG8_STAGE(PG8_SA(1, 1), a1 + hstep, voffA);
            PG8_WAIT_L(8); PG8_BAR; PG8_WAIT_L(0); PG8_MMA(0, 0, At, B0); PG8_BAR; PG8_SCHED;
            PG8_LDB(B1, 0, 1); PG8_STAGE(PG8_SB(0, 0), b2, voffB);
            PG8_BAR; PG8_WAIT_L(0); PG8_MMA(0, 1, At, B1); PG8_BAR;
            PG8_LDA(At, 0, 1); PG8_STAGE(PG8_SA(0, 0), a2, voffA);
            PG8_BAR; PG8_WAIT_L(0); PG8_MMA(1, 0, At, B0); PG8_BAR; PG8_SCHED;
            PG8_STAGE(PG8_SB(0, 1), b2 + hstep, voffB);
            PG8_WAIT_V(6); PG8_BAR; PG8_MMA(1, 1, At, B1); PG8_BAR;
            PG8_LDB(B0, 1, 0); PG8_SCHED; PG8_LDA(At, 1, 0); PG8_STAGE(PG8_SA(0, 1), a2 + hstep, voffA);
            PG8_WAIT_L(8); PG8_BAR; PG8_WAIT_L(0); PG8_MMA(0, 0, At, B0); PG8_BAR; PG8_SCHED;
            PG8_LDB(B1, 1, 1); PG8_STAGE(PG8_SB(1, 0), b3, voffB);
            PG8_BAR; PG8_WAIT_L(0); PG8_MMA(0, 1, At, B1); PG8_BAR;
            PG8_LDA(At, 1, 1); PG8_STAGE(PG8_SA(1, 0), a3, voffA);
            PG8_BAR; PG8_WAIT_L(0); PG8_MMA(1, 0, At, B0); PG8_BAR; PG8_SCHED;
            PG8_STAGE(PG8_SB(1, 1), b3 + hstep, voffB);
            PG8_WAIT_V(6); PG8_BAR; PG8_MMA(1, 1, At, B1); PG8_BAR;
        }
        E(acc, cur, ui, wr, wc, fr, fq);
        if (!has_next) break;
#pragma unroll
        for (int a = 0; a < 2; ++a)
#pragma unroll
            for (int b = 0; b < 2; ++b)
#pragma unroll
                for (int m = 0; m < 4; ++m)
#pragma unroll
                    for (int n = 0; n < 2; ++n) acc[a][b][m][n] = (f32x4){0.f, 0.f, 0.f, 0.f};
        cur = nxt; cA = nA; cB = nB; ++ui;
    }
    PG8_WAIT_V(0);
    if (wr == 0) PG8_BAR;
    PG8_BAR;
#undef PG8_SA
#undef PG8_SB
#undef PG8_STAGE
#undef PG8_LDA
#undef PG8_LDB
#undef PG8_MMA
#undef PG8_WAIT_V
#undef PG8_WAIT_L
#undef PG8_BAR
#undef PG8_SCHED
}
}

typedef const __attribute__((address_space(4))) Params* KParamsPtr;
DI Params kparams() {
#if defined(__HIP_DEVICE_COMPILE__)
    const __attribute__((address_space(4))) char* q = (const __attribute__((address_space(4))) char*)__builtin_amdgcn_kernarg_segment_ptr();
    asm volatile("" : "+s"(q));
    KParamsPtr kp = (KParamsPtr)q;
    Params r;
    r.xp = kp->xp; r.xs = kp->xs; r.ck = kp->ck; r.cv = kp->cv; r.sh = kp->sh; r.sc = kp->sc; r.spool = kp->spool;
    r.w_in = kp->w_in; r.sinks = kp->sinks; r.conv_w = kp->conv_w; r.conv_b = kp->conv_b; r.ga_w = kp->ga_w; r.ga_b = kp->ga_b; r.gx_w = kp->gx_w; r.gx_b = kp->gx_b; r.lam = kp->lam;
    r.pool_w = kp->pool_w; r.pool_scale = kp->pool_scale; r.w_out = kp->w_out; r.ln1_g = kp->ln1_g; r.ln1_b = kp->ln1_b; r.w_ff1 = kp->w_ff1; r.w_ff2 = kp->w_ff2; r.ln2_g = kp->ln2_g; r.ln2_b = kp->ln2_b;
    r.out = kp->out; r.ws = kp->ws;
    return r;
#else
    return Params{};
#endif
}

struct RowCtx { float mu, rstd; };
DI void row_stats(const float* part, int row, int fq, float& mu, float& rstd) {
    const f32x4* p = (const f32x4*)(part + (size_t)row * 32 + fq * 8);
    const f32x4 a = p[0], b = p[1];
    float s = (a.x + a.z) + (b.x + b.z), ss = (a.y + a.w) + (b.y + b.w);
    s += __shfl_xor(s, 16); s += __shfl_xor(s, 32); ss += __shfl_xor(ss, 16); ss += __shfl_xor(ss, 32);
    mu = s * (1.0f / 1024.0f); const float var = ss * (1.0f / 1024.0f) - mu * mu; rstd = rsqrtf(fmaxf(var, 0.f) + LN_EPS);
}

DI void row_stats_s(const float* part_s, int srow, int fq, float& mu, float& rstd) {
    const f32x4* p = (const f32x4*)(part_s + (size_t)srow * 128 + fq * 32);
    float s = 0.f, ss = 0.f;
#pragma unroll
    for (int i = 0; i < 8; ++i) { const f32x4 a = p[i]; s += a.x + a.z; ss += a.y + a.w; }
    s += __shfl_xor(s, 16); s += __shfl_xor(s, 32); ss += __shfl_xor(ss, 16); ss += __shfl_xor(ss, 32);
    mu = s * (1.0f / 1024.0f); const float var = ss * (1.0f / 1024.0f) - mu * mu; rstd = rsqrtf(fmaxf(var, 0.f) + LN_EPS);
}
DI void row_stats_any(const float* part, const float* part_s, int row, int fq, float& mu, float& rstd) {
    if (row < TP) row_stats(part, row, fq, mu, rstd); else row_stats_s(part_s, row - TP, fq, mu, rstd);
}

struct ColCtx { f32x4 a, b; };
DI void st_bf8(bf16_t* dst, f32x4 v0, f32x4 v1) { u32x4 w; w.x = pk2(v0.x, v0.y); w.y = pk2(v0.z, v0.w); w.z = pk2(v1.x, v1.y); w.w = pk2(v1.z, v1.w); *(u32x4*)dst = w; }
struct FIn {
    static constexpr bool STATS = false, PRELOAD = false, DEFERRED_PREP = true, STAGGER = false;
    const float* part; const float* part_s; const float* cs; const float* bw; int fold; int layer; bf16_t* QKV; bf16_t* U2; float* out; float* part_out; float* part_out_s;
    DI bool is_dry() const { return false; }
    DI const float* stats_src() const { return fold ? part : nullptr; }
    static DI FIn make(const Params& p, int l, int) { unsigned char* ws = p.ws;
        return FIn{(const float*)(ws + WS_ST2), (const float*)(ws + WS_STS2), (const float*)(ws + WS_CSIN) + l * 1536, (const float*)(ws + WS_BWIN) + l * 1536, l, l, (bf16_t*)(ws + WS_QKV), (bf16_t*)(ws + WS_U2), p.out, nullptr, nullptr}; }
    template <bool SMP> DI RowCtx row_begin(int row, int fq) const { RowCtx r{0.f, 1.f}; if (fold) { if (SMP) row_stats_s(part_s, row - TP, fq, r.mu, r.rstd); else row_stats(part, row, fq, r.mu, r.rstd); } return r; }
    DI ColCtx col_begin(int col) const { ColCtx c; c.a = *(const f32x4*)(cs + col); c.b = *(const f32x4*)(bw + col); return c; }
    DI f32x4 row_load8(int, int) const { return (f32x4){0.f, 0.f, 0.f, 0.f}; }
    DI f32x4 row_load4(int, int) const { return (f32x4){0.f, 0.f, 0.f, 0.f}; }
    DI f32x4 compute(int, int col, f32x4 a, const RowCtx& rc, const ColCtx& cc, float, float) const {
        f32x4 v = a;
        if (fold) v = (a - rc.mu * cc.a) * rc.rstd + cc.b;
        return v;
    }
    DI float* kv_dst(int row, int col) const {
        float* dst = nullptr; const int c7 = (col - 512) & 127; const bool isk = col < 640;
        if (row < TP) { const int t = row & 4095; if (t >= 3968) dst = out + (isk ? O_PK : O_PV) + ((size_t)((layer * 4 + (row >> 12)) * 128 + (t - 3968))) * 128 + c7; }
        else { dst = out + (isk ? O_SK : O_SV) + ((size_t)((layer * 128 + (row - TP)) * 128 + 127)) * 128 + c7; }
        return dst;
    }
    DI void store8(int row, int col, f32x4 v0, f32x4 v1) const {
        if (col < 512) st_bf8(QKV + (size_t)row * 768 + col, v0 * QSCALE, v1 * QSCALE);
        else if (col < 768) { st_bf8(QKV + (size_t)row * 768 + col, v0, v1); float* dst = kv_dst(row, col); if (dst) { *(f32x4*)dst = v0; *(f32x4*)(dst + 4) = v1; } }
        else st_bf8(U2 + (size_t)row * 768 + (col - 768), v0, v1);
    }
    DI void store4(int row, int col, f32x4 v) const {
        if (col < 512) st_bf4(QKV + (size_t)row * 768 + col, v * QSCALE);
        else if (col < 768) { st_bf4(QKV + (size_t)row * 768 + col, v); float* dst = kv_dst(row, col); if (dst) *(f32x4*)dst = v; }
        else st_bf4(U2 + (size_t)row * 768 + (col - 768), v);
    }
};
struct FFF1 {
    static constexpr bool STATS = false, PRELOAD = false, DEFERRED_PREP = false, STAGGER = true;
    const float* part; const float* part_s; const float* cs; const float* bw; bf16_t* HID; float* part_out; float* part_out_s;
    DI bool is_dry() const { return false; }
    DI const float* stats_src() const { return part; }
    static DI FFF1 make(const Params& p, int l, int) { unsigned char* ws = p.ws;
        return FFF1{(const float*)(ws + WS_ST1), (const float*)(ws + WS_STS1), (const float*)(ws + WS_CS1) + l * 4096, (const float*)(ws + WS_BW1) + l * 4096, (bf16_t*)(ws + WS_HID), nullptr, nullptr}; }
    template <bool SMP> DI RowCtx row_begin(int row, int fq) const { RowCtx r; if (SMP) row_stats_s(part_s, row - TP, fq, r.mu, r.rstd); else row_stats(part, row, fq, r.mu, r.rstd); return r; }
    DI ColCtx col_begin(int col) const { ColCtx c; c.a = *(const f32x4*)(cs + col); c.b = *(const f32x4*)(bw + col); return c; }
    DI f32x4 row_load8(int, int) const { return (f32x4){0.f, 0.f, 0.f, 0.f}; }
    DI f32x4 row_load4(int, int) const { return (f32x4){0.f, 0.f, 0.f, 0.f}; }
    DI f32x4 compute(int, int, f32x4 a, const RowCtx& rc, const ColCtx& cc, float, float) const {
        f32x4 v = (a - rc.mu * cc.a) * rc.rstd + cc.b;
        v.x = fmaxf(v.x, 0.f); v.y = fmaxf(v.y, 0.f); v.z = fmaxf(v.z, 0.f); v.w = fmaxf(v.w, 0.f); return v * v;
    }
    DI void store8(int row, int col, f32x4 v0, f32x4 v1) const { st_bf8(HID + (size_t)row * 4096 + col, v0, v1); }
    DI void store4(int row, int col, f32x4 v) const { st_bf4(HID + (size_t)row * 4096 + col, v); }
};
template <bool DRY> struct FResT {
    static constexpr bool STATS = true, PRELOAD = true, DEFERRED_PREP = false, STAGGER = false;
    int raw; const float* part; const float* part_s; const float* g; const float* b; float* Y; bf16_t* YB; float* part_out; float* part_out_s;
    static DI FResT make(const Params& p, int l, int which) { unsigned char* ws = p.ws;
        if (which == 0) return FResT{l == 0 ? 1 : 0, (const float*)(ws + WS_ST2), (const float*)(ws + WS_STS2), p.ln2_g, p.ln2_b, nullptr, (bf16_t*)(ws + WS_YB), (float*)(ws + WS_ST1), (float*)(ws + WS_STS1)};
        return FResT{0, (const float*)(ws + WS_ST1), (const float*)(ws + WS_STS1), p.ln1_g + l * 1024, p.ln1_b + l * 1024, nullptr, (bf16_t*)(ws + WS_YB), (float*)(ws + WS_ST2), (float*)(ws + WS_STS2)}; }
    DI bool is_dry() const { return DRY; }
    DI const float* stats_src() const { return raw ? nullptr : part; }
    template <bool SMP> DI RowCtx row_begin(int row, int fq) const { RowCtx r{0.f, 1.f}; if (!raw) { if (SMP) row_stats_s(part_s, row - TP, fq, r.mu, r.rstd); else row_stats(part, row, fq, r.mu, r.rstd); } return r; }
    DI ColCtx col_begin(int col) const { ColCtx c; c.a = *(const f32x4*)(g + col); c.b = *(const f32x4*)(b + col); return c; }
    DI f32x4 row_load8(int row, int col) const { const u32x4 w = *(const u32x4*)(YB + (size_t)row * 1024 + col); return __builtin_bit_cast(f32x4, w); }
    DI f32x4 row_load4(int row, int col) const { const u32x2 w = *(const u32x2*)(YB + (size_t)row * 1024 + col); return (f32x4){__uint_as_float(w.x), __uint_as_float(w.y), 0.f, 0.f}; }
    DI f32x4 compute(int, int, f32x4 a, const RowCtx& rc, const ColCtx& cc, float p0, float p1) const {
        const unsigned w0 = __float_as_uint(p0), w1 = __float_as_uint(p1);
        const f32x4 x = (f32x4){__uint_as_float(w0 << 16), __uint_as_float(w0 & 0xffff0000u), __uint_as_float(w1 << 16), __uint_as_float(w1 & 0xffff0000u)};
        const f32x4 r = raw ? x : ((x - rc.mu) * rc.rstd * cc.a + cc.b);
        return ALPHA * r + a;
    }
    DI void store8(int row, int col, f32x4 v0, f32x4 v1) const {
        if (!DRY) { st_bf8(YB + (size_t)row * 1024 + col, v0, v1); if (Y) { float* d = Y + (size_t)row * 1024 + col; *(f32x4*)d = v0; *(f32x4*)(d + 4) = v1; } }
    }
    DI void store4(int row, int col, f32x4 v) const {
        if (!DRY) { st_bf4(YB + (size_t)row * 1024 + col, v); if (Y) *(f32x4*)(Y + (size_t)row * 1024 + col) = v; }
    }
};
typedef FResT<false> FRes;

constexpr int STAT_TAB_OFF = 131072;
template <class F> struct EpiWrap {
    int l, which; LAS unsigned char* lds;
    DI void operator()(const f32x4 (&acc)[2][2][4][2], const pg8::Unit& u, int ui, int wr, int wc, int fr, int fq) const {
        const Params p = kparams();
        const F f = F::make(p, launder_i(l), which);
        const bool has_stats = f.stats_src() != nullptr;
        const LAS f32x2* tab = (const LAS f32x2*)(lds + STAT_TAB_OFF) + ui * 256 + wr * 64 + fr;
        const int rbase = u.pm * 256 + wr * 64 + fr, cbase = u.pn * 256 + wc * 32 + 8 * fq;
        ColCtx cc[2][2];
#pragma unroll
        for (int bj = 0; bj < 2; ++bj)
#pragma unroll
            for (int n = 0; n < 2; ++n) cc[bj][n] = f.col_begin(cbase + bj * 128 + 4 * n);
#pragma unroll
        for (int ai = 0; ai < 2; ++ai) {
            RowCtx rc[4]; float s[4], ss[4];
#pragma unroll
            for (int m = 0; m < 4; ++m) { const f32x2 t = has_stats ? tab[ai * 128 + m * 16] : (f32x2){0.f, 1.f}; rc[m].mu = t.x; rc[m].rstd = t.y; s[m] = 0.f; ss[m] = 0.f; }
#pragma unroll
            for (int bj = 0; bj < 2; ++bj) {
                const int col8 = cbase + bj * 128;
                f32x4 pre, nxt = f.row_load8(rbase + ai * 128, col8);
#pragma unroll
                for (int m = 0; m < 4; ++m) {
                    const int row = rbase + ai * 128 + m * 16;
                    pre = nxt;
                    if (F::PRELOAD && m < 3) nxt = f.row_load8(row + 16, col8);
                    const f32x4 y0 = f.compute(row, col8, acc[ai][bj][m][0], rc[m], cc[bj][0], pre.x, pre.y);
                    const f32x4 y1 = f.compute(row, col8 + 4, acc[ai][bj][m][1], rc[m], cc[bj][1], pre.z, pre.w);
                    if (F::STATS) { s[m] += ((y0.x + y0.y) + (y0.z + y0.w)) + ((y1.x + y1.y) + (y1.z + y1.w));
                        ss[m] += ((y0.x * y0.x + y0.y * y0.y) + (y0.z * y0.z + y0.w * y0.w)) + ((y1.x * y1.x + y1.y * y1.y) + (y1.z * y1.z + y1.w * y1.w)); }
                    f.store8(row, col8, y0, y1);
                }
            }
            if (F::STATS) {
#pragma unroll
                for (int m = 0; m < 4; ++m) {
                    float a = s[m], b = ss[m];
                    a += __shfl_xor(a, 16); a += __shfl_xor(a, 32); b += __shfl_xor(b, 16); b += __shfl_xor(b, 32);
                    if (fq == 0 && !f.is_dry()) *(f32x2*)(f.part_out + (size_t)(rbase + ai * 128 + m * 16) * 32 + (u.pn * 4 + wc) * 2) = (f32x2){a, b};
                }
            }
        }
    }
};

template <class F>
DI void sgemm_unit(LAS unsigned char* lds, const bf16_t* A, const bf16_t* Wt, int K, int col0, const F& f, int wid, int lane) {
    const int fr = lane & 15, fq = lane >> 4;
    const int kw = K >> 3;
    const bf16_t* ap = A + (size_t)fr * K + wid * kw + 8 * fq;
    const bf16_t* wp = Wt + (size_t)(col0 + fr) * K + wid * kw + 8 * fq;
    const int row = TP + wid * 16 + fr;
    const RowCtx rc = f.template row_begin<true>(row, fq);
    const ColCtx cc = f.col_begin(col0 + 4 * fq);
    const f32x4 pre = f.row_load4(row, col0 + 4 * fq);
    f32x4 acc[8];
#pragma unroll
    for (int i = 0; i < 8; ++i) acc[i] = (f32x4){0.f, 0.f, 0.f, 0.f};
#pragma unroll 2
    for (int k = 0; k < kw; k += 32) {
        const bf16x8 w = *(const bf16x8*)(wp + k);
#pragma unroll
        for (int mt = 0; mt < 8; ++mt) { const bf16x8 a = *(const bf16x8*)(ap + (size_t)mt * 16 * K + k); acc[mt] = mfma16(w, a, acc[mt]); }
    }
    LAS f32x4* red = (LAS f32x4*)lds;
#pragma unroll
    for (int mt = 0; mt < 8; ++mt) red[(wid * 8 + mt) * 64 + lane] = acc[mt];
    __syncthreads();
    f32x4 tot = (f32x4){0.f, 0.f, 0.f, 0.f};
#pragma unroll
    for (int s = 0; s < 8; ++s) tot += red[(s * 8 + wid) * 64 + lane];
    const f32x4 y = f.compute(row, col0 + 4 * fq, tot, rc, cc, pre.x, pre.y);
    f.store4(row, col0 + 4 * fq, y);
    if (F::STATS) {
        float s = (y.x + y.y) + (y.z + y.w), ss = (y.x * y.x + y.y * y.y) + (y.z * y.z + y.w * y.w);
        s += __shfl_xor(s, 16); s += __shfl_xor(s, 32); ss += __shfl_xor(ss, 16); ss += __shfl_xor(ss, 32);
        if (fq == 0 && !f.is_dry()) *(f32x2*)(f.part_out_s + (size_t)(row - TP) * 128 + (col0 >> 4) * 2) = (f32x2){s, ss};
    }
    __syncthreads();
}

DI void prep_deferred(const Params& p, int slot, LAS unsigned char* lds, int tid, int widx, int NW);
template <class F>
DI void gemm_all(LAS unsigned char* lds, const bf16_t* A, const bf16_t* Wt, int N, int K, int l, int which, int vb, int G, int tid) {
    int wid, lane; RELAUNDER();
    pg8::Gemm g{A, Wt, TP, N, K}; pg8::StaticOrder S; S.init(TP, N, G, vb);
    {
        const Params p = kparams();
        const F f = F::make(p, launder_i(l), which);
        const float* part = f.stats_src();
        if (part) {
            LAS f32x2* tab = (LAS f32x2*)(lds + STAT_TAB_OFF);
            const int r = tid >> 1, hlf = tid & 1;
            f32x4 v[4][4]; bool ok[4];
#pragma unroll
            for (int i = 0; i < 4; ++i) { pg8::Unit u; ok[i] = S.next(i, u); const int row = (ok[i] ? u.pm : 0) * 256 + r;
                const f32x4* pp = (const f32x4*)(part + (size_t)row * 32 + hlf * 16);
#pragma unroll
                for (int j = 0; j < 4; ++j) v[i][j] = pp[j]; }
#pragma unroll
            for (int i = 0; i < 4; ++i) {
                float s = 0.f, ss = 0.f;
#pragma unroll
                for (int j = 0; j < 4; ++j) { s += v[i][j].x + v[i][j].z; ss += v[i][j].y + v[i][j].w; }
                s += __shfl_xor(s, 1); ss += __shfl_xor(ss, 1);
                const float mu = s * (1.0f / 1024.0f), var = ss * (1.0f / 1024.0f) - mu * mu, rstd = rsqrtf(fmaxf(var, 0.f) + LN_EPS);
                if (hlf == 0) tab[i * 256 + r] = (f32x2){mu, rstd};
            }
        }
        __syncthreads();
    }
    const int nsu_ = N / 16;
    const bool s_first = false;
    if (F::STAGGER && (((vb >> 3) & 1) != 0) && (G & 15) == 0) {
        const Params p = kparams();
        prep_deferred(p, launder_i(l) + 1, lds, tid, ((vb >> 4) << 3) | (vb & 7), G >> 1);
        __syncthreads();
    }
    EpiWrap<F> E{l, which, lds};
    pg8::gemm_phase<EpiWrap<F>>(lds, g, S, E, tid);
    if (F::DEFERRED_PREP) {
        const int nwg = (TP / 256) * (N / 256), first = (nwg > G && nwg < 2 * G) ? (nwg - G) : 0;
        if (vb >= first) { const Params p = kparams(); prep_deferred(p, launder_i(l) + 3, lds, tid, vb - first, G - first); __syncthreads(); }
    }
    const int nsu = N / 16;
    const int su0 = G - 1 - vb;
    if (su0 < nsu && !s_first) {
        const Params p = kparams();
        const F f = F::make(p, launder_i(l), which);
        for (int su = su0; su < nsu; su += G) sgemm_unit<F>(lds, A + (size_t)TP * K, Wt, K, su * 16, f, wid, lane);
    }
}

DI void transpose_tile_load(const float* W, const float* gain, int N, int k0, int n0, int tid, f32x4 (&v)[8]) {
#pragma unroll
    for (int i = 0; i < 8; ++i) { const int e = tid + 512 * i, row = e >> 5, c4 = e & 31;
        f32x4 x = __builtin_nontemporal_load((const f32x4*)(W + (size_t)(k0 + row) * N + n0 + 4 * c4));
        if (gain) x = x * gain[k0 + row];
        v[i] = x; }
}
DI void transpose_tile_store(LAS float* T, bf16_t* WT, int K, int k0, int n0, int tid, const f32x4 (&v)[8]) {
#pragma unroll
    for (int i = 0; i < 8; ++i) { const int e = tid + 512 * i, row = e >> 5, c4 = e & 31; LAS float* d = T + row * 129 + 4 * c4; d[0] = v[i].x; d[1] = v[i].y; d[2] = v[i].z; d[3] = v[i].w; }
    __syncthreads();
#pragma unroll
    for (int i = 0; i < 4; ++i) { const int e = tid + 512 * i, n = e >> 4, c8 = e & 15; const LAS float* s = T + (8 * c8) * 129 + n;
        u32x4 o; o.x = pk2(s[0], s[129]); o.y = pk2(s[2 * 129], s[3 * 129]); o.z = pk2(s[4 * 129], s[5 * 129]); o.w = pk2(s[6 * 129], s[7 * 129]);
        *(u32x4*)(WT + (size_t)(n0 + n) * K + k0 + 8 * c8) = o; }
    __syncthreads();
}
struct TrJob { const float* W; const float* gain; bf16_t* WT; int K, N, k0, n0; };
DI TrJob tr_job(const Params& p, int which, int l, int item) {
    unsigned char* ws = p.ws; TrJob j;
    if (which == 0) { j.W = p.w_in + (size_t)l * 1024 * 1536; j.gain = l ? p.ln2_g : nullptr; j.WT = (bf16_t*)(ws + WS_WIN) + (size_t)l * 1536 * 1024; j.K = 1024; j.N = 1536; }
    else if (which == 1) { j.W = p.w_out + (size_t)l * 1024 * 1024; j.gain = nullptr; j.WT = (bf16_t*)(ws + WS_WOUT) + (size_t)l * 1024 * 1024; j.K = 1024; j.N = 1024; }
    else if (which == 2) { j.W = p.w_ff1 + (size_t)l * 1024 * 4096; j.gain = p.ln1_g + l * 1024; j.WT = (bf16_t*)(ws + WS_W1) + (size_t)l * 4096 * 1024; j.K = 1024; j.N = 4096; }
    else { j.W = p.w_ff2 + (size_t)l * 4096 * 1024; j.gain = nullptr; j.WT = (bf16_t*)(ws + WS_W2) + (size_t)l * 1024 * 4096; j.K = 4096; j.N = 1024; }
    const int nb = j.N / 128; j.k0 = (item / nb) * 128; j.n0 = (item % nb) * 128; return j;
}
DI TrJob tr_slot_job(const Params& p, int slot, int it) {
    if (slot == 0) { if (it < 96) return tr_job(p, 0, 0, it); return tr_job(p, 0, 1, it - 96); }
    if (slot <= 2) return tr_job(p, 3, slot - 1, it);
    if (it < 64) return tr_job(p, 1, slot - 3, it);
    return tr_job(p, 2, slot - 3, it - 64);
}
DI void transpose_slot(const Params& p, int slot, LAS unsigned char* lds, int tid, int widx, int NW) {
    const int nit = slot == 0 ? 192 : (slot <= 2 ? 256 : 320);
    LAS float* T = (LAS float*)lds;
    f32x4 v[8];
    int it = widx;
    if (it < nit) { const TrJob j = tr_slot_job(p, slot, it); transpose_tile_load(j.W, j.gain, j.N, j.k0, j.n0, tid, v); }
    for (; it < nit; it += NW) {
        const TrJob j = tr_slot_job(p, slot, it);
#pragma unroll
        for (int i = 0; i < 8; ++i) { const int e = tid + 512 * i, row = e >> 5, c4 = e & 31; LAS float* d = T + row * 129 + 4 * c4; d[0] = v[i].x; d[1] = v[i].y; d[2] = v[i].z; d[3] = v[i].w; }
        __syncthreads();
        if (it + NW < nit) { const TrJob jn = tr_slot_job(p, slot, it + NW); transpose_tile_load(jn.W, jn.gain, jn.N, jn.k0, jn.n0, tid, v); }
#pragma unroll
        for (int i = 0; i < 4; ++i) { const int e = tid + 512 * i, n = e >> 4, c8 = e & 15; const LAS float* s = T + (8 * c8) * 129 + n;
            u32x4 o; o.x = pk2(s[0], s[129]); o.y = pk2(s[2 * 129], s[3 * 129]); o.z = pk2(s[4 * 129], s[5 * 129]); o.w = pk2(s[6 * 129], s[7 * 129]);
            *(u32x4*)(j.WT + (size_t)(j.n0 + n) * j.K + j.k0 + 8 * c8) = o; }
        __syncthreads();
    }
}
DI void colsum_item(const float* W, const float* gain, const float* bias, int N, int c0, float* cs, float* bw, LAS float* red, int wid, int lane) {
    float s1 = 0.f, s2 = 0.f;
    const float* wp = W + (size_t)(wid * 128) * N + c0 + lane;
#pragma unroll 32
    for (int k = 0; k < 128; ++k) { const float w = wp[(size_t)k * N]; const int kk = wid * 128 + k; s1 += bfround(gain[kk] * w); s2 += bias[kk] * w; }
    red[wid * 128 + lane] = s1; red[wid * 128 + 64 + lane] = s2;
    __syncthreads();
    if (wid == 0) { float a = 0.f, b = 0.f;
#pragma unroll
        for (int w = 0; w < 8; ++w) { a += red[w * 128 + lane]; b += red[w * 128 + 64 + lane]; }
        cs[c0 + lane] = a; bw[c0 + lane] = b; }
    __syncthreads();
}
DI void prep_deferred(const Params& p, int slot, LAS unsigned char* lds, int tid, int widx, int NW) {
    tid = launder_v(tid);
    transpose_slot(p, slot, lds, tid, widx, NW);
}
DI void phase_prep(const Params& p, LAS unsigned char* lds, int tid, int wid, int lane, int vb, int G) {
    RELAUNDER();
    unsigned char* ws = p.ws;
    const int gw = vb * 8 + wid, NGW = G * 8;
    transpose_slot(p, 0, lds, tid, vb, G);
    bf16_t* YB = (bf16_t*)(ws + WS_YB);
    for (int m0 = gw; m0 < MT; m0 += 4 * NGW) {
        f32x4 v[4][4];
#pragma unroll
        for (int r = 0; r < 4; ++r) { const int m = m0 + r * NGW; const int mm = m < MT ? m : m0;
            const f32x4* src = (const f32x4*)(mm < TP ? p.xp + (size_t)mm * 1024 : p.xs + (size_t)(mm - TP) * 1024);
#pragma unroll
            for (int j = 0; j < 4; ++j) v[r][j] = __builtin_nontemporal_load(src + lane + 64 * j); }
#pragma unroll
        for (int r = 0; r < 4; ++r) { const int m = m0 + r * NGW;
            if (m < MT) {
#pragma unroll
                for (int j = 0; j < 4; ++j) st_bf4(YB + (size_t)m * 1024 + 4 * (lane + 64 * j), v[r][j]); } }
    }
#pragma unroll
    for (int which = 0; which < 3; ++which) {
        const float* src = which == 0 ? p.ga_w : (which == 1 ? p.gx_w : p.pool_w);
        bf16_t* dst = (bf16_t*)(ws + (which == 0 ? WS_GAT : (which == 1 ? WS_GXT : WS_PWT)));
        for (int r = vb * NTHR + tid; r < 32768; r += G * NTHR) {
            const int ln = r >> 12, d = (r >> 6) & 63, c = r & 63;
            dst[r] = (bf16_t)(pk2(src[(ln << 12) + c * 64 + d], 0.f) & 0xffffu);
        }
    }
    __syncthreads();
}

DI void attn_item(const Params& p, int layer, int item, LAS unsigned char* lds, int tid, int wid, int lane) {
    RELAUNDER();
    const int kvh = item & 1, qb = (item >> 1) & 31, b = item >> 6;
    const bf16_t* QKV = (const bf16_t*)(p.ws + WS_QKV); bf16_t* MIX = (bf16_t*)(p.ws + WS_MIX);
    LAS bf16_t* Ks = (LAS bf16_t*)lds;
    LAS bf16_t* Vt = (LAS bf16_t*)(lds + 36864);
    {
        const int key = tid >> 1, half = tid & 1; const int tok = qb * 128 - 128 + key;
        u32x4 kv[4], vv[4];
        if (tok >= 0) { const bf16_t* src = QKV + ((size_t)b * 4096 + tok) * 768 + 512 + kvh * 64 + half * 32;
#pragma unroll
            for (int i = 0; i < 4; ++i) { kv[i] = ((const u32x4*)src)[i]; vv[i] = ((const u32x4*)(src + 128))[i]; } }
        else {
#pragma unroll
            for (int i = 0; i < 4; ++i) { kv[i] = (u32x4){0u, 0u, 0u, 0u}; vv[i] = (u32x4){0u, 0u, 0u, 0u}; } }
#pragma unroll
        for (int i = 0; i < 4; ++i) *(LAS u32x4*)(Ks + key * 72 + half * 32 + 8 * i) = kv[i];
#pragma unroll
        for (int i = 0; i < 4; ++i)
#pragma unroll
            for (int e = 0; e < 8; ++e) { const int d = half * 32 + 8 * i + e; Vt[d * 264 + key] = (bf16_t)((vv[i][e >> 1] >> (16 * (e & 1))) & 0xffffu); }
    }
    __syncthreads();
    const int g = wid >> 1, qh = wid & 1, h = kvh * 4 + g, fr = lane & 15, fq = lane >> 4;
    const float slope2 = exp2f(-(float)(h + 1)) * LOG2E, sink2 = p.sinks[layer * 8 + h] * LOG2E;
    const size_t rowbase = (size_t)b * 4096 + qb * 128;
    bf16x8 qall[4][2];
#pragma unroll
    for (int qt = 0; qt < 4; ++qt) { const bf16_t* qp = QKV + (rowbase + qh * 64 + qt * 16 + fr) * 768 + h * 64 + 8 * fq; qall[qt][0] = *(const bf16x8*)qp; qall[qt][1] = *(const bf16x8*)(qp + 32); }
#pragma unroll
    for (int qt = 0; qt < 4; ++qt) {
        const int i0 = qh * 64 + qt * 16, jb = 32 * ((qh * 4 + qt) >> 1), iq = i0 + fr;
        const bf16x8 q0 = qall[qt][0], q1 = qall[qt][1];
        f32x4 s[10];
        float mx = sink2;
        const bool odd = (qt & 1) != 0;
        if (qb > 0) {
            const float t0 = -slope2 * (float)(iq + 128 - jb - 4 * fq);
            const float tb0 = t0, tb1 = t0 + slope2, tb2 = t0 + 2.0f * slope2, tb3 = t0 + 3.0f * slope2;
#pragma unroll
            for (int kt = 0; kt < 10; ++kt) {
                const bool dead = odd ? (kt == 0) : (kt == 9);
                if (dead) { s[kt] = (f32x4){0.f, 0.f, 0.f, 0.f}; continue; }
                const float c = slope2 * (float)(16 * kt);
                const LAS bf16_t* kp = Ks + (jb + 16 * kt + fr) * 72 + 8 * fq;
                const bf16x8 k0 = *(const LAS bf16x8*)kp, k1 = *(const LAS bf16x8*)(kp + 32);
                s[kt] = mfma16(k0, q0, (f32x4){tb0 + c, tb1 + c, tb2 + c, tb3 + c}); s[kt] = mfma16(k1, q1, s[kt]);
                const bool lo = odd ? (kt == 1) : (kt == 0), hi = odd ? (kt == 9) : (kt == 8);
#pragma unroll
                for (int i = 0; i < 4; ++i) {
                    if (lo) s[kt][i] = (4 * fq + i >= fr) ? s[kt][i] : -1e30f;
                    if (hi) s[kt][i] = (4 * fq + i <= fr) ? s[kt][i] : -1e30f;
                    mx = fmaxf(mx, s[kt][i]); }
            }
        } else {
#pragma unroll
            for (int kt = 0; kt < 10; ++kt) { const LAS bf16_t* kp = Ks + (jb + 16 * kt + fr) * 72 + 8 * fq;
                const bf16x8 k0 = *(const LAS bf16x8*)kp, k1 = *(const LAS bf16x8*)(kp + 32);
                s[kt] = mfma16(k0, q0, (f32x4){0.f, 0.f, 0.f, 0.f}); s[kt] = mfma16(k1, q1, s[kt]); }
#pragma unroll
            for (int kt = 0; kt < 10; ++kt)
#pragma unroll
                for (int i = 0; i < 4; ++i) { const int j = jb + 16 * kt + 4 * fq + i, delta = iq + 128 - j;
                    const bool valid = (delta >= 0) && (delta <= 128) && (j >= 128);
                    const float v = s[kt][i] - slope2 * (float)delta;
                    s[kt][i] = valid ? v : -1e30f; mx = fmaxf(mx, s[kt][i]); }
        }
        mx = fmaxf(mx, __shfl_xor(mx, 16)); mx = fmaxf(mx, __shfl_xor(mx, 32));
        float sum = 0.f;
#pragma unroll
        for (int kt = 0; kt < 10; ++kt) {
            if (qb > 0 && (odd ? (kt == 0) : (kt == 9))) continue;
#pragma unroll
            for (int i = 0; i < 4; ++i) { const float pv = __builtin_amdgcn_exp2f(s[kt][i] - mx); s[kt][i] = pv; sum += pv; }
        }
        sum += __shfl_xor(sum, 16); sum += __shfl_xor(sum, 32);
        const float inv = 1.0f / (sum + __builtin_amdgcn_exp2f(sink2 - mx));
        bf16x8 pf[5];
#pragma unroll
        for (int G = 0; G < 5; ++G) pf[G] = pack8(s[2 * G], s[2 * G + 1]);
#pragma unroll
        for (int dt = 0; dt < 4; ++dt) {
            f32x4 o = (f32x4){0.f, 0.f, 0.f, 0.f};
#pragma unroll
            for (int G = 0; G < 5; ++G) { const LAS bf16_t* vp = Vt + (16 * dt + fr) * 264 + jb + 32 * G + 4 * fq;
                const u32x2 lo = *(const LAS u32x2*)vp, hi = *(const LAS u32x2*)(vp + 16);
                const u32x4 w = (u32x4){lo.x, lo.y, hi.x, hi.y};
                o = mfma16(__builtin_bit_cast(bf16x8, w), pf[G], o); }
            st_bf4(MIX + (rowbase + iq) * 1024 + h * 64 + 16 * dt + 4 * fq, o * inv);
        }
    }
    __syncthreads();
}

DI void sattn_item(const Params& p, int layer, int j, LAS unsigned char* lds, int tid, int wid, int lane) {
    RELAUNDER();
    LAS float* Kc = (LAS float*)lds;
    LAS float* Vc = Kc + 129 * 132;
    LAS float* Ps = Vc + 129 * 132;
    LAS float* Qs = Ps + 8 * 132;
    const size_t cbase = ((size_t)(layer * 128 + j)) * 128 * 128;
    const f32x4* ck = (const f32x4*)(p.ck + cbase); const f32x4* cv = (const f32x4*)(p.cv + cbase);
    f32x4* sk = (f32x4*)(p.out + O_SK + cbase); f32x4* sv = (f32x4*)(p.out + O_SV + cbase);
#pragma unroll
    for (int i = 0; i < 8; ++i) { const int idx = tid + 512 * i, s = idx >> 5, c4 = idx & 31;
        const f32x4 kv = __builtin_nontemporal_load(ck + idx), vv = __builtin_nontemporal_load(cv + idx);
        *(LAS f32x4*)(Kc + s * 132 + 4 * c4) = kv; *(LAS f32x4*)(Vc + s * 132 + 4 * c4) = vv;
        if (s >= 1) { __builtin_nontemporal_store(kv, sk + (idx - 32)); __builtin_nontemporal_store(vv, sv + (idx - 32)); } }
    if (tid < 32) *(LAS f32x4*)(Kc + 128 * 132 + 4 * tid) = sk[127 * 32 + tid];
    else if (tid < 64) *(LAS f32x4*)(Vc + 128 * 132 + 4 * (tid - 32)) = sv[127 * 32 + (tid - 32)];
    const bf16_t* QKV = (const bf16_t*)(p.ws + WS_QKV);
    Qs[tid] = bf2f(QKV[(size_t)(TP + j) * 768 + tid]);
    __syncthreads();
    const int h = wid, kvh = h >> 2;
    const float slope = exp2f(-(float)(h + 1)), sink2 = p.sinks[layer * 8 + h] * LOG2E;
    float sc[3];
#pragma unroll
    for (int r = 0; r < 3; ++r) {
        const int s = (r < 2) ? lane + 64 * r : 128;
        const LAS f32x4* kp = (const LAS f32x4*)(Kc + s * 132 + kvh * 64); const LAS f32x4* qp = (const LAS f32x4*)(Qs + h * 64);
        float d = 0.f;
#pragma unroll
        for (int i = 0; i < 16; ++i) { const f32x4 a = kp[i], q = qp[i]; d += (a.x * q.x + a.y * q.y) + (a.z * q.z + a.w * q.w); }
        const float delta = (float)(128 - s);
        sc[r] = d - slope * LOG2E * delta;
        if (r == 2 && lane != 0) sc[r] = -1e30f;
    }
    float mx = fmaxf(fmaxf(sc[0], sc[1]), fmaxf(sc[2], sink2));
#pragma unroll
    for (int o = 1; o < 64; o <<= 1) mx = fmaxf(mx, __shfl_xor(mx, o));
    float sum = 0.f;
#pragma unroll
    for (int r = 0; r < 3; ++r) { sc[r] = __builtin_amdgcn_exp2f(sc[r] - mx); sum += sc[r]; }
#pragma unroll
    for (int o = 1; o < 64; o <<= 1) sum += __shfl_xor(sum, o);
    const float inv = 1.0f / (sum + __builtin_amdgcn_exp2f(sink2 - mx));
    Ps[h * 132 + lane] = sc[0]; Ps[h * 132 + 64 + lane] = sc[1]; if (lane == 0) Ps[h * 132 + 128] = sc[2];
    lds_wait();
    float o = 0.f;
#pragma unroll 8
    for (int s = 0; s < 129; ++s) o += Ps[h * 132 + s] * Vc[s * 132 + kvh * 64 + lane];
    bf16_t* MIX = (bf16_t*)(p.ws + WS_MIX);
    MIX[(size_t)(TP + j) * 1024 + h * 64 + lane] = (bf16_t)(pk2(o * inv, 0.f) & 0xffffu);
    __syncthreads();
}

DI float fsigmoid(float x) { return __builtin_amdgcn_rcpf(1.0f + __builtin_amdgcn_exp2f(-LOG2E * x)); }
DI void rglru_item(const Params& p, int layer, int item, LAS unsigned char* lds, int tid, int wid, int lane) {
    RELAUNDER();
    LAS float* XC = (LAS float*)lds;
    const bf16_t* U2 = (const bf16_t*)(p.ws + WS_U2);
    const int ti = item >> 1, chalf = item & 1;
    const bool smp = (ti == 128);
    const int b = ti >> 5, ch = ti & 31;
    {
        const int cq = tid & 31, tg = tid >> 5, cqg = chalf * 32 + cq;
        const f32x4 cb = ((const f32x4*)(p.conv_b + layer * 256))[cqg];
        f32x4 cw[4];
#pragma unroll
        for (int t = 0; t < 4; ++t) cw[t] = ((const f32x4*)(p.conv_w + (layer * 4 + t) * 256))[cqg];
        if (!smp) {
            f32x4 x[11];
#pragma unroll
            for (int k = 0; k < 11; ++k) { const int t = ch * 128 + 8 * tg - 3 + k;
                x[k] = (t >= 0) ? ld_bf4(U2 + ((size_t)b * 4096 + t) * 768 + 4 * cqg) : (f32x4){0.f, 0.f, 0.f, 0.f}; }
#pragma unroll
            for (int k = 0; k < 8; ++k) { const f32x4 xc = cb + cw[0] * x[k] + cw[1] * x[k + 1] + cw[2] * x[k + 2] + cw[3] * x[k + 3];
                *(LAS f32x4*)(XC + (8 * tg + k) * 132 + 4 * cq) = xc; }
            if (ch == 31 && tg == 15) { f32x4* pc = (f32x4*)(p.out + O_PC + (size_t)(layer * 4 + b) * 3 * 256);
                pc[0 * 64 + cqg] = x[8]; pc[1 * 64 + cqg] = x[9]; pc[2 * 64 + cqg] = x[10]; }
        } else {
#pragma unroll 4
            for (int k = 0; k < 8; ++k) { const int j = 8 * tg + k;
                const f32x4* scp = (const f32x4*)(p.sc + (size_t)(layer * 128 + j) * 3 * 256);
                const f32x4 s0 = scp[cqg], s1 = scp[64 + cqg], s2 = scp[128 + cqg], xr = ld_bf4(U2 + (size_t)(TP + j) * 768 + 4 * cqg);
                const f32x4 xc = cb + cw[0] * s0 + cw[1] * s1 + cw[2] * s2 + cw[3] * xr;
                *(LAS f32x4*)(XC + j * 132 + 4 * cq) = xc;
                f32x4* oc = (f32x4*)(p.out + O_SC + (size_t)(layer * 128 + j) * 3 * 256);
                oc[cqg] = s1; oc[64 + cqg] = s2; oc[128 + cqg] = xr; }
        }
    }
    __syncthreads();
    const int nl = wid >> 2, n = 2 * chalf + nl, fr = lane & 15, fq = lane >> 4;
    const int d = 16 * (wid & 3) + fr, cl = 64 * nl + d, c = 128 * chalf + cl;
    const bf16_t* GaT = (const bf16_t*)(p.ws + WS_GAT); const bf16_t* GxT = (const bf16_t*)(p.ws + WS_GXT);
    bf16x8 wa[2], wx[2];
#pragma unroll
    for (int ks = 0; ks < 2; ++ks) { const size_t o = ((size_t)((layer * 4 + n) * 64 + d)) * 64 + 32 * ks + 8 * fq; wa[ks] = *(const bf16x8*)(GaT + o); wx[ks] = *(const bf16x8*)(GxT + o); }
    const float ba = p.ga_b[layer * 256 + c], bx = p.gx_b[layer * 256 + c];
    const float spv = -8.0f * LOG2E * log1pf(__expf(-p.lam[layer * 256 + c]));
    float Ac = 1.f, Bc = 0.f;
    unsigned* HC = (unsigned*)(p.ws + WS_HL);
    bf16_t* MIX = (bf16_t*)(p.ws + WS_MIX);
    for (int tt = 0; tt < 8; ++tt) {
        bf16x8 af[2];
#pragma unroll
        for (int ks = 0; ks < 2; ++ks) { const LAS f32x4* src = (const LAS f32x4*)(XC + (16 * tt + fr) * 132 + 64 * nl + 32 * ks + 8 * fq); af[ks] = pack8(src[0], src[1]); }
        f32x4 ar = (f32x4){0.f, 0.f, 0.f, 0.f}, ai = (f32x4){0.f, 0.f, 0.f, 0.f};
#pragma unroll
        for (int ks = 0; ks < 2; ++ks) { ar = mfma16(af[ks], wa[ks], ar); ai = mfma16(af[ks], wx[ks], ai); }
        float av[4], bv[4];
#pragma unroll
        for (int i = 0; i < 4; ++i) { const int t = 16 * tt + 4 * fq + i; const float xcv = XC[t * 132 + cl];
            const float r = fsigmoid(ar[i] + ba), ig = fsigmoid(ai[i] + bx);
            const float a = __builtin_amdgcn_exp2f(spv * r);
            av[i] = a; bv[i] = __builtin_amdgcn_sqrtf(fmaxf(1.0f - a * a, 0.f)) * (ig * xcv); }
        if (smp) {
#pragma unroll
            for (int i = 0; i < 4; ++i) { const int j = 16 * tt + 4 * fq + i;
                const float h0 = p.sh[(size_t)(layer * 128 + j) * 256 + c];
                const float hv = av[i] * h0 + bv[i];
                p.out[O_SH + (size_t)(layer * 128 + j) * 256 + c] = hv;
                const float gr = bf2f(U2[(size_t)(TP + j) * 768 + 256 + c]);
                MIX[(size_t)(TP + j) * 1024 + 512 + c] = (bf16_t)(pk2(hv * gelu_tanh(gr), 0.f) & 0xffffu); }
        } else {
            float A4 = 1.f, B4 = 0.f;
#pragma unroll
            for (int i = 0; i < 4; ++i) { B4 = av[i] * B4 + bv[i]; A4 *= av[i]; }
            { const float A1 = __shfl_up(A4, 16), B1 = __shfl_up(B4, 16); if (fq >= 1) { B4 = A4 * B1 + B4; A4 = A4 * A1; } }
            { const float A2 = __shfl_up(A4, 32), B2 = __shfl_up(B4, 32); if (fq >= 2) { B4 = A4 * B2 + B4; A4 = A4 * A2; } }
            float Ae = __shfl_up(A4, 16), Be = __shfl_up(B4, 16); if (fq == 0) { Ae = 1.f; Be = 0.f; }
            const float At = __shfl(A4, 48 + fr), Bt = __shfl(B4, 48 + fr);
            float Ain = Ac * Ae, hin = Ae * Bc + Be;
#pragma unroll
            for (int i = 0; i < 4; ++i) { hin = av[i] * hin + bv[i]; Ain *= av[i];
                const size_t o = ((size_t)b * 4096 + ch * 128 + 16 * tt + 4 * fq + i) * 256 + c;
                HC[o] = pk2(hin, Ain); }
            Bc = At * Bc + Bt; Ac *= At;
        }
    }
    if (!smp && fq == 0) { ((float*)(p.ws + WS_AGA))[ti * 256 + c] = Ac; ((float*)(p.ws + WS_AGB))[ti * 256 + c] = Bc; }
    __syncthreads();
}

DI void rowsum_rows(const bf16_t* WT, const float* gain, const float* bias, int nrows, float* cs, float* bw, int gw, int NGW, int lane) {
    f32x4 r4[4];
#pragma unroll
    for (int j = 0; j < 4; ++j) { const f32x4 g4 = ((const f32x4*)gain)[lane * 4 + j], b4 = ((const f32x4*)bias)[lane * 4 + j]; r4[j] = b4 / g4; }
    for (int n = gw; n < nrows; n += NGW) {
        const u32x4* wp = (const u32x4*)(WT + (size_t)n * 1024 + 16 * lane);
        const u32x4 w0 = wp[0], w1 = wp[1];
        float s = 0.f, t = 0.f;
        const unsigned ww[8] = {w0.x, w0.y, w0.z, w0.w, w1.x, w1.y, w1.z, w1.w};
#pragma unroll
        for (int q = 0; q < 8; ++q) { const float lo = __uint_as_float(ww[q] << 16), hi = __uint_as_float(ww[q] & 0xffff0000u);
            s += lo + hi; t += lo * r4[q >> 1][(q & 1) * 2] + hi * r4[q >> 1][(q & 1) * 2 + 1]; }
#pragma unroll
        for (int o = 1; o < 64; o <<= 1) { s += __shfl_xor(s, o); t += __shfl_xor(t, o); }
        if (lane == 0) { cs[n] = s; bw[n] = t; }
    }
}

DI void fixup_item(const Params& p, int layer, int item, int tid) {
    tid = launder_v(tid);
    const int ti = item >> 2, qr = item & 3;
    const int b = ti >> 5, ch = ti & 31, c = tid & 255, half = tid >> 8;
    const float* AGA = (const float*)(p.ws + WS_AGA); const float* AGB = (const float*)(p.ws + WS_AGB);
    float carry = 0.f;
    {
        float ca[31], cb[31];
#pragma unroll
        for (int j = 0; j < 31; ++j) { const bool on = j < ch; ca[j] = on ? AGA[(b * 32 + j) * 256 + c] : 1.f; cb[j] = on ? AGB[(b * 32 + j) * 256 + c] : 0.f; }
#pragma unroll
        for (int j = 0; j < 31; ++j) carry = ca[j] * carry + cb[j];
    }
    const unsigned* HC = (const unsigned*)(p.ws + WS_HL); const bf16_t* U2 = (const bf16_t*)(p.ws + WS_U2);
    bf16_t* MIX = (bf16_t*)(p.ws + WS_MIX);
    const size_t row0 = (size_t)b * 4096 + ch * 128 + qr * 32 + half * 16;
    unsigned hc[16]; float grv[16];
#pragma unroll
    for (int k = 0; k < 16; ++k) { hc[k] = __builtin_nontemporal_load(HC + (row0 + k) * 256 + c); grv[k] = bf2f(__builtin_nontemporal_load(U2 + (row0 + k) * 768 + 256 + c)); }
    float h = 0.f;
#pragma unroll
    for (int k = 0; k < 16; ++k) { h = __uint_as_float(hc[k] << 16) + __uint_as_float(hc[k] & 0xffff0000u) * carry; MIX[(row0 + k) * 1024 + 512 + c] = (bf16_t)(pk2(h * gelu_tanh(grv[k]), 0.f) & 0xffffu); }
    if (ch == 31 && qr == 3 && half == 1) p.out[O_PH + (size_t)(layer * 4 + b) * 256 + c] = AGA[(b * 32 + 31) * 256 + c] * carry + AGB[(b * 32 + 31) * 256 + c];
}

DI void st_bf4_lds(LAS bf16_t* dst, f32x4 v) { u32x2 w; w.x = pk2(v.x, v.y); w.y = pk2(v.z, v.w); *(LAS u32x2*)dst = w; }
DI void pool_item(const Params& p, int layer, int ti, LAS unsigned char* lds, int tid, int wid, int lane) {
    RELAUNDER();
    LAS float* Zs = (LAS float*)lds;
    LAS bf16_t* Ds = (LAS bf16_t*)(lds + 48128);
    LAS bf16_t* Pw = (LAS bf16_t*)(lds + 115712);
    LAS float* Sc = (LAS float*)(lds + 152576);
    const bf16_t* U2 = (const bf16_t*)(p.ws + WS_U2);
    const bool smp = (ti >= 128);
    const int b = ti >> 5, ch = ti & 31;
    const int cq = tid & 63, gq = cq >> 4, tg = tid >> 6;
    const float wf = (float)(2 << gq);
    {
        const bf16_t* PwT = (const bf16_t*)(p.ws + WS_PWT) + (size_t)layer * 4 * 64 * 64;
#pragma unroll
        for (int i = 0; i < 4; ++i) { const int idx = tid + 512 * i, rowi = idx >> 3, c8 = idx & 7;
            *(LAS u32x4*)(Pw + rowi * 72 + 8 * c8) = *(const u32x4*)(PwT + (size_t)rowi * 64 + 8 * c8); }
        if (tid < 64) *(LAS f32x4*)(Sc + 4 * tid) = ((const f32x4*)(p.pool_scale + layer * 256))[tid];
    }
    if (!smp) {
        if (ch == 31) {
            for (int idx = tid; idx < 15 * 64; idx += NTHR) { const int r = idx >> 6, c4 = idx & 63;
                ((f32x4*)(p.out + O_PP + ((size_t)(layer * 4 + b) * 15 + r) * 256))[c4] = ld_bf4(U2 + ((size_t)b * 4096 + 4081 + r) * 768 + 512 + 4 * c4); }
        }
        f32x4 pf[6];
#pragma unroll
        for (int i = 0; i < 6; ++i) { const int e = tid + 512 * i, r = e >> 6, c4 = e & 63, t = ch * 128 - 15 + r;
            pf[i] = (e < 47 * 64 && t >= 0) ? ld_bf4(U2 + ((size_t)b * 4096 + t) * 768 + 512 + 4 * c4) : (f32x4){0.f, 0.f, 0.f, 0.f}; }
        for (int q = 0; q < 4; ++q) {
#pragma unroll
            for (int i = 0; i < 6; ++i) { const int e = tid + 512 * i; if (e < 47 * 64) *(LAS f32x4*)(Zs + 4 * e) = pf[i]; }
            __syncthreads();
            if (q < 3) {
#pragma unroll
                for (int i = 0; i < 6; ++i) { const int e = tid + 512 * i, r = e >> 6, c4 = e & 63, t = ch * 128 + 32 * (q + 1) - 15 + r;
                    pf[i] = (e < 47 * 64 && t >= 0) ? ld_bf4(U2 + ((size_t)b * 4096 + t) * 768 + 512 + 4 * c4) : (f32x4){0.f, 0.f, 0.f, 0.f}; }
            }
            f32x4 v[19], zs[4], res[4];
#pragma unroll
            for (int k = 0; k < 19; ++k) v[k] = *(const LAS f32x4*)(Zs + (4 * tg + k) * 256 + 4 * cq);
#pragma unroll
            for (int j = 0; j < 4; ++j) zs[j] = v[15 + j];
#pragma unroll
            for (int k = 18; k >= 1; --k) v[k] += v[k - 1];
#pragma unroll
            for (int j = 0; j < 4; ++j) res[j] = v[15 + j];
#pragma unroll
            for (int k = 18; k >= 3; --k) v[k] += v[k - 2];
#pragma unroll
            for (int j = 0; j < 4; ++j) res[j] = (gq >= 1) ? v[15 + j] : res[j];
#pragma unroll
            for (int k = 18; k >= 7; --k) v[k] += v[k - 4];
#pragma unroll
            for (int j = 0; j < 4; ++j) res[j] = (gq >= 2) ? v[15 + j] : res[j];
#pragma unroll
            for (int k = 18; k >= 15; --k) v[k] += v[k - 8];
#pragma unroll
            for (int j = 0; j < 4; ++j) res[j] = (gq >= 3) ? v[15 + j] : res[j];
#pragma unroll
            for (int j = 0; j < 4; ++j) { const int tl = 32 * q + 4 * tg + j; const float rc = __builtin_amdgcn_rcpf(fminf((float)(ch * 128 + tl + 1), wf));
                const f32x4 diff = res[j] * rc - zs[j];
                st_bf4_lds(Ds + tl * 264 + 4 * cq, diff); }
            __syncthreads();
        }
    } else {
        const int j0 = 32 * (ti - 128);
        const float rw = 1.0f / wf;
#pragma unroll 2
        for (int k = 0; k < 4; ++k) { const int jl = 4 * tg + k, j = j0 + jl;
            const f32x4* sp = (const f32x4*)(p.spool + (size_t)(layer * 128 + j) * 15 * 256);
            f32x4 st[15];
#pragma unroll
            for (int r = 0; r < 15; ++r) st[r] = sp[r * 64 + cq];
            const f32x4 z = ld_bf4(U2 + (size_t)(TP + j) * 768 + 512 + 4 * cq);
            const f32x4 s2 = z + st[14];
            const f32x4 s4 = s2 + (st[13] + st[12]);
            const f32x4 s8 = s4 + ((st[11] + st[10]) + (st[9] + st[8]));
            const f32x4 s16 = s8 + (((st[7] + st[6]) + (st[5] + st[4])) + ((st[3] + st[2]) + (st[1] + st[0])));
            const f32x4 rs = (gq == 0) ? s2 : ((gq == 1) ? s4 : ((gq == 2) ? s8 : s16));
            const f32x4 diff = rs * rw - z;
            st_bf4_lds(Ds + jl * 264 + 4 * cq, diff);
            f32x4* op = (f32x4*)(p.out + O_SP + (size_t)(layer * 128 + j) * 15 * 256);
#pragma unroll
            for (int r = 0; r < 14; ++r) op[r * 64 + cq] = st[r + 1];
            op[14 * 64 + cq] = z; }
        __syncthreads();
    }
    const int fr = lane & 15, fq = lane >> 4;
    bf16_t* MIX = (bf16_t*)(p.ws + WS_MIX);
    if (!smp || wid < 2) {
        const size_t row = smp ? (size_t)(TP + 32 * (ti - 128) + 16 * wid + fr) : ((size_t)b * 4096 + ch * 128 + 16 * wid + fr);
#pragma unroll
        for (int g = 0; g < 4; ++g) {
            bf16x8 bfr[2];
#pragma unroll
            for (int ks = 0; ks < 2; ++ks) bfr[ks] = *(const LAS bf16x8*)(Ds + (16 * wid + fr) * 264 + 64 * g + 32 * ks + 8 * fq);
#pragma unroll
            for (int dt = 0; dt < 4; ++dt) {
                f32x4 o = (f32x4){0.f, 0.f, 0.f, 0.f};
#pragma unroll
                for (int ks = 0; ks < 2; ++ks) { const bf16x8 a = *(const LAS bf16x8*)(Pw + (g * 64 + 16 * dt + fr) * 72 + 32 * ks + 8 * fq); o = mfma16(a, bfr[ks], o); }
                const int c = 64 * g + 16 * dt + 4 * fq;
                const f32x4 sc4 = *(const LAS f32x4*)(Sc + c);
                st_bf4(MIX + row * 1024 + 768 + c, o * sc4);
            }
        }
    }
    __syncthreads();
}

DI void final_ln(const Params& p, int vb, int G, int tid) {
    int wid, lane; RELAUNDER();
    const float* part = (const float*)(p.ws + WS_ST2); const float* part_s = (const float*)(p.ws + WS_STS2);
    const bf16_t* YB = (const bf16_t*)(p.ws + WS_YB);
    const f32x4* g = (const f32x4*)(p.ln2_g + 1024); const f32x4* bb = (const f32x4*)(p.ln2_b + 1024);
    f32x4 g4[4], b4[4];
#pragma unroll
    for (int j = 0; j < 4; ++j) { g4[j] = g[lane + 64 * j]; b4[j] = bb[lane + 64 * j]; }
    const int gw = vb * 8 + wid, NGW = G * 8;
    for (int row0 = gw; row0 < MT; row0 += 4 * NGW) {
        f32x4 y[4][4]; float mu[4], rs[4];
#pragma unroll
        for (int r = 0; r < 4; ++r) { const int row = (row0 + r * NGW < MT) ? row0 + r * NGW : row0;
#pragma unroll
            for (int j = 0; j < 4; ++j) y[r][j] = ld_bf4_nt(YB + (size_t)row * 1024 + 4 * (lane + 64 * j));
            row_stats_any(part, part_s, row, lane >> 4, mu[r], rs[r]); }
#pragma unroll
        for (int r = 0; r < 4; ++r) { const int row = row0 + r * NGW;
            if (row < MT) { f32x4* op = (f32x4*)(p.out + (size_t)row * 1024);
#pragma unroll
                for (int j = 0; j < 4; ++j) __builtin_nontemporal_store((y[r][j] - mu[r]) * rs[r] * g4[j] + b4[j], op + lane + 64 * j); } }
    }
}

#define XB_TMO      128
#define XB_XCNT(j)  (256  + 64 * (j))
#define XB_XSUB(j)  (1280 + 64 * (j))
#define XB_XGEN(j)  (2304 + 64 * (j))
#define XB_TOP      3328
#define XB_TOPGEN   3392
#define XCD_BAR_WORDS 3456
#define XB_SPIN_CAP (1u << 22)
DI unsigned xb_ld(unsigned* p)              { return __hip_atomic_load(p, __ATOMIC_RELAXED, __HIP_MEMORY_SCOPE_AGENT); }
DI unsigned xb_add(unsigned* p, unsigned v) { return __hip_atomic_fetch_add(p, v, __ATOMIC_RELAXED, __HIP_MEMORY_SCOPE_AGENT); }
DI unsigned xb_xcc_id() { return (unsigned)__builtin_amdgcn_s_getreg((3 << 11) | 20) & 0xFu; }
#define XB_SPIN(cond, bar) do { unsigned _sp = 0; while (cond) { __builtin_amdgcn_s_sleep(1); \
    if ((++_sp & 255u) == 0u) { if (xb_ld(&(bar)[XB_TMO])) break; if (_sp > XB_SPIN_CAP) { atomicAdd(&(bar)[XB_TMO], 1u); break; } } } } while (0)
DI void xcd_barrier_complete(unsigned* bar, unsigned x, unsigned& nloc, unsigned& nx) {
    const unsigned G = gridDim.x;
    unsigned sum, cnt, mine, sp = 0u;
    for (;;) {
        sum = 0u; cnt = 0u; mine = 0u;
#pragma unroll
        for (unsigned j = 0; j < 16; ++j) { const unsigned c = xb_ld(&bar[XB_XCNT(j)]); sum += c; cnt += (c > 0u) ? 1u : 0u; mine = (j == x) ? c : mine; }
        if (sum == G) break;
        __builtin_amdgcn_s_sleep(1);
        if ((++sp & 255u) == 0u) { if (xb_ld(&bar[XB_TMO])) break; if (sp > XB_SPIN_CAP) { atomicAdd(&bar[XB_TMO], 1u); break; } }
    }
    nloc = mine > 0u ? mine : 1u; nx = cnt > 0u ? cnt : 1u;
}
DI void xcd_barrier(unsigned* bar, volatile LAS unsigned* st) {
    asm volatile("s_waitcnt vmcnt(0)" ::: "memory");
    __syncthreads();
    if (threadIdx.x == 0) {
        const unsigned x = xb_xcc_id();
        __builtin_amdgcn_s_waitcnt(0);
        unsigned nloc = st[0], nx = st[1];
        if (nloc == 0u) { xcd_barrier_complete(bar, x, nloc, nx); st[0] = nloc; st[1] = nx; }
        const unsigned old = xb_add(&bar[XB_XSUB(x)], 1u);
        const unsigned gen = old / nloc;
        if (old + 1u == (gen + 1u) * nloc) {
            __builtin_amdgcn_fence(__ATOMIC_RELEASE, "agent");
            asm volatile("s_waitcnt vmcnt(0)" ::: "memory");
            const unsigned og = xb_add(&bar[XB_TOP], 1u);
            const unsigned tg = og / nx;
            if (og + 1u == (tg + 1u) * nx) xb_add(&bar[XB_TOPGEN], 1u);
            else XB_SPIN(xb_ld(&bar[XB_TOPGEN]) == tg, bar);
            __builtin_amdgcn_fence(__ATOMIC_ACQUIRE, "agent");
            xb_add(&bar[XB_XGEN(x)], 1u);
            asm volatile("s_waitcnt vmcnt(0)" ::: "memory");
        } else {
            XB_SPIN(xb_ld(&bar[XB_XGEN(x)]) == gen, bar);
            __builtin_amdgcn_fence(__ATOMIC_ACQUIRE, "agent");
            asm volatile("s_waitcnt vmcnt(0)" ::: "memory");
        }
    }
    __syncthreads();
}

DI int launder_i_unused(int x) { asm volatile("" : "+s"(x)); return x; }

__global__ void __launch_bounds__(NTHR, 2) hybrid_fwd(Params p_unused) {
    extern __shared__ __attribute__((aligned(16))) unsigned char smem[];
    LAS unsigned char* lds = (LAS unsigned char*)smem;
    cg::grid_group grid = cg::this_grid();
    const int tid = threadIdx.x, wid = __builtin_amdgcn_readfirstlane(tid >> 6), lane = tid & 63;
    const int vb = blockIdx.x, G = gridDim.x;
    volatile LAS unsigned* xst = (volatile LAS unsigned*)(lds + LDS_BYTES - 16);
    { unsigned* bar0 = (unsigned*)(kparams().ws + WS_BAR); if (tid == 0) { xst[0] = 0u; xst[1] = 0u; (void)xb_add(&bar0[XB_XCNT(xb_xcc_id())], 1u); } }
    __syncthreads();

#if !(PHOFF & 1)
    for (int rep = 0; rep < REP_PREP; ++rep) { const Params p = kparams(); phase_prep(p, lds, tid, wid, lane, vb, G); }
#endif
    if (kparams().out == nullptr) grid.sync();
    GSYNC();

#pragma nounroll
    for (int l0 = 0; l0 < 2; ++l0) {
#if !(PHOFF & 2)
        for (int rep = 0; rep < REP_G1; ++rep) {
            const Params p = kparams(); const int l = launder_i(l0); unsigned char* ws = p.ws;
            gemm_all<FIn>(lds, (const bf16_t*)(ws + WS_YB), (const bf16_t*)(ws + WS_WIN) + (size_t)l * 1536 * 1024, NIN, 1024, l, 0, vb, G, tid);
        }
#endif
        GSYNC();
        for (int rep = 0; rep < REP_MIX; ++rep) {
            const int l = launder_i(l0);
            unsigned* qctr = (unsigned*)(kparams().ws + WS_QCTR) + 64 * l;
            int it = (G == 256) ? ((vb & 7) * 32 + (vb >> 3)) : vb;
            for (;;) {
                if (it >= 774) break;
#if !(PHOFF & 4)
                if (it < 256) for (int r2 = 0; r2 < REP_ATT; ++r2) { const Params p = kparams(); attn_item(p, l, it, lds, tid, wid, lane); }
#endif
#if !(PHOFF & 8)
                if (it >= 256 && it < 514) for (int r2 = 0; r2 < REP_RG; ++r2) { const Params p = kparams(); rglru_item(p, l, it - 256, lds, tid, wid, lane); }
#endif
#if !(PHOFF & 16)
                if (it >= 514 && it < 646) for (int r2 = 0; r2 < REP_POOL; ++r2) { const Params p = kparams(); pool_item(p, l, it - 514, lds, tid, wid, lane); }
#endif
#if !(PHOFF & 32)
                if (it >= 646) for (int r2 = 0; r2 < REP_SATT; ++r2) { const Params p = kparams(); sattn_item(p, l, it - 646, lds, tid, wid, lane); }
#endif
                if (tid == 0) xst[2] = G + xb_add(qctr, 1u);
                __syncthreads();
                it = __builtin_amdgcn_readfirstlane((int)xst[2]);
                __syncthreads();
            }
        }
        GSYNC();
#if !(PHOFF & 64)
        for (int rep = 0; rep < REP_FIX; ++rep) { const Params p = kparams(); const int l = launder_i(l0); for (int it = vb; it < 512; it += G) fixup_item(p, l, it, tid); }
#endif
        {
            const Params p = kparams(); const int l = launder_i(l0); unsigned char* ws = p.ws;
            const int tid2 = launder_v(tid), lane2 = tid2 & 63, gw = vb * 8 + (tid2 >> 6), NGW = G * 8;
            rowsum_rows((const bf16_t*)(ws + WS_W1) + (size_t)l * 4096 * 1024, p.ln1_g + l * 1024, p.ln1_b + l * 1024, 4096, (float*)(ws + WS_CS1) + l * 4096, (float*)(ws + WS_BW1) + l * 4096, gw, NGW, lane2);
            if (l == 0) rowsum_rows((const bf16_t*)(ws + WS_WIN) + (size_t)1536 * 1024, p.ln2_g, p.ln2_b, 1536, (float*)(ws + WS_CSIN) + 1536, (float*)(ws + WS_BWIN) + 1536, gw, NGW, lane2);
        }
        GSYNC();
#if !(PHOFF & 128)
        for (int rep = 0; rep < REP_G2; ++rep) {
            const Params p = kparams(); const int l = launder_i(l0); unsigned char* ws = p.ws;
#if REP_G2 > 1
            if (rep < REP_G2 - 1) gemm_all<FResT<true>>(lds, (const bf16_t*)(ws + WS_MIX), (const bf16_t*)(ws + WS_WOUT) + (size_t)l * 1024 * 1024, 1024, 1024, l, 0, vb, G, tid); else
#endif
            gemm_all<FRes>(lds, (const bf16_t*)(ws + WS_MIX), (const bf16_t*)(ws + WS_WOUT) + (size_t)l * 1024 * 1024, 1024, 1024, l, 0, vb, G, tid);
        }
#endif
        GSYNC();
#if !(PHOFF & 256)
        for (int rep = 0; rep < REP_G3; ++rep) {
            const Params p = kparams(); const int l = launder_i(l0); unsigned char* ws = p.ws;
            gemm_all<FFF1>(lds, (const bf16_t*)(ws + WS_YB), (const bf16_t*)(ws + WS_W1) + (size_t)l * 4096 * 1024, DFF, 1024, l, 0, vb, G, tid);
        }
#endif
        GSYNC();
#if !(PHOFF & 512)
        for (int rep = 0; rep < REP_G4; ++rep) {
            const Params p = kparams(); const int l = launder_i(l0); unsigned char* ws = p.ws;
#if REP_G4 > 1
            if (rep < REP_G4 - 1) gemm_all<FResT<true>>(lds, (const bf16_t*)(ws + WS_HID), (const bf16_t*)(ws + WS_W2) + (size_t)l * 1024 * 4096, 1024, 4096, l, 1, vb, G, tid); else
#endif
            gemm_all<FRes>(lds, (const bf16_t*)(ws + WS_HID), (const bf16_t*)(ws + WS_W2) + (size_t)l * 1024 * 4096, 1024, 4096, l, 1, vb, G, tid);
        }
#endif
        GSYNC();
    }
    { const Params p = kparams(); final_ln(p, vb, G, tid); }
}

extern "C" void kernel_launch(void* const* d_in, const int* in_sizes, int n_in, void* d_out, int out_size, void* d_ws, size_t ws_size, hipStream_t stream) {
    static int grid_blocks = 0;
    if (!grid_blocks) {
        int dev = 0, cus = 0, per_cu = 0;
        hipGetDevice(&dev);
        hipDeviceGetAttribute(&cus, hipDeviceAttributeMultiprocessorCount, dev);
        hipFuncSetAttribute((const void*)hybrid_fwd, hipFuncAttributeMaxDynamicSharedMemorySize, LDS_BYTES);
        hipOccupancyMaxActiveBlocksPerMultiprocessor(&per_cu, (const void*)hybrid_fwd, NTHR, LDS_BYTES);
        if (per_cu < 1) per_cu = 1;
        grid_blocks = cus * per_cu;
        if (ws_size < WS_END) fprintf(stderr, "kernel_launch: workspace too small: %zu < %zu\n", ws_size, (size_t)WS_END);
        fprintf(stderr, "kernel_launch: grid %d (cus %d x %d)\n", grid_blocks, cus, per_cu);
    }
    if (hipMemsetAsync((char*)d_ws + WS_BAR, 0, XCD_BAR_WORDS * 4 + 1024, stream) != hipSuccess) fprintf(stderr, "memset failed\n");
    Params p{};
    const float** pp = (const float**)&p;
    for (int i = 0; i < 25; ++i) pp[i] = (const float*)d_in[i];
    p.out = (float*)d_out; p.ws = (unsigned char*)d_ws;
    void* args[] = {&p};
    hipError_t e = hipLaunchCooperativeKernel((const void*)hybrid_fwd, dim3(grid_blocks), dim3(NTHR), args, LDS_BYTES, stream);
    if (e != hipSuccess) fprintf(stderr, "cooperative launch failed: %s (grid %d)\n", hipGetErrorString(e), grid_blocks);
}
```

```cpp
#include <hip/hip_runtime.h>
#include <hip/hip_cooperative_groups.h>
#include <cstdio>
namespace cg = cooperative_groups;

#define LAS __attribute__((address_space(3)))
typedef unsigned short bf16_t;
typedef short bf16x8 __attribute__((ext_vector_type(8)));
typedef float f32x4 __attribute__((ext_vector_type(4)));
typedef float f32x2 __attribute__((ext_vector_type(2)));
typedef unsigned u32x4 __attribute__((ext_vector_type(4)));
typedef unsigned u32x2 __attribute__((ext_vector_type(2)));
#define DI __device__ __forceinline__
#ifndef PHOFF
#define PHOFF 0
#endif
#ifndef REP_SYNC
#define REP_SYNC 1
#endif
#ifndef REP_MIX
#define REP_MIX 1
#endif
#ifndef REP_G3
#define REP_G3 1
#endif
#ifndef REP_PREP
#define REP_PREP 1
#endif
#ifndef REP_FIX
#define REP_FIX 1
#endif
#ifndef REP_ATT
#define REP_ATT 1
#endif
#ifndef REP_RG
#define REP_RG 1
#endif
#ifndef REP_POOL
#define REP_POOL 1
#endif
#ifndef REP_SATT
#define REP_SATT 1
#endif
#ifndef REP_G2
#define REP_G2 1
#endif
#ifndef REP_G4
#define REP_G4 1
#endif
#ifndef REP_G1
#define REP_G1 1
#endif
#define GSYNC() do { for (int _r = 0; _r < REP_SYNC; ++_r) { unsigned* _bar = (unsigned*)(kparams().ws + WS_BAR); xcd_barrier(_bar, xst); } } while (0)

constexpr int DM = 1024, TP = 16384, TS = 128, MT = TP + TS, NIN = 1536, DFF = 4096;
constexpr int NTHR = 512;
constexpr float LOG2E = 1.4426950408889634f;
constexpr float ALPHA = 1.4142135623730951f;
constexpr float QSCALE = 0.125f * 1.4426950408889634f;
constexpr float LN_EPS = 1e-5f;
constexpr size_t O_YP = 0, O_YS = 16777216, O_PK = 16908288, O_PV = 17039360, O_PH = 17170432, O_PC = 17172480, O_PP = 17178624,
                 O_SK = 17209344, O_SV = 21403648, O_SH = 25597952, O_SC = 25663488, O_SP = 25860096;
constexpr size_t WS_WIN = 0;
constexpr size_t WS_WOUT = WS_WIN + 2ull * 1536 * 1024 * 2;
constexpr size_t WS_W1 = WS_WOUT + 2ull * 1024 * 1024 * 2;
constexpr size_t WS_W2 = WS_W1 + 2ull * 4096 * 1024 * 2;
constexpr size_t WS_YB = WS_W2 + 2ull * 4096 * 1024 * 2;
constexpr size_t WS_MIX = WS_YB + (size_t)MT * 1024 * 2;
constexpr size_t WS_HID = WS_MIX + (size_t)MT * 1024 * 2;
constexpr size_t WS_QKV = WS_HID;
constexpr size_t WS_U2 = WS_QKV + (size_t)MT * 768 * 2;
constexpr size_t WS_HL = WS_U2 + (size_t)MT * 768 * 4;
constexpr size_t WS_CA = WS_HL + (size_t)TP * 256 * 4;
constexpr size_t WS_ST1 = WS_HID + (size_t)MT * 4096 * 2;
constexpr size_t WS_ST2 = WS_ST1 + (size_t)MT * 32 * 4;
constexpr size_t WS_CSIN = WS_ST2 + (size_t)MT * 32 * 4;
constexpr size_t WS_BWIN = WS_CSIN + 2 * 1536 * 4;
constexpr size_t WS_CS1 = WS_BWIN + 2 * 1536 * 4;
constexpr size_t WS_BW1 = WS_CS1 + 2 * 4096 * 4;
constexpr size_t WS_GAT = WS_BW1 + 2 * 4096 * 4;
constexpr size_t WS_GXT = WS_GAT + 2 * 4 * 64 * 64 * 2;
constexpr size_t WS_PWT = WS_GXT + 2 * 4 * 64 * 64 * 2;
constexpr size_t WS_AGA = WS_PWT + 2 * 4 * 64 * 64 * 2;
constexpr size_t WS_AGB = WS_AGA + 128 * 256 * 4;
constexpr size_t WS_STS1 = WS_AGB + 128 * 256 * 4;
constexpr size_t WS_STS2 = WS_STS1 + 128 * 128 * 4;
constexpr size_t WS_BAR = WS_STS2 + 128 * 128 * 4;
constexpr size_t WS_QCTR = WS_BAR + 3456 * 4;
constexpr size_t WS_END = WS_QCTR + 1024;
static_assert(WS_CA + (size_t)TP * 256 * 4 <= WS_ST1, "alias region overflow");
static_assert(WS_END <= 268435456ull, "workspace budget");
constexpr int LDS_BYTES = 163840;

struct Params {
    const float* xp; const float* xs; const float* ck; const float* cv; const float* sh; const float* sc; const float* spool;
    const float* w_in; const float* sinks; const float* conv_w; const float* conv_b; const float* ga_w; const float* ga_b; const float* gx_w; const float* gx_b; const float* lam;
    const float* pool_w; const float* pool_scale; const float* w_out; const float* ln1_g; const float* ln1_b; const float* w_ff1; const float* w_ff2; const float* ln2_g; const float* ln2_b;
    float* out; unsigned char* ws;
};

DI unsigned pk2(float lo, float hi) { unsigned r; asm volatile("v_cvt_pk_bf16_f32 %0, %1, %2" : "=v"(r) : "v"(lo), "v"(hi)); return r; }
DI float bf2f(bf16_t b) { return __uint_as_float(((unsigned)b) << 16); }
DI float bfround(float x) { return __uint_as_float(pk2(x, 0.f) << 16); }
DI f32x4 mfma16(bf16x8 a, bf16x8 b, f32x4 c) { return __builtin_amdgcn_mfma_f32_16x16x32_bf16(a, b, c, 0, 0, 0); }
DI int launder_v(int x) { asm volatile("" : "+v"(x)); return x; }
DI int launder_i(int x) { asm volatile("" : "+s"(x)); return x; }
#define RELAUNDER() do { tid = launder_v(tid); lane = tid & 63; wid = __builtin_amdgcn_readfirstlane(tid >> 6); } while (0)
DI void lds_wait() { asm volatile("s_waitcnt lgkmcnt(0)" ::: "memory"); }
DI float sigmoidf_(float x) { return 1.0f / (1.0f + __expf(-x)); }
DI float gelu_tanh(float x) { const float u = 0.7978845608028654f * (x + 0.044715f * x * x * x); return x * __builtin_amdgcn_rcpf(1.0f + __builtin_amdgcn_exp2f(-2.0f * 1.4426950408889634f * u)); }
DI bf16x8 pack8(f32x4 lo, f32x4 hi) { u32x4 w; w.x = pk2(lo.x, lo.y); w.y = pk2(lo.z, lo.w); w.z = pk2(hi.x, hi.y); w.w = pk2(hi.z, hi.w); return __builtin_bit_cast(bf16x8, w); }
DI f32x4 ld_bf4_nt(const bf16_t* p) { const u32x2 w = __builtin_nontemporal_load((const u32x2*)p); return (f32x4){__uint_as_float(w.x << 16), __uint_as_float(w.x & 0xffff0000u), __uint_as_float(w.y << 16), __uint_as_float(w.y & 0xffff0000u)}; }
DI f32x4 ld_bf4(const bf16_t* p) { const u32x2 w = *(const u32x2*)p; return (f32x4){__uint_as_float(w.x << 16), __uint_as_float(w.x & 0xffff0000u), __uint_as_float(w.y << 16), __uint_as_float(w.y & 0xffff0000u)}; }
DI void st_bf4(bf16_t* dst, f32x4 v) { u32x2 w; w.x = pk2(v.x, v.y); w.y = pk2(v.z, v.w); *(u32x2*)dst = w; }

namespace pg8 {
constexpr int BM = 256, BK = 64, HALF = 128, HTB = HALF * BK * 2, STAGE_BYTES = 8 * HTB, NXCD = 8, WGM = 8;
DI int lds_byte(int r, int c) { const int st = (r >> 4) * 2 + (c >> 5), rr = r & 15, cc = c & 31, ob = rr * 64 + cc * 2; return st * 1024 + (ob ^ (((ob >> 9) & 1) << 5)); }
DI void stage_rc(int b, int& R, int& C) { const int st = b / 1024, sb = b % 1024, swz = sb ^ (((sb >> 9) & 1) << 5); R = (st >> 1) * 16 + swz / 64; C = (st & 1) * 32 + (swz % 64) / 2; }
DI int perm32(int rho) { const int n = rho >> 4, i = rho & 15; return 8 * (i >> 2) + 4 * n + (i & 3); }
struct Unit { int pm, pn; };
struct Gemm { const bf16_t* A; const bf16_t* Bt; int M, N, K; };
struct StaticOrder {
    int nM, nN, nwg, G, c;
    DI void init(int M, int N, int G_, int c_) { nM = M / BM; nN = N / BM; nwg = nM * nN; G = G_; c = c_; }
    DI bool next(int i, Unit& u) const {
        const long L = (long)i * G + c; if (L >= nwg) return false;
        int wgid = (int)L; { const int q = nwg / NXCD, r = nwg % NXCD, xcd = wgid % NXCD, off = wgid / NXCD; wgid = (xcd < r ? xcd * (q + 1) : r * (q + 1) + (xcd - r) * q) + off; }
        const int nig = WGM * nN, gid = wgid / nig, fm = gid * WGM, gsz = (nM - fm) < WGM ? (nM - fm) : WGM;
        u.pm = fm + ((wgid % nig) % gsz); u.pn = (wgid % nig) / gsz; return true;
    }
};

template <class Epi>
DI void gemm_phase(LAS unsigned char* lds, const Gemm g, const StaticOrder& S, const Epi& E, int tid) {
    const int wid = __builtin_amdgcn_readfirstlane(tid >> 6), lane = tid & 63, wr = wid >> 2, wc = wid & 3, fr = lane & 15, fq = lane >> 4;
    const int K = g.K, nt = K / BK;
    unsigned voffA[2], voffB[2];
#pragma unroll
    for (int i = 0; i < 2; ++i) { int R, C; stage_rc(tid * 16 + i * 8192, R, C); const int Rb = (R & ~31) + perm32(R & 31); voffA[i] = (unsigned)(R * K + C) * 2u; voffB[i] = (unsigned)(Rb * K + C) * 2u; }
    const size_t kstep = (size_t)(BK * 2);
    const size_t hstep = (size_t)HALF * K * 2;
    const size_t tstep = 2 * hstep;
    const unsigned ldsw = (unsigned)wid * 1024u;
    const int aoff = lds_byte(wr * 64 + fr, fq * 8), boff = lds_byte(wc * 32 + fr, fq * 8);
#define PG8_SA(b, h) (((b) * 2 + (h)) * HTB)
#define PG8_SB(b, h) ((4 + (b) * 2 + (h)) * HTB)
#define PG8_STAGE(bufoff, gbase, voff) do { _Pragma("unroll") for (int _i = 0; _i < 2; ++_i) \
        __builtin_amdgcn_global_load_lds((const unsigned*)((const char*)(gbase) + (voff)[_i]), (LAS unsigned*)(lds + (bufoff) + ldsw + _i * 8192), 16, 0, 0); } while (0)
#define PG8_LDA(dst, b, h) do { _Pragma("unroll") for (int m = 0; m < 4; ++m) _Pragma("unroll") for (int k = 0; k < 2; ++k) dst[m][k] = *(const LAS bf16x8*)(lds + PG8_SA(b, h) + aoff + m * 2048 + k * 1024); } while (0)
#define PG8_LDB(dst, b, h) do { _Pragma("unroll") for (int n = 0; n < 2; ++n) _Pragma("unroll") for (int k = 0; k < 2; ++k) dst[n][k] = *(const LAS bf16x8*)(lds + PG8_SB(b, h) + boff + n * 2048 + k * 1024); } while (0)
#define PG8_MMA(ai, bj, At, Bt) do { __builtin_amdgcn_s_setprio(1); _Pragma("unroll") for (int m = 0; m < 4; ++m) _Pragma("unroll") for (int n = 0; n < 2; ++n) _Pragma("unroll") for (int k = 0; k < 2; ++k) \
        acc[ai][bj][m][n] = __builtin_amdgcn_mfma_f32_16x16x32_bf16(Bt[n][k], At[m][k], acc[ai][bj][m][n], 0, 0, 0); __builtin_amdgcn_s_setprio(0); } while (0)
#define PG8_WAIT_V(n) asm volatile("s_waitcnt vmcnt(" #n ")" ::: "memory")
#define PG8_WAIT_L(n) asm volatile("s_waitcnt lgkmcnt(" #n ")" ::: "memory")
#define PG8_BAR __builtin_amdgcn_s_barrier()
#define PG8_SCHED __builtin_amdgcn_sched_barrier(0)
    Unit cur, nxt; int ui = 0;
    if (!S.next(0, cur)) return;
    f32x4 acc[2][2][4][2];
#pragma unroll
    for (int a = 0; a < 2; ++a)
#pragma unroll
        for (int b = 0; b < 2; ++b)
#pragma unroll
            for (int m = 0; m < 4; ++m)
#pragma unroll
                for (int n = 0; n < 2; ++n) acc[a][b][m][n] = (f32x4){0.f, 0.f, 0.f, 0.f};
    bf16x8 At[4][2], B0[2][2], B1[2][2];
    const char* cA = (const char*)g.A + (size_t)cur.pm * tstep; const char* cB = (const char*)g.Bt + (size_t)cur.pn * tstep;
    PG8_STAGE(PG8_SB(0, 0), cB, voffB); PG8_STAGE(PG8_SA(0, 0), cA, voffA); PG8_STAGE(PG8_SB(0, 1), cB + hstep, voffB); PG8_STAGE(PG8_SA(0, 1), cA + hstep, voffA);
    if (wr == 1) PG8_BAR;
    PG8_WAIT_V(4); PG8_BAR;
    PG8_STAGE(PG8_SB(1, 0), cB + kstep, voffB); PG8_STAGE(PG8_SA(1, 0), cA + kstep, voffA); PG8_STAGE(PG8_SB(1, 1), cB + hstep + kstep, voffB);
    PG8_WAIT_V(6); PG8_BAR;
    for (;;) {
        const bool has_next = S.next(ui + 1, nxt);
        const char* nA = has_next ? (const char*)g.A + (size_t)nxt.pm * tstep : cA; const char* nB = has_next ? (const char*)g.Bt + (size_t)nxt.pn * tstep : cB;
        for (int t = 0; t < nt; t += 2) {
            const bool last = (t == nt - 2);
            const char* a1 = cA + (size_t)(t + 1) * kstep;
            const char* a2 = last ? nA : cA + (size_t)(t + 2) * kstep; const char* b2 = last ? nB : cB + (size_t)(t + 2) * kstep;
            const char* a3 = a2 + kstep; const char* b3 = b2 + kstep;
            PG8_LDB(B0, 0, 0); PG8_SCHED; PG8_LDA(At, 0, 0); PG8_STAGE(PG8_SA(1, 1), a1 + hstep, voffA);
            PG8_WAIT_L(8); PG8_BAR; PG8_WAIT_L(0); PG8_MMA(0, 0, At, B0); PG8_BAR; PG8_SCHED;
            PG8_LDB(B1, 0, 1); PG8_STAGE(PG8_SB(0, 0), b2, voffB);
            PG8_BAR; PG8_WAIT_L(0); PG8_MMA(0, 1, At, B1); PG8_BAR;
            PG8_LDA(At, 0, 1); PG8_STAGE(PG8_SA(0, 0), a2, voffA);
            PG8_BAR; PG8_WAIT_L(0); PG8_MMA(1, 0, At, B0); PG8_BAR; PG8_SCHED;
            PG8_STAGE(PG8_SB(0, 1), b2 + hstep, voffB);
            PG8_WAIT_V(6); PG8_BAR; PG8_MMA(1, 1, At, B1); PG8_BAR;
            PG8_LDB(B0, 1, 0); PG8_SCHED; PG8_LDA(At, 1, 0); PG8_STAGE(PG8_SA(0, 1), a2 + hstep, voffA);
            PG8_WAIT_L(8); PG8_BAR; PG8_WAIT_L(0); PG8_MMA(0, 0, At, B0); PG8_BAR; PG8_SCHED;
            PG8_LDB(B1, 1, 1); PG8_STAGE(PG8_SB(1, 0), b3, voffB);
            PG8_BAR; PG8_WAIT_L(0); PG8_MMA(0, 1, At, B1); PG8_BAR;
            PG8_LDA(At, 1, 1); PG8_STAGE(PG8_SA(1, 0), a3, voffA);
            PG8_BAR; PG8_WAIT_L(0); PG8_MMA(1, 0, At, B0); PG8_BAR; PG8_SCHED;
            PG8_STAGE(PG8_SB(1, 1), b3 + hstep, voffB);
            PG8_WAIT_V(6); PG8_BAR; PG8_MMA(1, 1, At, B1); PG8_BAR;
        }
        E(acc, cur, ui, wr, wc, fr, fq);
        if (!has_next) break;
#pragma unroll
        for (int a = 0; a < 2; ++a)
#pragma unroll
            for (int b = 0; b < 2; ++b)
#pragma unroll
                for (int m = 0; m < 4; ++m)
#pragma unroll
                    for (int n = 0; n < 2; ++n) acc[a][b][m][n] = (f32x4){0.f, 0.f, 0.f, 0.f};
        cur = nxt; cA = nA; cB = nB; ++ui;
    }
    PG8_WAIT_V(0);
    if (wr == 0) PG8_BAR;
    PG8_BAR;
#undef PG8_SA
#undef PG8_SB
#undef PG8_STAGE
#undef PG8_LDA
#undef PG8_LDB
#undef PG8_MMA
#undef PG8_WAIT_V
#undef PG8_WAIT_L
#undef PG8_BAR
#undef PG8_SCHED
}
}

typedef const __attribute__((address_space(4))) Params* KParamsPtr;
DI Params kparams() {
#if defined(__HIP_DEVICE_COMPILE__)
    const __attribute__((address_space(4))) char* q = (const __attribute__((address_space(4))) char*)__builtin_amdgcn_kernarg_segment_ptr();
    asm volatile("" : "+s"(q));
    KParamsPtr kp = (KParamsPtr)q;
    Params r;
    r.xp = kp->xp; r.xs = kp->xs; r.ck = kp->ck; r.cv = kp->cv; r.sh = kp->sh; r.sc = kp->sc; r.spool = kp->spool;
    r.w_in = kp->w_in; r.sinks = kp->sinks; r.conv_w = kp->conv_w; r.conv_b = kp->conv_b; r.ga_w = kp->ga_w; r.ga_b = kp->ga_b; r.gx_w = kp->gx_w; r.gx_b = kp->gx_b; r.lam = kp->lam;
    r.pool_w = kp->pool_w; r.pool_scale = kp->pool_scale; r.w_out = kp->w_out; r.ln1_g = kp->ln1_g; r.ln1_b = kp->ln1_b; r.w_ff1 = kp->w_ff1; r.w_ff2 = kp->w_ff2; r.ln2_g = kp->ln2_g; r.ln2_b = kp->ln2_b;
    r.out = kp->out; r.ws = kp->ws;
    return r;
#else
    return Params{};
#endif
}

struct RowCtx { float mu, rstd; };
DI void row_stats(const float* part, int row, int fq, float& mu, float& rstd) {
    const f32x4* p = (const f32x4*)(part + (size_t)row * 32 + fq * 8);
    const f32x4 a = p[0], b = p[1];
    float s = (a.x + a.z) + (b.x + b.z), ss = (a.y + a.w) + (b.y + b.w);
    s += __shfl_xor(s, 16); s += __shfl_xor(s, 32); ss += __shfl_xor(ss, 16); ss += __shfl_xor(ss, 32);
    mu = s * (1.0f / 1024.0f); const float var = ss * (1.0f / 1024.0f) - mu * mu; rstd = rsqrtf(fmaxf(var, 0.f) + LN_EPS);
}

DI void row_stats_s(const float* part_s, int srow, int fq, float& mu, float& rstd) {
    const f32x4* p = (const f32x4*)(part_s + (size_t)srow * 128 + fq * 32);
    float s = 0.f, ss = 0.f;
#pragma unroll
    for (int i = 0; i < 8; ++i) { const f32x4 a = p[i]; s += a.x + a.z; ss += a.y + a.w; }
    s += __shfl_xor(s, 16); s += __shfl_xor(s, 32); ss += __shfl_xor(ss, 16); ss += __shfl_xor(ss, 32);
    mu = s * (1.0f / 1024.0f); const float var = ss * (1.0f / 1024.0f) - mu * mu; rstd = rsqrtf(fmaxf(var, 0.f) + LN_EPS);
}
DI void row_stats_any(const float* part, const float* part_s, int row, int fq, float& mu, float& rstd) {
    if (row < TP) row_stats(part, row, fq, mu, rstd); else row_stats_s(part_s, row - TP, fq, mu, rstd);
}

struct ColCtx { f32x4 a, b; };
DI void st_bf8(bf16_t* dst, f32x4 v0, f32x4 v1) { u32x4 w; w.x = pk2(v0.x, v0.y); w.y = pk2(v0.z, v0.w); w.z = pk2(v1.x, v1.y); w.w = pk2(v1.z, v1.w); *(u32x4*)dst = w; }
struct FIn {
    static constexpr bool STATS = false, PRELOAD = false, DEFERRED_PREP = true, STAGGER = false;
    const float* part; const float* part_s; const float* cs; const float* bw; int fold; int layer; bf16_t* QKV; bf16_t* U2; float* out; float* part_out; float* part_out_s;
    DI bool is_dry() const { return false; }
    DI const float* stats_src() const { return fold ? part : nullptr; }
    static DI FIn make(const Params& p, int l, int) { unsigned char* ws = p.ws;
        return FIn{(const float*)(ws + WS_ST2), (const float*)(ws + WS_STS2), (const float*)(ws + WS_CSIN) + l * 1536, (const float*)(ws + WS_BWIN) + l * 1536, l, l, (bf16_t*)(ws + WS_QKV), (bf16_t*)(ws + WS_U2), p.out, nullptr, nullptr}; }
    template <bool SMP> DI RowCtx row_begin(int row, int fq) const { RowCtx r{0.f, 1.f}; if (fold) { if (SMP) row_stats_s(part_s, row - TP, fq, r.mu, r.rstd); else row_stats(part, row, fq, r.mu, r.rstd); } return r; }
    DI ColCtx col_begin(int col) const { ColCtx c; c.a = *(const f32x4*)(cs + col); c.b = *(const f32x4*)(bw + col); return c; }
    DI f32x4 row_load8(int, int) const { return (f32x4){0.f, 0.f, 0.f, 0.f}; }
    DI f32x4 row_load4(int, int) const { return (f32x4){0.f, 0.f, 0.f, 0.f}; }
    DI f32x4 compute(int, int col, f32x4 a, const RowCtx& rc, const ColCtx& cc, float, float) const {
        f32x4 v = a;
        if (fold) v = (a - rc.mu * cc.a) * rc.rstd + cc.b;
        return v;
    }
    DI float* kv_dst(int row, int col) const {
        float* dst = nullptr; const int c7 = (col - 512) & 127; const bool isk = col < 640;
        if (row < TP) { const int t = row & 4095; if (t >= 3968) dst = out + (isk ? O_PK : O_PV) + ((size_t)((layer * 4 + (row >> 12)) * 128 + (t - 3968))) * 128 + c7; }
        else { dst = out + (isk ? O_SK : O_SV) + ((size_t)((layer * 128 + (row - TP)) * 128 + 127)) * 128 + c7; }
        return dst;
    }
    DI void store8(int row, int col, f32x4 v0, f32x4 v1) const {
        if (col < 512) st_bf8(QKV + (size_t)row * 768 + col, v0 * QSCALE, v1 * QSCALE);
        else if (col < 768) { st_bf8(QKV + (size_t)row * 768 + col, v0, v1); float* dst = kv_dst(row, col); if (dst) { *(f32x4*)dst = v0; *(f32x4*)(dst + 4) = v1; } }
        else st_bf8(U2 + (size_t)row * 768 + (col - 768), v0, v1);
    }
    DI void store4(int row, int col, f32x4 v) const {
        if (col < 512) st_bf4(QKV + (size_t)row * 768 + col, v * QSCALE);
        else if (col < 768) { st_bf4(QKV + (size_t)row * 768 + col, v); float* dst = kv_dst(row, col); if (dst) *(f32x4*)dst = v; }
        else st_bf4(U2 + (size_t)row * 768 + (col - 768), v);
    }
};
struct FFF1 {
    static constexpr bool STATS = false, PRELOAD = false, DEFERRED_PREP = false, STAGGER = true;
    const float* part; const float* part_s; const float* cs; const float* bw; bf16_t* HID; float* part_out; float* part_out_s;
    DI bool is_dry() const { return false; }
    DI const float* stats_src() const { return part; }
    static DI FFF1 make(const Params& p, int l, int) { unsigned char* ws = p.ws;
        return FFF1{(const float*)(ws + WS_ST1), (const float*)(ws + WS_STS1), (const float*)(ws + WS_CS1) + l * 4096, (const float*)(ws + WS_BW1) + l * 4096, (bf16_t*)(ws + WS_HID), nullptr, nullptr}; }
    template <bool SMP> DI RowCtx row_begin(int row, int fq) const { RowCtx r; if (SMP) row_stats_s(part_s, row - TP, fq, r.mu, r.rstd); else row_stats(part, row, fq, r.mu, r.rstd); return r; }
    DI ColCtx col_begin(int col) const { ColCtx c; c.a = *(const f32x4*)(cs + col); c.b = *(const f32x4*)(bw + col); return c; }
    DI f32x4 row_load8(int, int) const { return (f32x4){0.f, 0.f, 0.f, 0.f}; }
    DI f32x4 row_load4(int, int) const { return (f32x4){0.f, 0.f, 0.f, 0.f}; }
    DI f32x4 compute(int, int, f32x4 a, const RowCtx& rc, const ColCtx& cc, float, float) const {
        f32x4 v = (a - rc.mu * cc.a) * rc.rstd + cc.b;
        v.x = fmaxf(v.x, 0.f); v.y = fmaxf(v.y, 0.f); v.z = fmaxf(v.z, 0.f); v.w = fmaxf(v.w, 0.f); return v * v;
    }
    DI void store8(int row, int col, f32x4 v0, f32x4 v1) const { st_bf8(HID + (size_t)row * 4096 + col, v0, v1); }
    DI void store4(int row, int col, f32x4 v) const { st_bf4(HID + (size_t)row * 4096 + col, v); }
};
template <bool DRY> struct FResT {
    static constexpr bool STATS = true, PRELOAD = true, DEFERRED_PREP = false, STAGGER = false;
    int raw; const float* part; const float* part_s; const float* g; const float* b; float* Y; bf16_t* YB; float* part_out; float* part_out_s;
    static DI FResT make(const Params& p, int l, int which) { unsigned char* ws = p.ws;
        if (which == 0) return FResT{l == 0 ? 1 : 0, (const float*)(ws + WS_ST2), (const float*)(ws + WS_STS2), p.ln2_g, p.ln2_b, nullptr, (bf16_t*)(ws + WS_YB), (float*)(ws + WS_ST1), (float*)(ws + WS_STS1)};
        return FResT{0, (const float*)(ws + WS_ST1), (const float*)(ws + WS_STS1), p.ln1_g + l * 1024, p.ln1_b + l * 1024, nullptr, (bf16_t*)(ws + WS_YB), (float*)(ws + WS_ST2), (float*)(ws + WS_STS2)}; }
    DI bool is_dry() const { return DRY; }
    DI const float* stats_src() const { return raw ? nullptr : part; }
    template <bool SMP> DI RowCtx row_begin(int row, int fq) const { RowCtx r{0.f, 1.f}; if (!raw) { if (SMP) row_stats_s(part_s, row - TP, fq, r.mu, r.rstd); else row_stats(part, row, fq, r.mu, r.rstd); } return r; }
    DI ColCtx col_begin(int col) const { ColCtx c; c.a = *(const f32x4*)(g + col); c.b = *(const f32x4*)(b + col); return c; }
    DI f32x4 row_load8(int row, int col) const { const u32x4 w = *(const u32x4*)(YB + (size_t)row * 1024 + col); return __builtin_bit_cast(f32x4, w); }
    DI f32x4 row_load4(int row, int col) const { const u32x2 w = *(const u32x2*)(YB + (size_t)row * 1024 + col); return (f32x4){__uint_as_float(w.x), __uint_as_float(w.y), 0.f, 0.f}; }
    DI f32x4 compute(int, int, f32x4 a, const RowCtx& rc, const ColCtx& cc, float p0, float p1) const {
        const unsigned w0 = __float_as_uint(p0), w1 = __float_as_uint(p1);
        const f32x4 x = (f32x4){__uint_as_float(w0 << 16), __uint_as_float(w0 & 0xffff0000u), __uint_as_float(w1 << 16), __uint_as_float(w1 & 0xffff0000u)};
        const f32x4 r = raw ? x : ((x - rc.mu) * rc.rstd * cc.a + cc.b);
        return ALPHA * r + a;
    }
    DI void store8(int row, int col, f32x4 v0, f32x4 v1) const {
        if (!DRY) { st_bf8(YB + (size_t)row * 1024 + col, v0, v1); if (Y) { float* d = Y + (size_t)row * 1024 + col; *(f32x4*)d = v0; *(f32x4*)(d + 4) = v1; } }
    }
    DI void store4(int row, int col, f32x4 v) const {
        if (!DRY) { st_bf4(YB + (size_t)row * 1024 + col, v); if (Y) *(f32x4*)(Y + (size_t)row * 1024 + col) = v; }
    }
};
typedef FResT<false> FRes;

constexpr int STAT_TAB_OFF = 131072;
template <class F> struct EpiWrap {
    int l, which; LAS unsigned char* lds;
    DI void operator()(const f32x4 (&acc)[2][2][4][2], const pg8::Unit& u, int ui, int wr, int wc, int fr, int fq) const {
        const Params p = kparams();
        const F f = F::make(p, launder_i(l), which);
        const bool has_stats = f.stats_src() != nullptr;
        const LAS f32x2* tab = (const LAS f32x2*)(lds + STAT_TAB_OFF) + ui * 256 + wr * 64 + fr;
        const int rbase = u.pm * 256 + wr * 64 + fr, cbase = u.pn * 256 + wc * 32 + 8 * fq;
        ColCtx cc[2][2];
#pragma unroll
        for (int bj = 0; bj < 2; ++bj)
#pragma unroll
            for (int n = 0; n < 2; ++n) cc[bj][n] = f.col_begin(cbase + bj * 128 + 4 * n);
#pragma unroll
        for (int ai = 0; ai < 2; ++ai) {
            RowCtx rc[4]; float s[4], ss[4];
#pragma unroll
            for (int m = 0; m < 4; ++m) { const f32x2 t = has_stats ? tab[ai * 128 + m * 16] : (f32x2){0.f, 1.f}; rc[m].mu = t.x; rc[m].rstd = t.y; s[m] = 0.f; ss[m] = 0.f; }
#pragma unroll
            for (int bj = 0; bj < 2; ++bj) {
                const int col8 = cbase + bj * 128;
                f32x4 pre, nxt = f.row_load8(rbase + ai * 128, col8);
#pragma unroll
                for (int m = 0; m < 4; ++m) {
                    const int row = rbase + ai * 128 + m * 16;
                    pre = nxt;
                    if (F::PRELOAD && m < 3) nxt = f.row_load8(row + 16, col8);
                    const f32x4 y0 = f.compute(row, col8, acc[ai][bj][m][0], rc[m], cc[bj][0], pre.x, pre.y);
                    const f32x4 y1 = f.compute(row, col8 + 4, acc[ai][bj][m][1], rc[m], cc[bj][1], pre.z, pre.w);
                    if (F::STATS) { s[m] += ((y0.x + y0.y) + (y0.z + y0.w)) + ((y1.x + y1.y) + (y1.z + y1.w));
                        ss[m] += ((y0.x * y0.x + y0.y * y0.y) + (y0.z * y0.z + y0.w * y0.w)) + ((y1.x * y1.x + y1.y * y1.y) + (y1.z * y1.z + y1.w * y1.w)); }
                    f.store8(row, col8, y0, y1);
                }
            }
            if (F::STATS) {
#pragma unroll
                for (int m = 0; m < 4; ++m) {
                    float a = s[m], b = ss[m];
                    a += __shfl_xor(a, 16); a += __shfl_xor(a, 32); b += __shfl_xor(b, 16); b += __shfl_xor(b, 32);
                    if (fq == 0 && !f.is_dry()) *(f32x2*)(f.part_out + (size_t)(rbase + ai * 128 + m * 16) * 32 + (u.pn * 4 + wc) * 2) = (f32x2){a, b};
                }
            }
        }
    }
};

template <class F>
DI void sgemm_unit(LAS unsigned char* lds, const bf16_t* A, const bf16_t* Wt, int K, int col0, const F& f, int wid, int lane) {
    const int fr = lane & 15, fq = lane >> 4;
    const int kw = K >> 3;
    const bf16_t* ap = A + (size_t)fr * K + wid * kw + 8 * fq;
    const bf16_t* wp = Wt + (size_t)(col0 + fr) * K + wid * kw + 8 * fq;
    const int row = TP + wid * 16 + fr;
    const RowCtx rc = f.template row_begin<true>(row, fq);
    const ColCtx cc = f.col_begin(col0 + 4 * fq);
    const f32x4 pre = f.row_load4(row, col0 + 4 * fq);
    f32x4 acc[8];
#pragma unroll
    for (int i = 0; i < 8; ++i) acc[i] = (f32x4){0.f, 0.f, 0.f, 0.f};
#pragma unroll 2
    for (int k = 0; k < kw; k += 32) {
        const bf16x8 w = *(const bf16x8*)(wp + k);
#pragma unroll
        for (int mt = 0; mt < 8; ++mt) { const bf16x8 a = *(const bf16x8*)(ap + (size_t)mt * 16 * K + k); acc[mt] = mfma16(w, a, acc[mt]); }
    }
    LAS f32x4* red = (LAS f32x4*)lds;
#pragma unroll
    for (int mt = 0; mt < 8; ++mt) red[(wid * 8 + mt) * 64 + lane] = acc[mt];
    __syncthreads();
    f32x4 tot = (f32x4){0.f, 0.f, 0.f, 0.f};
#pragma unroll
    for (int s = 0; s < 8; ++s) tot += red[(s * 8 + wid) * 64 + lane];
    const f32x4 y = f.compute(row, col0 + 4 * fq, tot, rc, cc, pre.x, pre.y);
    f.store4(row, col0 + 4 * fq, y);
    if (F::STATS) {
        float s = (y.x + y.y) + (y.z + y.w), ss = (y.x * y.x + y.y * y.y) + (y.z * y.z + y.w * y.w);
        s += __shfl_xor(s, 16); s += __shfl_xor(s, 32); ss += __shfl_xor(ss, 16); ss += __shfl_xor(ss, 32);
        if (fq == 0 && !f.is_dry()) *(f32x2*)(f.part_out_s + (size_t)(row - TP) * 128 + (col0 >> 4) * 2) = (f32x2){s, ss};
    }
    __syncthreads();
}

DI void prep_deferred(const Params& p, int slot, LAS unsigned char* lds, int tid, int widx, int NW);
template <class F>
DI void gemm_all(LAS unsigned char* lds, const bf16_t* A, const bf16_t* Wt, int N, int K, int l, int which, int vb, int G, int tid) {
    int wid, lane; RELAUNDER();
    pg8::Gemm g{A, Wt, TP, N, K}; pg8::StaticOrder S; S.init(TP, N, G, vb);
    {
        const Params p = kparams();
        const F f = F::make(p, launder_i(l), which);
        const float* part = f.stats_src();
        if (part) {
            LAS f32x2* tab = (LAS f32x2*)(lds + STAT_TAB_OFF);
            const int r = tid >> 1, hlf = tid & 1;
            f32x4 v[4][4]; bool ok[4];
#pragma unroll
            for (int i = 0; i < 4; ++i) { pg8::Unit u; ok[i] = S.next(i, u); const int row = (ok[i] ? u.pm : 0) * 256 + r;
                const f32x4* pp = (const f32x4*)(part + (size_t)row * 32 + hlf * 16);
#pragma unroll
                for (int j = 0; j < 4; ++j) v[i][j] = pp[j]; }
#pragma unroll
            for (int i = 0; i < 4; ++i) {
                float s = 0.f, ss = 0.f;
#pragma unroll
                for (int j = 0; j < 4; ++j) { s += v[i][j].x + v[i][j].z; ss += v[i][j].y + v[i][j].w; }
                s += __shfl_xor(s, 1); ss += __shfl_xor(ss, 1);
                const float mu = s * (1.0f / 1024.0f), var = ss * (1.0f / 1024.0f) - mu * mu, rstd = rsqrtf(fmaxf(var, 0.f) + LN_EPS);
                if (hlf == 0) tab[i * 256 + r] = (f32x2){mu, rstd};
            }
        }
        __syncthreads();
    }
    const int nsu_ = N / 16;
    const bool s_first = false;
    if (F::STAGGER && (((vb >> 3) & 1) != 0) && (G & 15) == 0) {
        const Params p = kparams();
        prep_deferred(p, launder_i(l) + 1, lds, tid, ((vb >> 4) << 3) | (vb & 7), G >> 1);
        __syncthreads();
    }
    EpiWrap<F> E{l, which, lds};
    pg8::gemm_phase<EpiWrap<F>>(lds, g, S, E, tid);
    if (F::DEFERRED_PREP) {
        const int nwg = (TP / 256) * (N / 256), first = (nwg > G && nwg < 2 * G) ? (nwg - G) : 0;
        if (vb >= first) { const Params p = kparams(); prep_deferred(p, launder_i(l) + 3, lds, tid, vb - first, G - first); __syncthreads(); }
    }
    const int nsu = N / 16;
    const int su0 = G - 1 - vb;
    if (su0 < nsu && !s_first) {
        const Params p = kparams();
        const F f = F::make(p, launder_i(l), which);
        for (int su = su0; su < nsu; su += G) sgemm_unit<F>(lds, A + (size_t)TP * K, Wt, K, su * 16, f, wid, lane);
    }
}

DI void transpose_tile_load(const float* W, const float* gain, int N, int k0, int n0, int tid, f32x4 (&v)[8]) {
#pragma unroll
    for (int i = 0; i < 8; ++i) { const int e = tid + 512 * i, row = e >> 5, c4 = e & 31;
        f32x4 x = __builtin_nontemporal_load((const f32x4*)(W + (size_t)(k0 + row) * N + n0 + 4 * c4));
        if (gain) x = x * gain[k0 + row];
        v[i] = x; }
}
DI void transpose_tile_store(LAS float* T, bf16_t* WT, int K, int k0, int n0, int tid, const f32x4 (&v)[8]) {
#pragma unroll
    for (int i = 0; i < 8; ++i) { const int e = tid + 512 * i, row = e >> 5, c4 = e & 31; LAS float* d = T + row * 129 + 4 * c4; d[0] = v[i].x; d[1] = v[i].y; d[2] = v[i].z; d[3] = v[i].w; }
    __syncthreads();
#pragma unroll
    for (int i = 0; i < 4; ++i) { const int e = tid + 512 * i, n = e >> 4, c8 = e & 15; const LAS float* s = T + (8 * c8) * 129 + n;
        u32x4 o; o.x = pk2(s[0], s[129]); o.y = pk2(s[2 * 129], s[3 * 129]); o.z = pk2(s[4 * 129], s[5 * 129]); o.w = pk2(s[6 * 129], s[7 * 129]);
        *(u32x4*)(WT + (size_t)(n0 + n) * K + k0 + 8 * c8) = o; }
    __syncthreads();
}
struct TrJob { const float* W; const float* gain; bf16_t* WT; int K, N, k0, n0; };
DI TrJob tr_job(const Params& p, int which, int l, int item) {
    unsigned char* ws = p.ws; TrJob j;
    if (which == 0) { j.W = p.w_in + (size_t)l * 1024 * 1536; j.gain = l ? p.ln2_g : nullptr; j.WT = (bf16_t*)(ws + WS_WIN) + (size_t)l * 1536 * 1024; j.K = 1024; j.N = 1536; }
    else if (which == 1) { j.W = p.w_out + (size_t)l * 1024 * 1024; j.gain = nullptr; j.WT = (bf16_t*)(ws + WS_WOUT) + (size_t)l * 1024 * 1024; j.K = 1024; j.N = 1024; }
    else if (which == 2) { j.W = p.w_ff1 + (size_t)l * 1024 * 4096; j.gain = p.ln1_g + l * 1024; j.WT = (bf16_t*)(ws + WS_W1) + (size_t)l * 4096 * 1024; j.K = 1024; j.N = 4096; }
    else { j.W = p.w_ff2 + (size_t)l * 4096 * 1024; j.gain = nullptr; j.WT = (bf16_t*)(ws + WS_W2) + (size_t)l * 1024 * 4096; j.K = 4096; j.N = 1024; }
    const int nb = j.N / 128; j.k0 = (item / nb) * 128; j.n0 = (item % nb) * 128; return j;
}
DI TrJob tr_slot_job(const Params& p, int slot, int it) {
    if (slot == 0) { if (it < 96) return tr_job(p, 0, 0, it); return tr_job(p, 0, 1, it - 96); }
    if (slot <= 2) return tr_job(p, 3, slot - 1, it);
    if (it < 64) return tr_job(p, 1, slot - 3, it);
    return tr_job(p, 2, slot - 3, it - 64);
}
DI void transpose_slot(const Params& p, int slot, LAS unsigned char* lds, int tid, int widx, int NW) {
    const int nit = slot == 0 ? 192 : (slot <= 2 ? 256 : 320);
    LAS float* T = (LAS float*)lds;
    f32x4 v[8];
    int it = widx;
    if (it < nit) { const TrJob j = tr_slot_job(p, slot, it); transpose_tile_load(j.W, j.gain, j.N, j.k0, j.n0, tid, v); }
    for (; it < nit; it += NW) {
        const TrJob j = tr_slot_job(p, slot, it);
#pragma unroll
        for (int i = 0; i < 8; ++i) { const int e = tid + 512 * i, row = e >> 5, c4 = e & 31; LAS float* d = T + row * 129 + 4 * c4; d[0] = v[i].x; d[1] = v[i].y; d[2] = v[i].z; d[3] = v[i].w; }
        __syncthreads();
        if (it + NW < nit) { const TrJob jn = tr_slot_job(p, slot, it + NW); transpose_tile_load(jn.W, jn.gain, jn.N, jn.k0, jn.n0, tid, v); }
#pragma unroll
        for (int i = 0; i < 4; ++i) { const int e = tid + 512 * i, n = e >> 4, c8 = e & 15; const LAS float* s = T + (8 * c8) * 129 + n;
            u32x4 o; o.x = pk2(s[0], s[129]); o.y = pk2(s[2 * 129], s[3 * 129]); o.z = pk2(s[4 * 129], s[5 * 129]); o.w = pk2(s[6 * 129], s[7 * 129]);
            *(u32x4*)(j.WT + (size_t)(j.n0 + n) * j.K + j.k0 + 8 * c8) = o; }
        __syncthreads();
    }
}
DI void colsum_item(const float* W, const float* gain, const float* bias, int N, int c0, float* cs, float* bw, LAS float* red, int wid, int lane) {
    float s1 = 0.f, s2 = 0.f;
    const float* wp = W + (size_t)(wid * 128) * N + c0 + lane;
#pragma unroll 32
    for (int k = 0; k < 128; ++k) { const float w = wp[(size_t)k * N]; const int kk = wid * 128 + k; s1 += bfround(gain[kk] * w); s2 += bias[kk] * w; }
    red[wid * 128 + lane] = s1; red[wid * 128 + 64 + lane] = s2;
    __syncthreads();
    if (wid == 0) { float a = 0.f, b = 0.f;
#pragma unroll
        for (int w = 0; w < 8; ++w) { a += red[w * 128 + lane]; b += red[w * 128 + 64 + lane]; }
        cs[c0 + lane] = a; bw[c0 + lane] = b; }
    __syncthreads();
}
DI void prep_deferred(const Params& p, int slot, LAS unsigned char* lds, int tid, int widx, int NW) {
    tid = launder_v(tid);
    transpose_slot(p, slot, lds, tid, widx, NW);
}
DI void phase_prep(const Params& p, LAS unsigned char* lds, int tid, int wid, int lane, int vb, int G) {
    RELAUNDER();
    unsigned char* ws = p.ws;
    const int gw = vb * 8 + wid, NGW = G * 8;
    transpose_slot(p, 0, lds, tid, vb, G);
    bf16_t* YB = (bf16_t*)(ws + WS_YB);
    for (int m0 = gw; m0 < MT; m0 += 4 * NGW) {
        f32x4 v[4][4];
#pragma unroll
        for (int r = 0; r < 4; ++r) { const int m = m0 + r * NGW; const int mm = m < MT ? m : m0;
            const f32x4* src = (const f32x4*)(mm < TP ? p.xp + (size_t)mm * 1024 : p.xs + (size_t)(mm - TP) * 1024);
#pragma unroll
            for (int j = 0; j < 4; ++j) v[r][j] = __builtin_nontemporal_load(src + lane + 64 * j); }
#pragma unroll
        for (int r = 0; r < 4; ++r) { const int m = m0 + r * NGW;
            if (m < MT) {
#pragma unroll
                for (int j = 0; j < 4; ++j) st_bf4(YB + (size_t)m * 1024 + 4 * (lane + 64 * j), v[r][j]); } }
    }
#pragma unroll
    for (int which = 0; which < 3; ++which) {
        const float* src = which == 0 ? p.ga_w : (which == 1 ? p.gx_w : p.pool_w);
        bf16_t* dst = (bf16_t*)(ws + (which == 0 ? WS_GAT : (which == 1 ? WS_GXT : WS_PWT)));
        for (int r = vb * NTHR + tid; r < 32768; r += G * NTHR) {
            const int ln = r >> 12, d = (r >> 6) & 63, c = r & 63;
            dst[r] = (bf16_t)(pk2(src[(ln << 12) + c * 64 + d], 0.f) & 0xffffu);
        }
    }
    __syncthreads();
}

DI void attn_item(const Params& p, int layer, int item, LAS unsigned char* lds, int tid, int wid, int lane) {
    RELAUNDER();
    const int kvh = item & 1, qb = (item >> 1) & 31, b = item >> 6;
    const bf16_t* QKV = (const bf16_t*)(p.ws + WS_QKV); bf16_t* MIX = (bf16_t*)(p.ws + WS_MIX);
    LAS bf16_t* Ks = (LAS bf16_t*)lds;
    LAS bf16_t* Vt = (LAS bf16_t*)(lds + 36864);
    {
        const int key = tid >> 1, half = tid & 1; const int tok = qb * 128 - 128 + key;
        u32x4 kv[4], vv[4];
        if (tok >= 0) { const bf16_t* src = QKV + ((size_t)b * 4096 + tok) * 768 + 512 + kvh * 64 + half * 32;
#pragma unroll
            for (int i = 0; i < 4; ++i) { kv[i] = ((const u32x4*)src)[i]; vv[i] = ((const u32x4*)(src + 128))[i]; } }
        else {
#pragma unroll
            for (int i = 0; i < 4; ++i) { kv[i] = (u32x4){0u, 0u, 0u, 0u}; vv[i] = (u32x4){0u, 0u, 0u, 0u}; } }
#pragma unroll
        for (int i = 0; i < 4; ++i) *(LAS u32x4*)(Ks + key * 72 + half * 32 + 8 * i) = kv[i];
#pragma unroll
        for (int i = 0; i < 4; ++i)
#pragma unroll
            for (int e = 0; e < 8; ++e) { const int d = half * 32 + 8 * i + e; Vt[d * 264 + key] = (bf16_t)((vv[i][e >> 1] >> (16 * (e & 1))) & 0xffffu); }
    }
    __syncthreads();
    const int g = wid >> 1, qh = wid & 1, h = kvh * 4 + g, fr = lane & 15, fq = lane >> 4;
    const float slope2 = exp2f(-(float)(h + 1)) * LOG2E, sink2 = p.sinks[layer * 8 + h] * LOG2E;
    const size_t rowbase = (size_t)b * 4096 + qb * 128;
    bf16x8 qall[4][2];
#pragma unroll
    for (int qt = 0; qt < 4; ++qt) { const bf16_t* qp = QKV + (rowbase + qh * 64 + qt * 16 + fr) * 768 + h * 64 + 8 * fq; qall[qt][0] = *(const bf16x8*)qp; qall[qt][1] = *(const bf16x8*)(qp + 32); }
#pragma unroll
    for (int qt = 0; qt < 4; ++qt) {
        const int i0 = qh * 64 + qt * 16, jb = 32 * ((qh * 4 + qt) >> 1), iq = i0 + fr;
        const bf16x8 q0 = qall[qt][0], q1 = qall[qt][1];
        f32x4 s[10];
        float mx = sink2;
        const bool odd = (qt & 1) != 0;
        if (qb > 0) {
            const float t0 = -slope2 * (float)(iq + 128 - jb - 4 * fq);
            const float tb0 = t0, tb1 = t0 + slope2, tb2 = t0 + 2.0f * slope2, tb3 = t0 + 3.0f * slope2;
#pragma unroll
            for (int kt = 0; kt < 10; ++kt) {
                const bool dead = odd ? (kt == 0) : (kt == 9);
                if (dead) { s[kt] = (f32x4){0.f, 0.f, 0.f, 0.f}; continue; }
                const float c = slope2 * (float)(16 * kt);
                const LAS bf16_t* kp = Ks + (jb + 16 * kt + fr) * 72 + 8 * fq;
                const bf16x8 k0 = *(const LAS bf16x8*)kp, k1 = *(const LAS bf16x8*)(kp + 32);
                s[kt] = mfma16(k0, q0, (f32x4){tb0 + c, tb1 + c, tb2 + c, tb3 + c}); s[kt] = mfma16(k1, q1, s[kt]);
                const bool lo = odd ? (kt == 1) : (kt == 0), hi = odd ? (kt == 9) : (kt == 8);
#pragma unroll
                for (int i = 0; i < 4; ++i) {
                    if (lo) s[kt][i] = (4 * fq + i >= fr) ? s[kt][i] : -1e30f;
                    if (hi) s[kt][i] = (4 * fq + i <= fr) ? s[kt][i] : -1e30f;
                    mx = fmaxf(mx, s[kt][i]); }
            }
        } else {
#pragma unroll
            for (int kt = 0; kt < 10; ++kt) { const LAS bf16_t* kp = Ks + (jb + 16 * kt + fr) * 72 + 8 * fq;
                const bf16x8 k0 = *(const LAS bf16x8*)kp, k1 = *(const LAS bf16x8*)(kp + 32);
                s[kt] = mfma16(k0, q0, (f32x4){0.f, 0.f, 0.f, 0.f}); s[kt] = mfma16(k1, q1, s[kt]); }
#pragma unroll
            for (int kt = 0; kt < 10; ++kt)
#pragma unroll
                for (int i = 0; i < 4; ++i) { const int j = jb + 16 * kt + 4 * fq + i, delta = iq + 128 - j;
                    const bool valid = (delta >= 0) && (delta <= 128) && (j >= 128);
                    const float v = s[kt][i] - slope2 * (float)delta;
                    s[kt][i] = valid ? v : -1e30f; mx = fmaxf(mx, s[kt][i]); }
        }
        mx = fmaxf(mx, __shfl_xor(mx, 16)); mx = fmaxf(mx, __shfl_xor(mx, 32));
        float sum = 0.f;
#pragma unroll
        for (int kt = 0; kt < 10; ++kt) {
            if (qb > 0 && (odd ? (kt == 0) : (kt == 9))) continue;
#pragma unroll
            for (int i = 0; i < 4; ++i) { const float pv = __builtin_amdgcn_exp2f(s[kt][i] - mx); s[kt][i] = pv; sum += pv; }
        }
        sum += __shfl_xor(sum, 16); sum += __shfl_xor(sum, 32);
        const float inv = 1.0f / (sum + __builtin_amdgcn_exp2f(sink2 - mx));
        bf16x8 pf[5];
#pragma unroll
        for (int G = 0; G < 5; ++G) pf[G] = pack8(s[2 * G], s[2 * G + 1]);
#pragma unroll
        for (int dt = 0; dt < 4; ++dt) {
            f32x4 o = (f32x4){0.f, 0.f, 0.f, 0.f};
#pragma unroll
            for (int G = 0; G < 5; ++G) { const LAS bf16_t* vp = Vt + (16 * dt + fr) * 264 + jb + 32 * G + 4 * fq;
                const u32x2 lo = *(const LAS u32x2*)vp, hi = *(const LAS u32x2*)(vp + 16);
                const u32x4 w = (u32x4){lo.x, lo.y, hi.x, hi.y};
                o = mfma16(__builtin_bit_cast(bf16x8, w), pf[G], o); }
            st_bf4(MIX + (rowbase + iq) * 1024 + h * 64 + 16 * dt + 4 * fq, o * inv);
        }
    }
    __syncthreads();
}

DI void sattn_item(const Params& p, int layer, int j, LAS unsigned char* lds, int tid, int wid, int lane) {
    RELAUNDER();
    LAS float* Kc = (LAS float*)lds;
    LAS float* Vc = Kc + 129 * 132;
    LAS float* Ps = Vc + 129 * 132;
    LAS float* Qs = Ps + 8 * 132;
    const size_t cbase = ((size_t)(layer * 128 + j)) * 128 * 128;
    const f32x4* ck = (const f32x4*)(p.ck + cbase); const f32x4* cv = (const f32x4*)(p.cv + cbase);
    f32x4* sk = (f32x4*)(p.out + O_SK + cbase); f32x4* sv = (f32x4*)(p.out + O_SV + cbase);
#pragma unroll
    for (int i = 0; i < 8; ++i) { const int idx = tid + 512 * i, s = idx >> 5, c4 = idx & 31;
        const f32x4 kv = __builtin_nontemporal_load(ck + idx), vv = __builtin_nontemporal_load(cv + idx);
        *(LAS f32x4*)(Kc + s * 132 + 4 * c4) = kv; *(LAS f32x4*)(Vc + s * 132 + 4 * c4) = vv;
        if (s >= 1) { __builtin_nontemporal_store(kv, sk + (idx - 32)); __builtin_nontemporal_store(vv, sv + (idx - 32)); } }
    if (tid < 32) *(LAS f32x4*)(Kc + 128 * 132 + 4 * tid) = sk[127 * 32 + tid];
    else if (tid < 64) *(LAS f32x4*)(Vc + 128 * 132 + 4 * (tid - 32)) = sv[127 * 32 + (tid - 32)];
    const bf16_t* QKV = (const bf16_t*)(p.ws + WS_QKV);
    Qs[tid] = bf2f(QKV[(size_t)(TP + j) * 768 + tid]);
    __syncthreads();
    const int h = wid, kvh = h >> 2;
    const float slope = exp2f(-(float)(h + 1)), sink2 = p.sinks[layer * 8 + h] * LOG2E;
    float sc[3];
#pragma unroll
    for (int r = 0; r < 3; ++r) {
        const int s = (r < 2) ? lane + 64 * r : 128;
        const LAS f32x4* kp = (const LAS f32x4*)(Kc + s * 132 + kvh * 64); const LAS f32x4* qp = (const LAS f32x4*)(Qs + h * 64);
        float d = 0.f;
#pragma unroll
        for (int i = 0; i < 16; ++i) { const f32x4 a = kp[i], q = qp[i]; d += (a.x * q.x + a.y * q.y) + (a.z * q.z + a.w * q.w); }
        const float delta = (float)(128 - s);
        sc[r] = d - slope * LOG2E * delta;
        if (r == 2 && lane != 0) sc[r] = -1e30f;
    }
    float mx = fmaxf(fmaxf(sc[0], sc[1]), fmaxf(sc[2], sink2));
#pragma unroll
    for (int o = 1; o < 64; o <<= 1) mx = fmaxf(mx, __shfl_xor(mx, o));
    float sum = 0.f;
#pragma unroll
    for (int r = 0; r < 3; ++r) { sc[r] = __builtin_amdgcn_exp2f(sc[r] - mx); sum += sc[r]; }
#pragma unroll
    for (int o = 1; o < 64; o <<= 1) sum += __shfl_xor(sum, o);
    const float inv = 1.0f / (sum + __builtin_amdgcn_exp2f(sink2 - mx));
    Ps[h * 132 + lane] = sc[0]; Ps[h * 132 + 64 + lane] = sc[1]; if (lane == 0) Ps[h * 132 + 128] = sc[2];
    lds_wait();
    float o = 0.f;
#pragma unroll 8
    for (int s = 0; s < 129; ++s) o += Ps[h * 132 + s] * Vc[s * 132 + kvh * 64 + lane];
    bf16_t* MIX = (bf16_t*)(p.ws + WS_MIX);
    MIX[(size_t)(TP + j) * 1024 + h * 64 + lane] = (bf16_t)(pk2(o * inv, 0.f) & 0xffffu);
    __syncthreads();
}

DI float fsigmoid(float x) { return __builtin_amdgcn_rcpf(1.0f + __builtin_amdgcn_exp2f(-LOG2E * x)); }
DI void rglru_item(const Params& p, int layer, int item, LAS unsigned char* lds, int tid, int wid, int lane) {
    RELAUNDER();
    LAS float* XC = (LAS float*)lds;
    const bf16_t* U2 = (const bf16_t*)(p.ws + WS_U2);
    const int ti = item >> 1, chalf = item & 1;
    const bool smp = (ti == 128);
    const int b = ti >> 5, ch = ti & 31;
    {
        const int cq = tid & 31, tg = tid >> 5, cqg = chalf * 32 + cq;
        const f32x4 cb = ((const f32x4*)(p.conv_b + layer * 256))[cqg];
        f32x4 cw[4];
#pragma unroll
        for (int t = 0; t < 4; ++t) cw[t] = ((const f32x4*)(p.conv_w + (layer * 4 + t) * 256))[cqg];
        if (!smp) {
            f32x4 x[11];
#pragma unroll
            for (int k = 0; k < 11; ++k) { const int t = ch * 128 + 8 * tg - 3 + k;
                x[k] = (t >= 0) ? ld_bf4(U2 + ((size_t)b * 4096 + t) * 768 + 4 * cqg) : (f32x4){0.f, 0.f, 0.f, 0.f}; }
#pragma unroll
            for (int k = 0; k < 8; ++k) { const f32x4 xc = cb + cw[0] * x[k] + cw[1] * x[k + 1] + cw[2] * x[k + 2] + cw[3] * x[k + 3];
                *(LAS f32x4*)(XC + (8 * tg + k) * 132 + 4 * cq) = xc; }
            if (ch == 31 && tg == 15) { f32x4* pc = (f32x4*)(p.out + O_PC + (size_t)(layer * 4 + b) * 3 * 256);
                pc[0 * 64 + cqg] = x[8]; pc[1 * 64 + cqg] = x[9]; pc[2 * 64 + cqg] = x[10]; }
        } else {
#pragma unroll 4
            for (int k = 0; k < 8; ++k) { const int j = 8 * tg + k;
                const f32x4* scp = (const f32x4*)(p.sc + (size_t)(layer * 128 + j) * 3 * 256);
                const f32x4 s0 = scp[cqg], s1 = scp[64 + cqg], s2 = scp[128 + cqg], xr = ld_bf4(U2 + (size_t)(TP + j) * 768 + 4 * cqg);
                const f32x4 xc = cb + cw[0] * s0 + cw[1] * s1 + cw[2] * s2 + cw[3] * xr;
                *(LAS f32x4*)(XC + j * 132 + 4 * cq) = xc;
                f32x4* oc = (f32x4*)(p.out + O_SC + (size_t)(layer * 128 + j) * 3 * 256);
                oc[cqg] = s1; oc[64 + cqg] = s2; oc[128 + cqg] = xr; }
        }
    }
    __syncthreads();
    const int nl = wid >> 2, n = 2 * chalf + nl, fr = lane & 15, fq = lane >> 4;
    const int d = 16 * (wid & 3) + fr, cl = 64 * nl + d, c = 128 * chalf + cl;
    const bf16_t* GaT = (const bf16_t*)(p.ws + WS_GAT); const bf16_t* GxT = (const bf16_t*)(p.ws + WS_GXT);
    bf16x8 wa[2], wx[2];
#pragma unroll
    for (int ks = 0; ks < 2; ++ks) { const size_t o = ((size_t)((layer * 4 + n) * 64 + d)) * 64 + 32 * ks + 8 * fq; wa[ks] = *(const bf16x8*)(GaT + o); wx[ks] = *(const bf16x8*)(GxT + o); }
    const float ba = p.ga_b[layer * 256 + c], bx = p.gx_b[layer * 256 + c];
    const float spv = -8.0f * LOG2E * log1pf(__expf(-p.lam[layer * 256 + c]));
    float Ac = 1.f, Bc = 0.f;
    unsigned* HC = (unsigned*)(p.ws + WS_HL);
    bf16_t* MIX = (bf16_t*)(p.ws + WS_MIX);
    for (int tt = 0; tt < 8; ++tt) {
        bf16x8 af[2];
#pragma unroll
        for (int ks = 0; ks < 2; ++ks) { const LAS f32x4* src = (const LAS f32x4*)(XC + (16 * tt + fr) * 132 + 64 * nl + 32 * ks + 8 * fq); af[ks] = pack8(src[0], src[1]); }
        f32x4 ar = (f32x4){0.f, 0.f, 0.f, 0.f}, ai = (f32x4){0.f, 0.f, 0.f, 0.f};
#pragma unroll
        for (int ks = 0; ks < 2; ++ks) { ar = mfma16(af[ks], wa[ks], ar); ai = mfma16(af[ks], wx[ks], ai); }
        float av[4], bv[4];
#pragma unroll
        for (int i = 0; i < 4; ++i) { const int t = 16 * tt + 4 * fq + i; const float xcv = XC[t * 132 + cl];
            const float r = fsigmoid(ar[i] + ba), ig = fsigmoid(ai[i] + bx);
            const float a = __builtin_amdgcn_exp2f(spv * r);
            av[i] = a; bv[i] = __builtin_amdgcn_sqrtf(fmaxf(1.0f - a * a, 0.f)) * (ig * xcv); }
        if (smp) {
#pragma unroll
            for (int i = 0; i < 4; ++i) { const int j = 16 * tt + 4 * fq + i;
                const float h0 = p.sh[(size_t)(layer * 128 + j) * 256 + c];
                const float hv = av[i] * h0 + bv[i];
                p.out[O_SH + (size_t)(layer * 128 + j) * 256 + c] = hv;
                const float gr = bf2f(U2[(size_t)(TP + j) * 768 + 256 + c]);
                MIX[(size_t)(TP + j) * 1024 + 512 + c] = (bf16_t)(pk2(hv * gelu_tanh(gr), 0.f) & 0xffffu); }
        } else {
            float A4 = 1.f, B4 = 0.f;
#pragma unroll
            for (int i = 0; i < 4; ++i) { B4 = av[i] * B4 + bv[i]; A4 *= av[i]; }
            { const float A1 = __shfl_up(A4, 16), B1 = __shfl_up(B4, 16); if (fq >= 1) { B4 = A4 * B1 + B4; A4 = A4 * A1; } }
            { const float A2 = __shfl_up(A4, 32), B2 = __shfl_up(B4, 32); if (fq >= 2) { B4 = A4 * B2 + B4; A4 = A4 * A2; } }
            float Ae = __shfl_up(A4, 16), Be = __shfl_up(B4, 16); if (fq == 0) { Ae = 1.f; Be = 0.f; }
            const float At = __shfl(A4, 48 + fr), Bt = __shfl(B4, 48 + fr);
            float Ain = Ac * Ae, hin = Ae * Bc + Be;
#pragma unroll
            for (int i = 0; i < 4; ++i) { hin = av[i] * hin + bv[i]; Ain *= av[i];
                const size_t o = ((size_t)b * 4096 + ch * 128 + 16 * tt + 4 * fq + i) * 256 + c;
                HC[o] = pk2(hin, Ain); }
            Bc = At * Bc + Bt; Ac *= At;
        }
    }
    if (!smp && fq == 0) { ((float*)(p.ws + WS_AGA))[ti * 256 + c] = Ac; ((float*)(p.ws + WS_AGB))[ti * 256 + c] = Bc; }
    __syncthreads();
}

DI void rowsum_rows(const bf16_t* WT, const float* gain, const float* bias, int nrows, float* cs, float* bw, int gw, int NGW, int lane) {
    f32x4 r4[4];
#pragma unroll
    for (int j = 0; j < 4; ++j) { const f32x4 g4 = ((const f32x4*)gain)[lane * 4 + j], b4 = ((const f32x4*)bias)[lane * 4 + j]; r4[j] = b4 / g4; }
    for (int n = gw; n < nrows; n += NGW) {
        const u32x4* wp = (const u32x4*)(WT + (size_t)n * 1024 + 16 * lane);
        const u32x4 w0 = wp[0], w1 = wp[1];
        float s = 0.f, t = 0.f;
        const unsigned ww[8] = {w0.x, w0.y, w0.z, w0.w, w1.x, w1.y, w1.z, w1.w};
#pragma unroll
        for (int q = 0; q < 8; ++q) { const float lo = __uint_as_float(ww[q] << 16), hi = __uint_as_float(ww[q] & 0xffff0000u);
            s += lo + hi; t += lo * r4[q >> 1][(q & 1) * 2] + hi * r4[q >> 1][(q & 1) * 2 + 1]; }
#pragma unroll
        for (int o = 1; o < 64; o <<= 1) { s += __shfl_xor(s, o); t += __shfl_xor(t, o); }
        if (lane == 0) { cs[n] = s; bw[n] = t; }
    }
}

DI void fixup_item(const Params& p, int layer, int item, int tid) {
    tid = launder_v(tid);
    const int ti = item >> 2, qr = item & 3;
    const int b = ti >> 5, ch = ti & 31, c = tid & 255, half = tid >> 8;
    const float* AGA = (const float*)(p.ws + WS_AGA); const float* AGB = (const float*)(p.ws + WS_AGB);
    float carry = 0.f;
    {
        float ca[31], cb[31];
#pragma unroll
        for (int j = 0; j < 31; ++j) { const bool on = j < ch; ca[j] = on ? AGA[(b * 32 + j) * 256 + c] : 1.f; cb[j] = on ? AGB[(b * 32 + j) * 256 + c] : 0.f; }
#pragma unroll
        for (int j = 0; j < 31; ++j) carry = ca[j] * carry + cb[j];
    }
    const unsigned* HC = (const unsigned*)(p.ws + WS_HL); const bf16_t* U2 = (const bf16_t*)(p.ws + WS_U2);
    bf16_t* MIX = (bf16_t*)(p.ws + WS_MIX);
    const size_t row0 = (size_t)b * 4096 + ch * 128 + qr * 32 + half * 16;
    unsigned hc[16]; float grv[16];
#pragma unroll
    for (int k = 0; k < 16; ++k) { hc[k] = __builtin_nontemporal_load(HC + (row0 + k) * 256 + c); grv[k] = bf2f(__builtin_nontemporal_load(U2 + (row0 + k) * 768 + 256 + c)); }
    float h = 0.f;
#pragma unroll
    for (int k = 0; k < 16; ++k) { h = __uint_as_float(hc[k] << 16) + __uint_as_float(hc[k] & 0xffff0000u) * carry; MIX[(row0 + k) * 1024 + 512 + c] = (bf16_t)(pk2(h * gelu_tanh(grv[k]), 0.f) & 0xffffu); }
    if (ch == 31 && qr == 3 && half == 1) p.out[O_PH + (size_t)(layer * 4 + b) * 256 + c] = AGA[(b * 32 + 31) * 256 + c] * carry + AGB[(b * 32 + 31) * 256 + c];
}

DI void st_bf4_lds(LAS bf16_t* dst, f32x4 v) { u32x2 w; w.x = pk2(v.x, v.y); w.y = pk2(v.z, v.w); *(LAS u32x2*)dst = w; }
DI void pool_item(const Params& p, int layer, int ti, LAS unsigned char* lds, int tid, int wid, int lane) {
    RELAUNDER();
    LAS float* Zs = (LAS float*)lds;
    LAS bf16_t* Ds = (LAS bf16_t*)(lds + 48128);
    LAS bf16_t* Pw = (LAS bf16_t*)(lds + 115712);
    LAS float* Sc = (LAS float*)(lds + 152576);
    const bf16_t* U2 = (const bf16_t*)(p.ws + WS_U2);
    const bool smp = (ti >= 128);
    const int b = ti >> 5, ch = ti & 31;
    const int cq = tid & 63, gq = cq >> 4, tg = tid >> 6;
    const float wf = (float)(2 << gq);
    {
        const bf16_t* PwT = (const bf16_t*)(p.ws + WS_PWT) + (size_t)layer * 4 * 64 * 64;
#pragma unroll
        for (int i = 0; i < 4; ++i) { const int idx = tid + 512 * i, rowi = idx >> 3, c8 = idx & 7;
            *(LAS u32x4*)(Pw + rowi * 72 + 8 * c8) = *(const u32x4*)(PwT + (size_t)rowi * 64 + 8 * c8); }
        if (tid < 64) *(LAS f32x4*)(Sc + 4 * tid) = ((const f32x4*)(p.pool_scale + layer * 256))[tid];
    }
    if (!smp) {
        if (ch == 31) {
            for (int idx = tid; idx < 15 * 64; idx += NTHR) { const int r = idx >> 6, c4 = idx & 63;
                ((f32x4*)(p.out + O_PP + ((size_t)(layer * 4 + b) * 15 + r) * 256))[c4] = ld_bf4(U2 + ((size_t)b * 4096 + 4081 + r) * 768 + 512 + 4 * c4); }
        }
        f32x4 pf[6];
#pragma unroll
        for (int i = 0; i < 6; ++i) { const int e = tid + 512 * i, r = e >> 6, c4 = e & 63, t = ch * 128 - 15 + r;
            pf[i] = (e < 47 * 64 && t >= 0) ? ld_bf4(U2 + ((size_t)b * 4096 + t) * 768 + 512 + 4 * c4) : (f32x4){0.f, 0.f, 0.f, 0.f}; }
        for (int q = 0; q < 4; ++q) {
#pragma unroll
            for (int i = 0; i < 6; ++i) { const int e = tid + 512 * i; if (e < 47 * 64) *(LAS f32x4*)(Zs + 4 * e) = pf[i]; }
            __syncthreads();
            if (q < 3) {
#pragma unroll
                for (int i = 0; i < 6; ++i) { const int e = tid + 512 * i, r = e >> 6, c4 = e & 63, t = ch * 128 + 32 * (q + 1) - 15 + r;
                    pf[i] = (e < 47 * 64 && t >= 0) ? ld_bf4(U2 + ((size_t)b * 4096 + t) * 768 + 512 + 4 * c4) : (f32x4){0.f, 0.f, 0.f, 0.f}; }
            }
            f32x4 v[19], zs[4], res[4];
#pragma unroll
            for (int k = 0; k < 19; ++k) v[k] = *(const LAS f32x4*)(Zs + (4 * tg + k) * 256 + 4 * cq);
#pragma unroll
            for (int j = 0; j < 4; ++j) zs[j] = v[15 + j];
#pragma unroll
            for (int k = 18; k >= 1; --k) v[k] += v[k - 1];
#pragma unroll
            for (int j = 0; j < 4; ++j) res[j] = v[15 + j];
#pragma unroll
            for (int k = 18; k >= 3; --k) v[k] += v[k - 2];
#pragma unroll
            for (int j = 0; j < 4; ++j) res[j] = (gq >= 1) ? v[15 + j] : res[j];
#pragma unroll
            for (int k = 18; k >= 7; --k) v[k] += v[k - 4];
#pragma unroll
            for (int j = 0; j < 4; ++j) res[j] = (gq >= 2) ? v[15 + j] : res[j];
#pragma unroll
            for (int k = 18; k >= 15; --k) v[k] += v[k - 8];
#pragma unroll
            for (int j = 0; j < 4; ++j) res[j] = (gq >= 3) ? v[15 + j] : res[j];
#pragma unroll
            for (int j = 0; j < 4; ++j) { const int tl = 32 * q + 4 * tg + j; const float rc = __builtin_amdgcn_rcpf(fminf((float)(ch * 128 + tl + 1), wf));
                const f32x4 diff = res[j] * rc - zs[j];
                st_bf4_lds(Ds + tl * 264 + 4 * cq, diff); }
            __syncthreads();
        }
    } else {
        const int j0 = 32 * (ti - 128);
        const float rw = 1.0f / wf;
#pragma unroll 2
        for (int k = 0; k < 4; ++k) { const int jl = 4 * tg + k, j = j0 + jl;
            const f32x4* sp = (const f32x4*)(p.spool + (size_t)(layer * 128 + j) * 15 * 256);
            f32x4 st[15];
#pragma unroll
            for (int r = 0; r < 15; ++r) st[r] = sp[r * 64 + cq];
            const f32x4 z = ld_bf4(U2 + (size_t)(TP + j) * 768 + 512 + 4 * cq);
            const f32x4 s2 = z + st[14];
            const f32x4 s4 = s2 + (st[13] + st[12]);
            const f32x4 s8 = s4 + ((st[11] + st[10]) + (st[9] + st[8]));
            const f32x4 s16 = s8 + (((st[7] + st[6]) + (st[5] + st[4])) + ((st[3] + st[2]) + (st[1] + st[0])));
            const f32x4 rs = (gq == 0) ? s2 : ((gq == 1) ? s4 : ((gq == 2) ? s8 : s16));
            const f32x4 diff = rs * rw - z;
            st_bf4_lds(Ds + jl * 264 + 4 * cq, diff);
            f32x4* op = (f32x4*)(p.out + O_SP + (size_t)(layer * 128 + j) * 15 * 256);
#pragma unroll
            for (int r = 0; r < 14; ++r) op[r * 64 + cq] = st[r + 1];
            op[14 * 64 + cq] = z; }
        __syncthreads();
    }
    const int fr = lane & 15, fq = lane >> 4;
    bf16_t* MIX = (bf16_t*)(p.ws + WS_MIX);
    if (!smp || wid < 2) {
        const size_t row = smp ? (size_t)(TP + 32 * (ti - 128) + 16 * wid + fr) : ((size_t)b * 4096 + ch * 128 + 16 * wid + fr);
#pragma unroll
        for (int g = 0; g < 4; ++g) {
            bf16x8 bfr[2];
#pragma unroll
            for (int ks = 0; ks < 2; ++ks) bfr[ks] = *(const LAS bf16x8*)(Ds + (16 * wid + fr) * 264 + 64 * g + 32 * ks + 8 * fq);
#pragma unroll
            for (int dt = 0; dt < 4; ++dt) {
                f32x4 o = (f32x4){0.f, 0.f, 0.f, 0.f};
#pragma unroll
                for (int ks = 0; ks < 2; ++ks) { const bf16x8 a = *(const LAS bf16x8*)(Pw + (g * 64 + 16 * dt + fr) * 72 + 32 * ks + 8 * fq); o = mfma16(a, bfr[ks], o); }
                const int c = 64 * g + 16 * dt + 4 * fq;
                const f32x4 sc4 = *(const LAS f32x4*)(Sc + c);
                st_bf4(MIX + row * 1024 + 768 + c, o * sc4);
            }
        }
    }
    __syncthreads();
}

DI void final_ln(const Params& p, int vb, int G, int tid) {
    int wid, lane; RELAUNDER();
    const float* part = (const float*)(p.ws + WS_ST2); const float* part_s = (const float*)(p.ws + WS_STS2);
    const bf16_t* YB = (const bf16_t*)(p.ws + WS_YB);
    const f32x4* g = (const f32x4*)(p.ln2_g + 1024); const f32x4* bb = (const f32x4*)(p.ln2_b + 1024);
    f32x4 g4[4], b4[4];
#pragma unroll
    for (int j = 0; j < 4; ++j) { g4[j] = g[lane + 64 * j]; b4[j] = bb[lane + 64 * j]; }
    const int gw = vb * 8 + wid, NGW = G * 8;
    for (int row0 = gw; row0 < MT; row0 += 4 * NGW) {
        f32x4 y[4][4]; float mu[4], rs[4];
#pragma unroll
        for (int r = 0; r < 4; ++r) { const int row = (row0 + r * NGW < MT) ? row0 + r * NGW : row0;
#pragma unroll
            for (int j = 0; j < 4; ++j) y[r][j] = ld_bf4_nt(YB + (size_t)row * 1024 + 4 * (lane + 64 * j));
            row_stats_any(part, part_s, row, lane >> 4, mu[r], rs[r]); }
#pragma unroll
        for (int r = 0; r < 4; ++r) { const int row = row0 + r * NGW;
            if (row < MT) { f32x4* op = (f32x4*)(p.out + (size_t)row * 1024);
#pragma unroll
                for (int j = 0; j < 4; ++j) __builtin_nontemporal_store((y[r][j] - mu[r]) * rs[r] * g4[j] + b4[j], op + lane + 64 * j); } }
    }
}

#define XB_TMO      128
#define XB_XCNT(j)  (256  + 64 * (j))
#define XB_XSUB(j)  (1280 + 64 * (j))
#define XB_XGEN(j)  (2304 + 64 * (j))
#define XB_TOP      3328
#define XB_TOPGEN   3392
#define XCD_BAR_WORDS 3456
#define XB_SPIN_CAP (1u << 22)
DI unsigned xb_ld(unsigned* p)              { return __hip_atomic_load(p, __ATOMIC_RELAXED, __HIP_MEMORY_SCOPE_AGENT); }
DI unsigned xb_add(unsigned* p, unsigned v) { return __hip_atomic_fetch_add(p, v, __ATOMIC_RELAXED, __HIP_MEMORY_SCOPE_AGENT); }
DI unsigned xb_xcc_id() { return (unsigned)__builtin_amdgcn_s_getreg((3 << 11) | 20) & 0xFu; }
#define XB_SPIN(cond, bar) do { unsigned _sp = 0; while (cond) { __builtin_amdgcn_s_sleep(1); \
    if ((++_sp & 255u) == 0u) { if (xb_ld(&(bar)[XB_TMO])) break; if (_sp > XB_SPIN_CAP) { atomicAdd(&(bar)[XB_TMO], 1u); break; } } } } while (0)
DI void xcd_barrier_complete(unsigned* bar, unsigned x, unsigned& nloc, unsigned& nx) {
    const unsigned G = gridDim.x;
    unsigned sum, cnt, mine, sp = 0u;
    for (;;) {
        sum = 0u; cnt = 0u; mine = 0u;
#pragma unroll
        for (unsigned j = 0; j < 16; ++j) { const unsigned c = xb_ld(&bar[XB_XCNT(j)]); sum += c; cnt += (c > 0u) ? 1u : 0u; mine = (j == x) ? c : mine; }
        if (sum == G) break;
        __builtin_amdgcn_s_sleep(1);
        if ((++sp & 255u) == 0u) { if (xb_ld(&bar[XB_TMO])) break; if (sp > XB_SPIN_CAP) { atomicAdd(&bar[XB_TMO], 1u); break; } }
    }
    nloc = mine > 0u ? mine : 1u; nx = cnt > 0u ? cnt : 1u;
}
DI void xcd_barrier(unsigned* bar, volatile LAS unsigned* st) {
    asm volatile("s_waitcnt vmcnt(0)" ::: "memory");
    __syncthreads();
    if (threadIdx.x == 0) {
        const unsigned x = xb_xcc_id();
        __builtin_amdgcn_s_waitcnt(0);
        unsigned nloc = st[0], nx = st[1];
        if (nloc == 0u) { xcd_barrier_complete(bar, x, nloc, nx); st[0] = nloc; st[1] = nx; }
        const unsigned old = xb_add(&bar[XB_XSUB(x)], 1u);
        const unsigned gen = old / nloc;
        if (old + 1u == (gen + 1u) * nloc) {
            __builtin_amdgcn_fence(__ATOMIC_RELEASE, "agent");
            asm volatile("s_waitcnt vmcnt(0)" ::: "memory");
            const unsigned og = xb_add(&bar[XB_TOP], 1u);
            const unsigned tg = og / nx;
            if (og + 1u == (tg + 1u) * nx) xb_add(&bar[XB_TOPGEN], 1u);
            else XB_SPIN(xb_ld(&bar[XB_TOPGEN]) == tg, bar);
            __builtin_amdgcn_fence(__ATOMIC_ACQUIRE, "agent");
            xb_add(&bar[XB_XGEN(x)], 1u);
            asm volatile("s_waitcnt vmcnt(0)" ::: "memory");
        } else {
            XB_SPIN(xb_ld(&bar[XB_XGEN(x)]) == gen, bar);
            __builtin_amdgcn_fence(__ATOMIC_ACQUIRE, "agent");
            asm volatile("s_waitcnt vmcnt(0)" ::: "memory");
        }
    }
    __syncthreads();
}

DI int launder_i_unused(int x) { asm volatile("" : "+s"(x)); return x; }

__global__ void __launch_bounds__(NTHR, 2) hybrid_fwd(Params p_unused) {
    extern __shared__ __attribute__((aligned(16))) unsigned char smem[];
    LAS unsigned char* lds = (LAS unsigned char*)smem;
    cg::grid_group grid = cg::this_grid();
    const int tid = threadIdx.x, wid = __builtin_amdgcn_readfirstlane(tid >> 6), lane = tid & 63;
    const int vb = blockIdx.x, G = gridDim.x;
    volatile LAS unsigned* xst = (volatile LAS unsigned*)(lds + LDS_BYTES - 16);
    { unsigned* bar0 = (unsigned*)(kparams().ws + WS_BAR); if (tid == 0) { xst[0] = 0u; xst[1] = 0u; (void)xb_add(&bar0[XB_XCNT(xb_xcc_id())], 1u); } }
    __syncthreads();

#if !(PHOFF & 1)
    for (int rep = 0; rep < REP_PREP; ++rep) { const Params p = kparams(); phase_prep(p, lds, tid, wid, lane, vb, G); }
#endif
    if (kparams().out == nullptr) grid.sync();
    GSYNC();

#pragma nounroll
    for (int l0 = 0; l0 < 2; ++l0) {
#if !(PHOFF & 2)
        for (int rep = 0; rep < REP_G1; ++rep) {
            const Params p = kparams(); const int l = launder_i(l0); unsigned char* ws = p.ws;
            gemm_all<FIn>(lds, (const bf16_t*)(ws + WS_YB), (const bf16_t*)(ws + WS_WIN) + (size_t)l * 1536 * 1024, NIN, 1024, l, 0, vb, G, tid);
        }
#endif
        GSYNC();
        for (int rep = 0; rep < REP_MIX; ++rep) {
            const int l = launder_i(l0);
            unsigned* qctr = (unsigned*)(kparams().ws + WS_QCTR) + 64 * l;
            int it = vb;
            for (;;) {
                if (it >= 774) break;
#if !(PHOFF & 4)
                if (it < 256) for (int r2 = 0; r2 < REP_ATT; ++r2) { const Params p = kparams(); attn_item(p, l, it, lds, tid, wid, lane); }
#endif
#if !(PHOFF & 8)
                if (it >= 256 && it < 514) for (int r2 = 0; r2 < REP_RG; ++r2) { const Params p = kparams(); rglru_item(p, l, it - 256, lds, tid, wid, lane); }
#endif
#if !(PHOFF & 16)
                if (it >= 514 && it < 646) for (int r2 = 0; r2 < REP_POOL; ++r2) { const Params p = kparams(); pool_item(p, l, it - 514, lds, tid, wid, lane); }
#endif
#if !(PHOFF & 32)
                if (it >= 646) for (int r2 = 0; r2 < REP_SATT; ++r2) { const Params p = kparams(); sattn_item(p, l, it - 646, lds, tid, wid, lane); }
#endif
                if (tid == 0) xst[2] = G + xb_add(qctr, 1u);
                __syncthreads();
                it = __builtin_amdgcn_readfirstlane((int)xst[2]);
                __syncthreads();
            }
        }
        GSYNC();
#if !(PHOFF & 64)
        for (int rep = 0; rep < REP_FIX; ++rep) { const Params p = kparams(); const int l = launder_i(l0); for (int it = vb; it < 512; it += G) fixup_item(p, l, it, tid); }
#endif
        {
            const Params p = kparams(); const int l = launder_i(l0); unsigned char* ws = p.ws;
            const int tid2 = launder_v(tid), lane2 = tid2 & 63, gw = vb * 8 + (tid2 >> 6), NGW = G * 8;
            rowsum_rows((const bf16_t*)(ws + WS_W1) + (size_t)l * 4096 * 1024, p.ln1_g + l * 1024, p.ln1_b + l * 1024, 4096, (float*)(ws + WS_CS1) + l * 4096, (float*)(ws + WS_BW1) + l * 4096, gw, NGW, lane2);
            if (l == 0) rowsum_rows((const bf16_t*)(ws + WS_WIN) + (size_t)1536 * 1024, p.ln2_g, p.ln2_b, 1536, (float*)(ws + WS_CSIN) + 1536, (float*)(ws + WS_BWIN) + 1536, gw, NGW, lane2);
        }
        GSYNC();
#if !(PHOFF & 128)
        for (int rep = 0; rep < REP_G2; ++rep) {
            const Params p = kparams(); const int l = launder_i(l0); unsigned char* ws = p.ws;
#if REP_G2 > 1
            if (rep < REP_G2 - 1) gemm_all<FResT<true>>(lds, (const bf16_t*)(ws + WS_MIX), (const bf16_t*)(ws + WS_WOUT) + (size_t)l * 1024 * 1024, 1024, 1024, l, 0, vb, G, tid); else
#endif
            gemm_all<FRes>(lds, (const bf16_t*)(ws + WS_MIX), (const bf16_t*)(ws + WS_WOUT) + (size_t)l * 1024 * 1024, 1024, 1024, l, 0, vb, G, tid);
        }
#endif
        GSYNC();
#if !(PHOFF & 256)
        for (int rep = 0; rep < REP_G3; ++rep) {
            const Params p = kparams(); const int l = launder_i(l0); unsigned char* ws = p.ws;
            gemm_all<FFF1>(lds, (const bf16_t*)(ws + WS_YB), (const bf16_t*)(ws + WS_W1) + (size_t)l * 4096 * 1024, DFF, 1024, l, 0, vb, G, tid);
        }
#endif
        GSYNC();
#if !(PHOFF & 512)
        for (int rep = 0; rep < REP_G4; ++rep) {
            const Params p = kparams(); const int l = launder_i(l0); unsigned char* ws = p.ws;
#if REP_G4 > 1
            if (rep < REP_G4 - 1) gemm_all<FResT<true>>(lds, (const bf16_t*)(ws + WS_HID), (const bf16_t*)(ws + WS_W2) + (size_t)l * 1024 * 4096, 1024, 4096, l, 1, vb, G, tid); else
#endif
            gemm_all<FRes>(lds, (const bf16_t*)(ws + WS_HID), (const bf16_t*)(ws + WS_W2) + (size_t)l * 1024 * 4096, 1024, 4096, l, 1, vb, G, tid);
        }
#endif
        GSYNC();
    }
    { const Params p = kparams(); final_ln(p, vb, G, tid); }
}

extern "C" void kernel_launch(void* const* d_in, const int* in_sizes, int n_in, void* d_out, int out_size, void* d_ws, size_t ws_size, hipStream_t stream) {
    static int grid_blocks = 0;
    if (!grid_blocks) {
        int dev = 0, cus = 0, per_cu = 0;
        hipGetDevice(&dev);
        hipDeviceGetAttribute(&cus, hipDeviceAttributeMultiprocessorCount, dev);
        hipFuncSetAttribute((const void*)hybrid_fwd, hipFuncAttributeMaxDynamicSharedMemorySize, LDS_BYTES);
        hipOccupancyMaxActiveBlocksPerMultiprocessor(&per_cu, (const void*)hybrid_fwd, NTHR, LDS_BYTES);
        if (per_cu < 1) per_cu = 1;
        grid_blocks = cus * per_cu;
        if (ws_size < WS_END) fprintf(stderr, "kernel_launch: workspace too small: %zu < %zu\n", ws_size, (size_t)WS_END);
        fprintf(stderr, "kernel_launch: grid %d (cus %d x %d)\n", grid_blocks, cus, per_cu);
    }
    if (hipMemsetAsync((char*)d_ws + WS_BAR, 0, XCD_BAR_WORDS * 4 + 1024, stream) != hipSuccess) fprintf(stderr, "memset failed\n");
    Params p{};
    const float** pp = (const float**)&p;
    for (int i = 0; i < 25; ++i) pp[i] = (const float*)d_in[i];
    p.out = (float*)d_out; p.ws = (unsigned char*)d_ws;
    void* args[] = {&p};
    hipError_t e = hipLaunchCooperativeKernel((const void*)hybrid_fwd, dim3(grid_blocks), dim3(NTHR), args, LDS_BYTES, stream);
    if (e != hipSuccess) fprintf(stderr, "cooperative launch failed: %s (grid %d)\n", hipGetErrorString(e), grid_blocks);
}
```

```cpp
#include <hip/hip_runtime.h>
#include <hip/hip_cooperative_groups.h>
#include <cstdio>
namespace cg = cooperative_groups;

#define LAS __attribute__((address_space(3)))
typedef unsigned short bf16_t;
typedef short bf16x8 __attribute__((ext_vector_type(8)));
typedef float f32x4 __attribute__((ext_vector_type(4)));
typedef float f32x2 __attribute__((ext_vector_type(2)));
typedef unsigned u32x4 __attribute__((ext_vector_type(4)));
typedef unsigned u32x2 __attribute__((ext_vector_type(2)));
#define DI __device__ __forceinline__
#ifndef PHOFF
#define PHOFF 0
#endif
#ifndef REP_SYNC
#define REP_SYNC 1
#endif
#ifndef REP_MIX
#define REP_MIX 1
#endif
#ifndef REP_G3
#define REP_G3 1
#endif
#ifndef REP_PREP
#define REP_PREP 1
#endif
#ifndef REP_FIX
#define REP_FIX 1
#endif
#ifndef REP_ATT
#define REP_ATT 1
#endif
#ifndef REP_RG
#define REP_RG 1
#endif
#ifndef REP_POOL
#define REP_POOL 1
#endif
#ifndef REP_SATT
#define REP_SATT 1
#endif
#ifndef REP_G2
#define REP_G2 1
#endif
#ifndef REP_G4
#define REP_G4 1
#endif
#ifndef REP_G1
#define REP_G1 1
#endif
#define GSYNC() do { for (int _r = 0; _r < REP_SYNC; ++_r) { unsigned* _bar = (unsigned*)(kparams().ws + WS_BAR); xcd_barrier(_bar, xst); } } while (0)

constexpr int DM = 1024, TP = 16384, TS = 128, MT = TP + TS, NIN = 1536, DFF = 4096;
constexpr int NTHR = 512;
constexpr float LOG2E = 1.4426950408889634f;
constexpr float ALPHA = 1.4142135623730951f;
constexpr float QSCALE = 0.125f * 1.4426950408889634f;
constexpr float LN_EPS = 1e-5f;
constexpr size_t O_YP = 0, O_YS = 16777216, O_PK = 16908288, O_PV = 17039360, O_PH = 17170432, O_PC = 17172480, O_PP = 17178624,
                 O_SK = 17209344, O_SV = 21403648, O_SH = 25597952, O_SC = 25663488, O_SP = 25860096;
constexpr size_t WS_WIN = 0;
constexpr size_t WS_WOUT = WS_WIN + 2ull * 1536 * 1024 * 2;
constexpr size_t WS_W1 = WS_WOUT + 2ull * 1024 * 1024 * 2;
constexpr size_t WS_W2 = WS_W1 + 2ull * 4096 * 1024 * 2;
constexpr size_t WS_YB = WS_W2 + 2ull * 4096 * 1024 * 2;
constexpr size_t WS_MIX = WS_YB + (size_t)MT * 1024 * 2;
constexpr size_t WS_HID = WS_MIX + (size_t)MT * 1024 * 2;
constexpr size_t WS_QKV = WS_HID;
constexpr size_t WS_U2 = WS_QKV + (size_t)MT * 768 * 2;
constexpr size_t WS_HL = WS_U2 + (size_t)MT * 768 * 4;
constexpr size_t WS_CA = WS_HL + (size_t)TP * 256 * 4;
constexpr size_t WS_ST1 = WS_HID + (size_t)MT * 4096 * 2;
constexpr size_t WS_ST2 = WS_ST1 + (size_t)MT * 32 * 4;
constexpr size_t WS_CSIN = WS_ST2 + (size_t)MT * 32 * 4;
constexpr size_t WS_BWIN = WS_CSIN + 2 * 1536 * 4;
constexpr size_t WS_CS1 = WS_BWIN + 2 * 1536 * 4;
constexpr size_t WS_BW1 = WS_CS1 + 2 * 4096 * 4;
constexpr size_t WS_GAT = WS_BW1 + 2 * 4096 * 4;
constexpr size_t WS_GXT = WS_GAT + 2 * 4 * 64 * 64 * 2;
constexpr size_t WS_PWT = WS_GXT + 2 * 4 * 64 * 64 * 2;
constexpr size_t WS_AGA = WS_PWT + 2 * 4 * 64 * 64 * 2;
constexpr size_t WS_AGB = WS_AGA + 128 * 256 * 4;
constexpr size_t WS_STS1 = WS_AGB + 128 * 256 * 4;
constexpr size_t WS_STS2 = WS_STS1 + 128 * 128 * 4;
constexpr size_t WS_BAR = WS_STS2 + 128 * 128 * 4;
constexpr size_t WS_QCTR = WS_BAR + 3456 * 4;
constexpr size_t WS_END = WS_QCTR + 1024;
static_assert(WS_CA + (size_t)TP * 256 * 4 <= WS_ST1, "alias region overflow");
static_assert(WS_END <= 268435456ull, "workspace budget");
constexpr int LDS_BYTES = 163840;

struct Params {
    const float* xp; const float* xs; const float* ck; const float* cv; const float* sh; const float* sc; const float* spool;
    const float* w_in; const float* sinks; const float* conv_w; const float* conv_b; const float* ga_w; const float* ga_b; const float* gx_w; const float* gx_b; const float* lam;
    const float* pool_w; const float* pool_scale; const float* w_out; const float* ln1_g; const float* ln1_b; const float* w_ff1; const float* w_ff2; const float* ln2_g; const float* ln2_b;
    float* out; unsigned char* ws;
};

DI unsigned pk2(float lo, float hi) { unsigned r; asm volatile("v_cvt_pk_bf16_f32 %0, %1, %2" : "=v"(r) : "v"(lo), "v"(hi)); return r; }
DI float bf2f(bf16_t b) { return __uint_as_float(((unsigned)b) << 16); }
DI float bfround(float x) { return __uint_as_float(pk2(x, 0.f) << 16); }
DI f32x4 mfma16(bf16x8 a, bf16x8 b, f32x4 c) { return __builtin_amdgcn_mfma_f32_16x16x32_bf16(a, b, c, 0, 0, 0); }
DI int launder_v(int x) { asm volatile("" : "+v"(x)); return x; }
DI int launder_i(int x) { asm volatile("" : "+s"(x)); return x; }
#define RELAUNDER() do { tid = launder_v(tid); lane = tid & 63; wid = __builtin_amdgcn_readfirstlane(tid >> 6); } while (0)
DI void lds_wait() { asm volatile("s_waitcnt lgkmcnt(0)" ::: "memory"); }
DI float sigmoidf_(float x) { return 1.0f / (1.0f + __expf(-x)); }
DI float gelu_tanh(float x) { const float u = 0.7978845608028654f * (x + 0.044715f * x * x * x); return x * __builtin_amdgcn_rcpf(1.0f + __builtin_amdgcn_exp2f(-2.0f * 1.4426950408889634f * u)); }
DI bf16x8 pack8(f32x4 lo, f32x4 hi) { u32x4 w; w.x = pk2(lo.x, lo.y); w.y = pk2(lo.z, lo.w); w.z = pk2(hi.x, hi.y); w.w = pk2(hi.z, hi.w); return __builtin_bit_cast(bf16x8, w); }
DI f32x4 ld_bf4_nt(const bf16_t* p) { const u32x2 w = __builtin_nontemporal_load((const u32x2*)p); return (f32x4){__uint_as_float(w.x << 16), __uint_as_float(w.x & 0xffff0000u), __uint_as_float(w.y << 16), __uint_as_float(w.y & 0xffff0000u)}; }
DI f32x4 ld_bf4(const bf16_t* p) { const u32x2 w = *(const u32x2*)p; return (f32x4){__uint_as_float(w.x << 16), __uint_as_float(w.x & 0xffff0000u), __uint_as_float(w.y << 16), __uint_as_float(w.y & 0xffff0000u)}; }
DI void st_bf4(bf16_t* dst, f32x4 v) { u32x2 w; w.x = pk2(v.x, v.y); w.y = pk2(v.z, v.w); *(u32x2*)dst = w; }

namespace pg8 {
constexpr int BM = 256, BK = 64, HALF = 128, HTB = HALF * BK * 2, STAGE_BYTES = 8 * HTB, NXCD = 8, WGM = 8;
DI int lds_byte(int r, int c) { const int st = (r >> 4) * 2 + (c >> 5), rr = r & 15, cc = c & 31, ob = rr * 64 + cc * 2; return st * 1024 + (ob ^ (((ob >> 9) & 1) << 5)); }
DI void stage_rc(int b, int& R, int& C) { const int st = b / 1024, sb = b % 1024, swz = sb ^ (((sb >> 9) & 1) << 5); R = (st >> 1) * 16 + swz / 64; C = (st & 1) * 32 + (swz % 64) / 2; }
DI int perm32(int rho) { const int n = rho >> 4, i = rho & 15; return 8 * (i >> 2) + 4 * n + (i & 3); }
struct Unit { int pm, pn; };
struct Gemm { const bf16_t* A; const bf16_t* Bt; int M, N, K; };
struct StaticOrder {
    int nM, nN, nwg, G, c;
    DI void init(int M, int N, int G_, int c_) { nM = M / BM; nN = N / BM; nwg = nM * nN; G = G_; c = c_; }
    DI bool next(int i, Unit& u) const {
        const long L = (long)i * G + c; if (L >= nwg) return false;
        int wgid = (int)L; { const int q = nwg / NXCD, r = nwg % NXCD, xcd = wgid % NXCD, off = wgid / NXCD; wgid = (xcd < r ? xcd * (q + 1) : r * (q + 1) + (xcd - r) * q) + off; }
        const int nig = WGM * nN, gid = wgid / nig, fm = gid * WGM, gsz = (nM - fm) < WGM ? (nM - fm) : WGM;
        u.pm = fm + ((wgid % nig) % gsz); u.pn = (wgid % nig) / gsz; return true;
    }
};

template <class Epi>
DI void gemm_phase(LAS unsigned char* lds, const Gemm g, const StaticOrder& S, const Epi& E, int tid) {
    const int wid = __builtin_amdgcn_readfirstlane(tid >> 6), lane = tid & 63, wr = wid >> 2, wc = wid & 3, fr = lane & 15, fq = lane >> 4;
    const int K = g.K, nt = K / BK;
    unsigned voffA[2], voffB[2];
#pragma unroll
    for (int i = 0; i < 2; ++i) { int R, C; stage_rc(tid * 16 + i * 8192, R, C); const int Rb = (R & ~31) + perm32(R & 31); voffA[i] = (unsigned)(R * K + C) * 2u; voffB[i] = (unsigned)(Rb * K + C) * 2u; }
    const size_t kstep = (size_t)(BK * 2);
    const size_t hstep = (size_t)HALF * K * 2;
    const size_t tstep = 2 * hstep;
    const unsigned ldsw = (unsigned)wid * 1024u;
    const int aoff = lds_byte(wr * 64 + fr, fq * 8), boff = lds_byte(wc * 32 + fr, fq * 8);
#define PG8_SA(b, h) (((b) * 2 + (h)) * HTB)
#define PG8_SB(b, h) ((4 + (b) * 2 + (h)) * HTB)
#define PG8_STAGE(bufoff, gbase, voff) do { _Pragma("unroll") for (int _i = 0; _i < 2; ++_i) \
        __builtin_amdgcn_global_load_lds((const unsigned*)((const char*)(gbase) + (voff)[_i]), (LAS unsigned*)(lds + (bufoff) + ldsw + _i * 8192), 16, 0, 0); } while (0)
#define PG8_LDA(dst, b, h) do { _Pragma("unroll") for (int m = 0; m < 4; ++m) _Pragma("unroll") for (int k = 0; k < 2; ++k) dst[m][k] = *(const LAS bf16x8*)(lds + PG8_SA(b, h) + aoff + m * 2048 + k * 1024); } while (0)
#define PG8_LDB(dst, b, h) do { _Pragma("unroll") for (int n = 0; n < 2; ++n) _Pragma("unroll") for (int k = 0; k < 2; ++k) dst[n][k] = *(const LAS bf16x8*)(lds + PG8_SB(b, h) + boff + n * 2048 + k * 1024); } while (0)
#define PG8_MMA(ai, bj, At, Bt) do { __builtin_amdgcn_s_setprio(1); _Pragma("unroll") for (int m = 0; m < 4; ++m) _Pragma("unroll") for (int n = 0; n < 2; ++n) _Pragma("unroll") for (int k = 0; k < 2; ++k) \
        acc[ai][bj][m][n] = __builtin_amdgcn_mfma_f32_16x16x32_bf16(Bt[n][k], At[m][k], acc[ai][bj][m][n], 0, 0, 0); __builtin_amdgcn_s_setprio(0); } while (0)
#define PG8_WAIT_V(n) asm volatile("s_waitcnt vmcnt(" #n ")" ::: "memory")
#define PG8_WAIT_L(n) asm volatile("s_waitcnt lgkmcnt(" #n ")" ::: "memory")
#define PG8_BAR __builtin_amdgcn_s_barrier()
#define PG8_SCHED __builtin_amdgcn_sched_barrier(0)
    Unit cur, nxt; int ui = 0;
    if (!S.next(0, cur)) return;
    f32x4 acc[2][2][4][2];
#pragma unroll
    for (int a = 0; a < 2; ++a)
#pragma unroll
        for (int b = 0; b < 2; ++b)
#pragma unroll
            for (int m = 0; m < 4; ++m)
#pragma unroll
                for (int n = 0; n < 2; ++n) acc[a][b][m][n] = (f32x4){0.f, 0.f, 0.f, 0.f};
    bf16x8 At[4][2], B0[2][2], B1[2][2];
    const char* cA = (const char*)g.A + (size_t)cur.pm * tstep; const char* cB = (const char*)g.Bt + (size_t)cur.pn * tstep;
    PG8_STAGE(PG8_SB(0, 0), cB, voffB); PG8_STAGE(PG8_SA(0, 0), cA, voffA); PG8_STAGE(PG8_SB(0, 1), cB + hstep, voffB); PG8_STAGE(PG8_SA(0, 1), cA + hstep, voffA);
    if (wr == 1) PG8_BAR;
    PG8_WAIT_V(4); PG8_BAR;
    PG8_STAGE(PG8_SB(1, 0), cB + kstep, voffB); PG8_STAGE(PG8_SA(1, 0), cA + kstep, voffA); PG8_STAGE(PG8_SB(1, 1), cB + hstep + kstep, voffB);
    PG8_WAIT_V(6); PG8_BAR;
    for (;;) {
        const bool has_next = S.next(ui + 1, nxt);
        const char* nA = has_next ? (const char*)g.A + (size_t)nxt.pm * tstep : cA; const char* nB = has_next ? (const char*)g.Bt + (size_t)nxt.pn * tstep : cB;
        for (int t = 0; t < nt; t += 2) {
            const bool last = (t == nt - 2);
            const char* a1 = cA + (size_t)(t + 1) * kstep;
            const char* a2 = last ? nA : cA + (size_t)(t + 2) * kstep; const char* b2 = last ? nB : cB + (size_t)(t + 2) * kstep;
            const char* a3 = a2 + kstep; const char* b3 = b2 + kstep;
            PG8_LDB(B0, 0, 0); PG8_SCHED; PG8_LDA(At, 0, 0); PG8_STAGE(PG8_SA(1, 1), a1 + hstep, voffA);
            PG8_WAIT_L(8); PG8_BAR; PG8_WAIT_L(0); PG8_MMA(0, 0, At, B0); PG8_BAR; PG8_SCHED;
            PG8_LDB(B1, 0, 1); PG8_STAGE(PG8_SB(0, 0), b2, voffB);
            PG8_BAR; PG8_WAIT_L(0); PG8_MMA(0, 1, At, B1); PG8_BAR;
            PG8_LDA(At, 0, 1); PG8_STAGE(PG8_SA(0, 0), a2, voffA);
            PG8_BAR; PG8_WAIT_L(0); PG8_MMA(1, 0, At, B0); PG8_BAR; PG8_SCHED;
            PG8_STAGE(PG8_SB(0, 1), b2 + hstep, voffB);
            PG8_WAIT_V(6); PG8_BAR; PG8_MMA(1, 1, At, B1); PG8_BAR;
            PG8_LDB(B0, 1, 0); PG8_SCHED; PG8_LDA(At, 1, 0); PG8_STAGE(PG8_SA(0, 1), a2 + hstep, voffA);
            PG8_WAIT_L(8); PG8_BAR; PG8_WAIT_L(0); PG8_MMA(0, 0, At, B0); PG8_BAR; PG8_SCHED;
            PG8_LDB(B1, 1, 1); PG8_STAGE(PG8_SB(1, 0), b3, voffB);
            PG8_BAR; PG8_WAIT_L(0); PG8_MMA(0, 1, At, B1); PG8_BAR;
            PG8_LDA(At, 1, 1); PG8_STAGE(PG8_SA(1, 0), a3, voffA);
            PG8_BAR; PG8_WAIT_L(0); PG8_MMA(1, 0, At, B0); PG8_BAR; PG8_SCHED;
            PG8_STAGE(PG8_SB(1, 1), b3 + hstep, voffB);
            PG8_WAIT_V(6); PG8_BAR; PG8_MMA(1, 1, At, B1); PG8_BAR;
        }
        E(acc, cur, ui, wr, wc, fr, fq);
        if (!has_next) break;
#pragma unroll
        for (int a = 0; a < 2; ++a)
#pragma unroll
            for (int b = 0; b < 2; ++b)
#pragma unroll
                for (int m = 0; m < 4; ++m)
#pragma unroll
                    for (int n = 0; n < 2; ++n) acc[a][b][m][n] = (f32x4){0.f, 0.f, 0.f, 0.f};
        cur = nxt; cA = nA; cB = nB; ++ui;
    }
    PG8_WAIT_V(0);
    if (wr == 0) PG8_BAR;
    PG8_BAR;
#undef PG8_SA
#undef PG8_SB
#undef PG8_STAGE
#undef PG8_LDA
#undef PG8_LDB
#undef PG8_MMA
#undef PG8_WAIT_V
#undef PG8_WAIT_L
#undef PG8_BAR
#undef PG8_SCHED
}
}

typedef const __attribute__((address_space(4))) Params* KParamsPtr;
DI Params kparams() {
#if defined(__HIP_DEVICE_COMPILE__)
    const __attribute__((address_space(4))) char* q = (const __attribute__((address_space(4))) char*)__builtin_amdgcn_kernarg_segment_ptr();
    asm volatile("" : "+s"(q));
    KParamsPtr kp = (KParamsPtr)q;
    Params r;
    r.xp = kp->xp; r.xs = kp->xs; r.ck = kp->ck; r.cv = kp->cv; r.sh = kp->sh; r.sc = kp->sc; r.spool = kp->spool;
    r.w_in = kp->w_in; r.sinks = kp->sinks; r.conv_w = kp->conv_w; r.conv_b = kp->conv_b; r.ga_w = kp->ga_w; r.ga_b = kp->ga_b; r.gx_w = kp->gx_w; r.gx_b = kp->gx_b; r.lam = kp->lam;
    r.pool_w = kp->pool_w; r.pool_scale = kp->pool_scale; r.w_out = kp->w_out; r.ln1_g = kp->ln1_g; r.ln1_b = kp->ln1_b; r.w_ff1 = kp->w_ff1; r.w_ff2 = kp->w_ff2; r.ln2_g = kp->ln2_g; r.ln2_b = kp->ln2_b;
    r.out = kp->out; r.ws = kp->ws;
    return r;
#else
    return Params{};
#endif
}

struct RowCtx { float mu, rstd; };
DI void row_stats(const float* part, int row, int fq, float& mu, float& rstd) {
    const f32x4* p = (const f32x4*)(part + (size_t)row * 32 + fq * 8);
    const f32x4 a = p[0], b = p[1];
    float s = (a.x + a.z) + (b.x + b.z), ss = (a.y + a.w) + (b.y + b.w);
    s += __shfl_xor(s, 16); s += __shfl_xor(s, 32); ss += __shfl_xor(ss, 16); ss += __shfl_xor(ss, 32);
    mu = s * (1.0f / 1024.0f); const float var = ss * (1.0f / 1024.0f) - mu * mu; rstd = rsqrtf(fmaxf(var, 0.f) + LN_EPS);
}

DI void row_stats_s(const float* part_s, int srow, int fq, float& mu, float& rstd) {
    const f32x4* p = (const f32x4*)(part_s + (size_t)srow * 128 + fq * 32);
    float s = 0.f, ss = 0.f;
#pragma unroll
    for (int i = 0; i < 8; ++i) { const f32x4 a = p[i]; s += a.x + a.z; ss += a.y + a.w; }
    s += __shfl_xor(s, 16); s += __shfl_xor(s, 32); ss += __shfl_xor(ss, 16); ss += __shfl_xor(ss, 32);
    mu = s * (1.0f / 1024.0f); const float var = ss * (1.0f / 1024.0f) - mu * mu; rstd = rsqrtf(fmaxf(var, 0.f) + LN_EPS);
}
DI void row_stats_any(const float* part, const float* part_s, int row, int fq, float& mu, float& rstd) {
    if (row < TP) row_stats(part, row, fq, mu, rstd); else row_stats_s(part_s, row - TP, fq, mu, rstd);
}

struct ColCtx { f32x4 a, b; };
DI void st_bf8(bf16_t* dst, f32x4 v0, f32x4 v1) { u32x4 w; w.x = pk2(v0.x, v0.y); w.y = pk2(v0.z, v0.w); w.z = pk2(v1.x, v1.y); w.w = pk2(v1.z, v1.w); *(u32x4*)dst = w; }
struct FIn {
    static constexpr bool STATS = false, PRELOAD = false, DEFERRED_PREP = true, STAGGER = false;
    const float* part; const float* part_s; const float* cs; const float* bw; int fold; int layer; bf16_t* QKV; bf16_t* U2; float* out; float* part_out; float* part_out_s;
    DI bool is_dry() const { return false; }
    DI const float* stats_src() const { return fold ? part : nullptr; }
    static DI FIn make(const Params& p, int l, int) { unsigned char* ws = p.ws;
        return FIn{(const float*)(ws + WS_ST2), (const float*)(ws + WS_STS2), (const float*)(ws + WS_CSIN) + l * 1536, (const float*)(ws + WS_BWIN) + l * 1536, l, l, (bf16_t*)(ws + WS_QKV), (bf16_t*)(ws + WS_U2), p.out, nullptr, nullptr}; }
    template <bool SMP> DI RowCtx row_begin(int row, int fq) const { RowCtx r{0.f, 1.f}; if (fold) { if (SMP) row_stats_s(part_s, row - TP, fq, r.mu, r.rstd); else row_stats(part, row, fq, r.mu, r.rstd); } return r; }
    DI ColCtx col_begin(int col) const { ColCtx c; c.a = *(const f32x4*)(cs + col); c.b = *(const f32x4*)(bw + col); return c; }
    DI f32x4 row_load8(int, int) const { return (f32x4){0.f, 0.f, 0.f, 0.f}; }
    DI f32x4 row_load4(int, int) const { return (f32x4){0.f, 0.f, 0.f, 0.f}; }
    DI f32x4 compute(int, int col, f32x4 a, const RowCtx& rc, const ColCtx& cc, float, float) const {
        f32x4 v = a;
        if (fold) v = (a - rc.mu * cc.a) * rc.rstd + cc.b;
        return v;
    }
    DI float* kv_dst(int row, int col) const {
        float* dst = nullptr; const int c7 = (col - 512) & 127; const bool isk = col < 640;
        if (row < TP) { const int t = row & 4095; if (t >= 3968) dst = out + (isk ? O_PK : O_PV) + ((size_t)((layer * 4 + (row >> 12)) * 128 + (t - 3968))) * 128 + c7; }
        else { dst = out + (isk ? O_SK : O_SV) + ((size_t)((layer * 128 + (row - TP)) * 128 + 127)) * 128 + c7; }
        return dst;
    }
    DI void store8(int row, int col, f32x4 v0, f32x4 v1) const {
        if (col < 512) st_bf8(QKV + (size_t)row * 768 + col, v0 * QSCALE, v1 * QSCALE);
        else if (col < 768) { st_bf8(QKV + (size_t)row * 768 + col, v0, v1); float* dst = kv_dst(row, col); if (dst) { *(f32x4*)dst = v0; *(f32x4*)(dst + 4) = v1; } }
        else st_bf8(U2 + (size_t)row * 768 + (col - 768), v0, v1);
    }
    DI void store4(int row, int col, f32x4 v) const {
        if (col < 512) st_bf4(QKV + (size_t)row * 768 + col, v * QSCALE);
        else if (col < 768) { st_bf4(QKV + (size_t)row * 768 + col, v); float* dst = kv_dst(row, col); if (dst) *(f32x4*)dst = v; }
        else st_bf4(U2 + (size_t)row * 768 + (col - 768), v);
    }
};
struct FFF1 {
    static constexpr bool STATS = false, PRELOAD = false, DEFERRED_PREP = false, STAGGER = true;
    const float* part; const float* part_s; const float* cs; const float* bw; bf16_t* HID; float* part_out; float* part_out_s;
    DI bool is_dry() const { return false; }
    DI const float* stats_src() const { return part; }
    static DI FFF1 make(const Params& p, int l, int) { unsigned char* ws = p.ws;
        return FFF1{(const float*)(ws + WS_ST1), (const float*)(ws + WS_STS1), (const float*)(ws + WS_CS1) + l * 4096, (const float*)(ws + WS_BW1) + l * 4096, (bf16_t*)(ws + WS_HID), nullptr, nullptr}; }
    template <bool SMP> DI RowCtx row_begin(int row, int fq) const { RowCtx r; if (SMP) row_stats_s(part_s, row - TP, fq, r.mu, r.rstd); else row_stats(part, row, fq, r.mu, r.rstd); return r; }
    DI ColCtx col_begin(int col) const { ColCtx c; c.a = *(const f32x4*)(cs + col); c.b = *(const f32x4*)(bw + col); return c; }
    DI f32x4 row_load8(int, int) const { return (f32x4){0.f, 0.f, 0.f, 0.f}; }
    DI f32x4 row_load4(int, int) const { return (f32x4){0.f, 0.f, 0.f, 0.f}; }
    DI f32x4 compute(int, int, f32x4 a, const RowCtx& rc, const ColCtx& cc, float, float) const {
        f32x4 v = (a - rc.mu * cc.a) * rc.rstd + cc.b;
        v.x = fmaxf(v.x, 0.f); v.y = fmaxf(v.y, 0.f); v.z = fmaxf(v.z, 0.f); v.w = fmaxf(v.w, 0.f); return v * v;
    }
    DI void store8(int row, int col, f32x4 v0, f32x4 v1) const { st_bf8(HID + (size_t)row * 4096 + col, v0, v1); }
    DI void store4(int row, int col, f32x4 v) const { st_bf4(HID + (size_t)row * 4096 + col, v); }
};
template <bool DRY> struct FResT {
    static constexpr bool STATS = true, PRELOAD = true, DEFERRED_PREP = false, STAGGER = false;
    int raw; const float* part; const float* part_s; const float* g; const float* b; float* Y; bf16_t* YB; float* part_out; float* part_out_s;
    static DI FResT make(const Params& p, int l, int which) { unsigned char* ws = p.ws;
        if (which == 0) return FResT{l == 0 ? 1 : 0, (const float*)(ws + WS_ST2), (const float*)(ws + WS_STS2), p.ln2_g, p.ln2_b, nullptr, (bf16_t*)(ws + WS_YB), (float*)(ws + WS_ST1), (float*)(ws + WS_STS1)};
        return FResT{0, (const float*)(ws + WS_ST1), (const float*)(ws + WS_STS1), p.ln1_g + l * 1024, p.ln1_b + l * 1024, nullptr, (bf16_t*)(ws + WS_YB), (float*)(ws + WS_ST2), (float*)(ws + WS_STS2)}; }
    DI bool is_dry() const { return DRY; }
    DI const float* stats_src() const { return raw ? nullptr : part; }
    template <bool SMP> DI RowCtx row_begin(int row, int fq) const { RowCtx r{0.f, 1.f}; if (!raw) { if (SMP) row_stats_s(part_s, row - TP, fq, r.mu, r.rstd); else row_stats(part, row, fq, r.mu, r.rstd); } return r; }
    DI ColCtx col_begin(int col) const { ColCtx c; c.a = *(const f32x4*)(g + col); c.b = *(const f32x4*)(b + col); return c; }
    DI f32x4 row_load8(int row, int col) const { const u32x4 w = *(const u32x4*)(YB + (size_t)row * 1024 + col); return __builtin_bit_cast(f32x4, w); }
    DI f32x4 row_load4(int row, int col) const { const u32x2 w = *(const u32x2*)(YB + (size_t)row * 1024 + col); return (f32x4){__uint_as_float(w.x), __uint_as_float(w.y), 0.f, 0.f}; }
    DI f32x4 compute(int, int, f32x4 a, const RowCtx& rc, const ColCtx& cc, float p0, float p1) const {
        const unsigned w0 = __float_as_uint(p0), w1 = __float_as_uint(p1);
        const f32x4 x = (f32x4){__uint_as_float(w0 << 16), __uint_as_float(w0 & 0xffff0000u), __uint_as_float(w1 << 16), __uint_as_float(w1 & 0xffff0000u)};
        const f32x4 r = raw ? x : ((x - rc.mu) * rc.rstd * cc.a + cc.b);
        return ALPHA * r + a;
    }
    DI void store8(int row, int col, f32x4 v0, f32x4 v1) const {
        if (!DRY) { st_bf8(YB + (size_t)row * 1024 + col, v0, v1); if (Y) { float* d = Y + (size_t)row * 1024 + col; *(f32x4*)d = v0; *(f32x4*)(d + 4) = v1; } }
    }
    DI void store4(int row, int col, f32x4 v) const {
        if (!DRY) { st_bf4(YB + (size_t)row * 1024 + col, v); if (Y) *(f32x4*)(Y + (size_t)row * 1024 + col) = v; }
    }
};
typedef FResT<false> FRes;

constexpr int STAT_TAB_OFF = 131072;
template <class F> struct EpiWrap {
    int l, which; LAS unsigned char* lds;
    DI void operator()(const f32x4 (&acc)[2][2][4][2], const pg8::Unit& u, int ui, int wr, int wc, int fr, int fq) const {
        const Params p = kparams();
        const F f = F::make(p, launder_i(l), which);
        const bool has_stats = f.stats_src() != nullptr;
        const LAS f32x2* tab = (const LAS f32x2*)(lds + STAT_TAB_OFF) + ui * 256 + wr * 64 + fr;
        const int rbase = u.pm * 256 + wr * 64 + fr, cbase = u.pn * 256 + wc * 32 + 8 * fq;
        ColCtx cc[2][2];
#pragma unroll
        for (int bj = 0; bj < 2; ++bj)
#pragma unroll
            for (int n = 0; n < 2; ++n) cc[bj][n] = f.col_begin(cbase + bj * 128 + 4 * n);
#pragma unroll
        for (int ai = 0; ai < 2; ++ai) {
            RowCtx rc[4]; float s[4], ss[4];
#pragma unroll
            for (int m = 0; m < 4; ++m) { const f32x2 t = has_stats ? tab[ai * 128 + m * 16] : (f32x2){0.f, 1.f}; rc[m].mu = t.x; rc[m].rstd = t.y; s[m] = 0.f; ss[m] = 0.f; }
#pragma unroll
            for (int bj = 0; bj < 2; ++bj) {
                const int col8 = cbase + bj * 128;
                f32x4 pre, nxt = f.row_load8(rbase + ai * 128, col8);
#pragma unroll
                for (int m = 0; m < 4; ++m) {
                    const int row = rbase + ai * 128 + m * 16;
                    pre = nxt;
                    if (F::PRELOAD && m < 3) nxt = f.row_load8(row + 16, col8);
                    const f32x4 y0 = f.compute(row, col8, acc[ai][bj][m][0], rc[m], cc[bj][0], pre.x, pre.y);
                    const f32x4 y1 = f.compute(row, col8 + 4, acc[ai][bj][m][1], rc[m], cc[bj][1], pre.z, pre.w);
                    if (F::STATS) { s[m] += ((y0.x + y0.y) + (y0.z + y0.w)) + ((y1.x + y1.y) + (y1.z + y1.w));
                        ss[m] += ((y0.x * y0.x + y0.y * y0.y) + (y0.z * y0.z + y0.w * y0.w)) + ((y1.x * y1.x + y1.y * y1.y) + (y1.z * y1.z + y1.w * y1.w)); }
                    f.store8(row, col8, y0, y1);
                }
            }
            if (F::STATS) {
#pragma unroll
                for (int m = 0; m < 4; ++m) {
                    float a = s[m], b = ss[m];
                    a += __shfl_xor(a, 16); a += __shfl_xor(a, 32); b += __shfl_xor(b, 16); b += __shfl_xor(b, 32);
                    if (fq == 0 && !f.is_dry()) *(f32x2*)(f.part_out + (size_t)(rbase + ai * 128 + m * 16) * 32 + (u.pn * 4 + wc) * 2) = (f32x2){a, b};
                }
            }
        }
    }
};

template <class F>
DI void sgemm_unit(LAS unsigned char* lds, const bf16_t* A, const bf16_t* Wt, int K, int col0, const F& f, int wid, int lane) {
    const int fr = lane & 15, fq = lane >> 4;
    const int kw = K >> 3;
    const bf16_t* ap = A + (size_t)fr * K + wid * kw + 8 * fq;
    const bf16_t* wp = Wt + (size_t)(col0 + fr) * K + wid * kw + 8 * fq;
    const int row = TP + wid * 16 + fr;
    const RowCtx rc = f.template row_begin<true>(row, fq);
    const ColCtx cc = f.col_begin(col0 + 4 * fq);
    const f32x4 pre = f.row_load4(row, col0 + 4 * fq);
    f32x4 acc[8];
#pragma unroll
    for (int i = 0; i < 8; ++i) acc[i] = (f32x4){0.f, 0.f, 0.f, 0.f};
#pragma unroll 2
    for (int k = 0; k < kw; k += 32) {
        const bf16x8 w = *(const bf16x8*)(wp + k);
#pragma unroll
        for (int mt = 0; mt < 8; ++mt) { const bf16x8 a = *(const bf16x8*)(ap + (size_t)mt * 16 * K + k); acc[mt] = mfma16(w, a, acc[mt]); }
    }
    LAS f32x4* red = (LAS f32x4*)lds;
#pragma unroll
    for (int mt = 0; mt < 8; ++mt) red[(wid * 8 + mt) * 64 + lane] = acc[mt];
    __syncthreads();
    f32x4 tot = (f32x4){0.f, 0.f, 0.f, 0.f};
#pragma unroll
    for (int s = 0; s < 8; ++s) tot += red[(s * 8 + wid) * 64 + lane];
    const f32x4 y = f.compute(row, col0 + 4 * fq, tot, rc, cc, pre.x, pre.y);
    f.store4(row, col0 + 4 * fq, y);
    if (F::STATS) {
        float s = (y.x + y.y) + (y.z + y.w), ss = (y.x * y.x + y.y * y.y) + (y.z * y.z + y.w * y.w);
        s += __shfl_xor(s, 16); s += __shfl_xor(s, 32); ss += __shfl_xor(ss, 16); ss += __shfl_xor(ss, 32);
        if (fq == 0 && !f.is_dry()) *(f32x2*)(f.part_out_s + (size_t)(row - TP) * 128 + (col0 >> 4) * 2) = (f32x2){s, ss};
    }
    __syncthreads();
}

DI void prep_deferred(const Params& p, int slot, LAS unsigned char* lds, int tid, int widx, int NW);
template <class F>
DI void gemm_all(LAS unsigned char* lds, const bf16_t* A, const bf16_t* Wt, int N, int K, int l, int which, int vb, int G, int tid) {
    int wid, lane; RELAUNDER();
    pg8::Gemm g{A, Wt, TP, N, K}; pg8::StaticOrder S; S.init(TP, N, G, vb);
    {
        const Params p = kparams();
        const F f = F::make(p, launder_i(l), which);
        const float* part = f.stats_src();
        if (part) {
            LAS f32x2* tab = (LAS f32x2*)(lds + STAT_TAB_OFF);
            const int r = tid >> 1, hlf = tid & 1;
            f32x4 v[4][4]; bool ok[4];
#pragma unroll
            for (int i = 0; i < 4; ++i) { pg8::Unit u; ok[i] = S.next(i, u); const int row = (ok[i] ? u.pm : 0) * 256 + r;
                const f32x4* pp = (const f32x4*)(part + (size_t)row * 32 + hlf * 16);
#pragma unroll
                for (int j = 0; j < 4; ++j) v[i][j] = pp[j]; }
#pragma unroll
            for (int i = 0; i < 4; ++i) {
                float s = 0.f, ss = 0.f;
#pragma unroll
                for (int j = 0; j < 4; ++j) { s += v[i][j].x + v[i][j].z; ss += v[i][j].y + v[i][j].w; }
                s += __shfl_xor(s, 1); ss += __shfl_xor(ss, 1);
                const float mu = s * (1.0f / 1024.0f), var = ss * (1.0f / 1024.0f) - mu * mu, rstd = rsqrtf(fmaxf(var, 0.f) + LN_EPS);
                if (hlf == 0) tab[i * 256 + r] = (f32x2){mu, rstd};
            }
        }
        __syncthreads();
    }
    const int nsu_ = N / 16;
    const bool s_first = false;
    if (F::STAGGER && (((vb >> 3) & 1) != 0) && (G & 15) == 0) {
        const Params p = kparams();
        prep_deferred(p, launder_i(l) + 1, lds, tid, ((vb >> 4) << 3) | (vb & 7), G >> 1);
        __syncthreads();
    }
    EpiWrap<F> E{l, which, lds};
    pg8::gemm_phase<EpiWrap<F>>(lds, g, S, E, tid);
    if (F::DEFERRED_PREP) {
        const int nwg = (TP / 256) * (N / 256), first = (nwg > G && nwg < 2 * G) ? (nwg - G) : 0;
        if (vb >= first) { const Params p = kparams(); prep_deferred(p, launder_i(l) + 3, lds, tid, vb - first, G - first); __syncthreads(); }
    }
    const int nsu = N / 16;
    const int su0 = G - 1 - vb;
    if (su0 < nsu && !s_first) {
        const Params p = kparams();
        const F f = F::make(p, launder_i(l), which);
        for (int su = su0; su < nsu; su += G) sgemm_unit<F>(lds, A + (size_t)TP * K, Wt, K, su * 16, f, wid, lane);
    }
}

DI void transpose_tile_load(const float* W, const float* gain, int N, int k0, int n0, int tid, f32x4 (&v)[8]) {
#pragma unroll
    for (int i = 0; i < 8; ++i) { const int e = tid + 512 * i, row = e >> 5, c4 = e & 31;
        f32x4 x = __builtin_nontemporal_load((const f32x4*)(W + (size_t)(k0 + row) * N + n0 + 4 * c4));
        if (gain) x = x * gain[k0 + row];
        v[i] = x; }
}
DI void transpose_tile_store(LAS float* T, bf16_t* WT, int K, int k0, int n0, int tid, const f32x4 (&v)[8]) {
#pragma unroll
    for (int i = 0; i < 8; ++i) { const int e = tid + 512 * i, row = e >> 5, c4 = e & 31; LAS float* d = T + row * 129 + 4 * c4; d[0] = v[i].x; d[1] = v[i].y; d[2] = v[i].z; d[3] = v[i].w; }
    __syncthreads();
#pragma unroll
    for (int i = 0; i < 4; ++i) { const int e = tid + 512 * i, n = e >> 4, c8 = e & 15; const LAS float* s = T + (8 * c8) * 129 + n;
        u32x4 o; o.x = pk2(s[0], s[129]); o.y = pk2(s[2 * 129], s[3 * 129]); o.z = pk2(s[4 * 129], s[5 * 129]); o.w = pk2(s[6 * 129], s[7 * 129]);
        *(u32x4*)(WT + (size_t)(n0 + n) * K + k0 + 8 * c8) = o; }
    __syncthreads();
}
struct TrJob { const float* W; const float* gain; bf16_t* WT; int K, N, k0, n0; };
DI TrJob tr_job(const Params& p, int which, int l, int item) {
    unsigned char* ws = p.ws; TrJob j;
    if (which == 0) { j.W = p.w_in + (size_t)l * 1024 * 1536; j.gain = l ? p.ln2_g : nullptr; j.WT = (bf16_t*)(ws + WS_WIN) + (size_t)l * 1536 * 1024; j.K = 1024; j.N = 1536; }
    else if (which == 1) { j.W = p.w_out + (size_t)l * 1024 * 1024; j.gain = nullptr; j.WT = (bf16_t*)(ws + WS_WOUT) + (size_t)l * 1024 * 1024; j.K = 1024; j.N = 1024; }
    else if (which == 2) { j.W = p.w_ff1 + (size_t)l * 1024 * 4096; j.gain = p.ln1_g + l * 1024; j.WT = (bf16_t*)(ws + WS_W1) + (size_t)l * 4096 * 1024; j.K = 1024; j.N = 4096; }
    else { j.W = p.w_ff2 + (size_t)l * 4096 * 1024; j.gain = nullptr; j.WT = (bf16_t*)(ws + WS_W2) + (size_t)l * 1024 * 4096; j.K = 4096; j.N = 1024; }
    const int nb = j.N / 128; j.k0 = (item / nb) * 128; j.n0 = (item % nb) * 128; return j;
}
DI TrJob tr_slot_job(const Params& p, int slot, int it) {
    if (slot == 0) { if (it < 96) return tr_job(p, 0, 0, it); return tr_job(p, 0, 1, it - 96); }
    if (slot <= 2) return tr_job(p, 3, slot - 1, it);
    if (it < 64) return tr_job(p, 1, slot - 3, it);
    return tr_job(p, 2, slot - 3, it - 64);
}
DI void transpose_slot(const Params& p, int slot, LAS unsigned char* lds, int tid, int widx, int NW) {
    const int nit = slot == 0 ? 192 : (slot <= 2 ? 256 : 320);
    LAS float* T = (LAS float*)lds;
    f32x4 v[8];
    int it = widx;
    if (it < nit) { const TrJob j = tr_slot_job(p, slot, it); transpose_tile_load(j.W, j.gain, j.N, j.k0, j.n0, tid, v); }
    for (; it < nit; it += NW) {
        const TrJob j = tr_slot_job(p, slot, it);
#pragma unroll
        for (int i = 0; i < 8; ++i) { const int e = tid + 512 * i, row = e >> 5, c4 = e & 31; LAS float* d = T + row * 129 + 4 * c4; d[0] = v[i].x; d[1] = v[i].y; d[2] = v[i].z; d[3] = v[i].w; }
        __syncthreads();
        if (it + NW < nit) { const TrJob jn = tr_slot_job(p, slot, it + NW); transpose_tile_load(jn.W, jn.gain, jn.N, jn.k0, jn.n0, tid, v); }
#pragma unroll
        for (int i = 0; i < 4; ++i) { const int e = tid + 512 * i, n = e >> 4, c8 = e & 15; const LAS float* s = T + (8 * c8) * 129 + n;
            u32x4 o; o.x = pk2(s[0], s[129]); o.y = pk2(s[2 * 129], s[3 * 129]); o.z = pk2(s[4 * 129], s[5 * 129]); o.w = pk2(s[6 * 129], s[7 * 129]);
            *(u32x4*)(j.WT + (size_t)(j.n0 + n) * j.K + j.k0 + 8 * c8) = o; }
        __syncthreads();
    }
}
DI void colsum_item(const float* W, const float* gain, const float* bias, int N, int c0, float* cs, float* bw, LAS float* red, int wid, int lane) {
    float s1 = 0.f, s2 = 0.f;
    const float* wp = W + (size_t)(wid * 128) * N + c0 + lane;
#pragma unroll 32
    for (int k = 0; k < 128; ++k) { const float w = wp[(size_t)k * N]; const int kk = wid * 128 + k; s1 += bfround(gain[kk] * w); s2 += bias[kk] * w; }
    red[wid * 128 + lane] = s1; red[wid * 128 + 64 + lane] = s2;
    __syncthreads();
    if (wid == 0) { float a = 0.f, b = 0.f;
#pragma unroll
        for (int w = 0; w < 8; ++w) { a += red[w * 128 + lane]; b += red[w * 128 + 64 + lane]; }
        cs[c0 + lane] = a; bw[c0 + lane] = b; }
    __syncthreads();
}
DI void prep_deferred(const Params& p, int slot, LAS unsigned char* lds, int tid, int widx, int NW) {
    tid = launder_v(tid);
    transpose_slot(p, slot, lds, tid, widx, NW);
}
DI void phase_prep(const Params& p, LAS unsigned char* lds, int tid, int wid, int lane, int vb, int G) {
    RELAUNDER();
    unsigned char* ws = p.ws;
    const int gw = vb * 8 + wid, NGW = G * 8;
    transpose_slot(p, 0, lds, tid, vb, G);
    bf16_t* YB = (bf16_t*)(ws + WS_YB);
    for (int m0 = gw; m0 < MT; m0 += 4 * NGW) {
        f32x4 v[4][4];
#pragma unroll
        for (int r = 0; r < 4; ++r) { const int m = m0 + r * NGW; const int mm = m < MT ? m : m0;
            const f32x4* src = (const f32x4*)(mm < TP ? p.xp + (size_t)mm * 1024 : p.xs + (size_t)(mm - TP) * 1024);
#pragma unroll
            for (int j = 0; j < 4; ++j) v[r][j] = __builtin_nontemporal_load(src + lane + 64 * j); }
#pragma unroll
        for (int r = 0; r < 4; ++r) { const int m = m0 + r * NGW;
            if (m < MT) {
#pragma unroll
                for (int j = 0; j < 4; ++j) st_bf4(YB + (size_t)m * 1024 + 4 * (lane + 64 * j), v[r][j]); } }
    }
#pragma unroll
    for (int which = 0; which < 3; ++which) {
        const float* src = which == 0 ? p.ga_w : (which == 1 ? p.gx_w : p.pool_w);
        bf16_t* dst = (bf16_t*)(ws + (which == 0 ? WS_GAT : (which == 1 ? WS_GXT : WS_PWT)));
        for (int r = vb * NTHR + tid; r < 32768; r += G * NTHR) {
            const int ln = r >> 12, d = (r >> 6) & 63, c = r & 63;
            dst[r] = (bf16_t)(pk2(src[(ln << 12) + c * 64 + d], 0.f) & 0xffffu);
        }
    }
    __syncthreads();
}

DI void attn_item(const Params& p, int layer, int item, LAS unsigned char* lds, int tid, int wid, int lane) {
    RELAUNDER();
    const int kvh = item & 1, qb = (item >> 1) & 31, b = item >> 6;
    const bf16_t* QKV = (const bf16_t*)(p.ws + WS_QKV); bf16_t* MIX = (bf16_t*)(p.ws + WS_MIX);
    LAS bf16_t* Ks = (LAS bf16_t*)lds;
    LAS bf16_t* Vt = (LAS bf16_t*)(lds + 36864);
    {
        const int key = tid >> 1, half = tid & 1; const int tok = qb * 128 - 128 + key;
        u32x4 kv[4], vv[4];
        if (tok >= 0) { const bf16_t* src = QKV + ((size_t)b * 4096 + tok) * 768 + 512 + kvh * 64 + half * 32;
#pragma unroll
            for (int i = 0; i < 4; ++i) { kv[i] = ((const u32x4*)src)[i]; vv[i] = ((const u32x4*)(src + 128))[i]; } }
        else {
#pragma unroll
            for (int i = 0; i < 4; ++i) { kv[i] = (u32x4){0u, 0u, 0u, 0u}; vv[i] = (u32x4){0u, 0u, 0u, 0u}; } }
#pragma unroll
        for (int i = 0; i < 4; ++i) *(LAS u32x4*)(Ks + key * 72 + half * 32 + 8 * i) = kv[i];
#pragma unroll
        for (int i = 0; i < 4; ++i)
#pragma unroll
            for (int e = 0; e < 8; ++e) { const int d = half * 32 + 8 * i + e; Vt[d * 264 + key] = (bf16_t)((vv[i][e >> 1] >> (16 * (e & 1))) & 0xffffu); }
    }
    __syncthreads();
    const int g = wid >> 1, qh = wid & 1, h = kvh * 4 + g, fr = lane & 15, fq = lane >> 4;
    const float slope2 = exp2f(-(float)(h + 1)) * LOG2E, sink2 = p.sinks[layer * 8 + h] * LOG2E;
    const size_t rowbase = (size_t)b * 4096 + qb * 128;
    bf16x8 qall[4][2];
#pragma unroll
    for (int qt = 0; qt < 4; ++qt) { const bf16_t* qp = QKV + (rowbase + qh * 64 + qt * 16 + fr) * 768 + h * 64 + 8 * fq; qall[qt][0] = *(const bf16x8*)qp; qall[qt][1] = *(const bf16x8*)(qp + 32); }
#pragma unroll
    for (int qt = 0; qt < 4; ++qt) {
        const int i0 = qh * 64 + qt * 16, jb = 32 * ((qh * 4 + qt) >> 1), iq = i0 + fr;
        const bf16x8 q0 = qall[qt][0], q1 = qall[qt][1];
        f32x4 s[10];
        float mx = sink2;
        const bool odd = (qt & 1) != 0;
        if (qb > 0) {
            const float t0 = -slope2 * (float)(iq + 128 - jb - 4 * fq);
            const float tb0 = t0, tb1 = t0 + slope2, tb2 = t0 + 2.0f * slope2, tb3 = t0 + 3.0f * slope2;
#pragma unroll
            for (int kt = 0; kt < 10; ++kt) {
                const bool dead = odd ? (kt == 0) : (kt == 9);
                if (dead) { s[kt] = (f32x4){0.f, 0.f, 0.f, 0.f}; continue; }
                const float c = slope2 * (float)(16 * kt);
                const LAS bf16_t* kp = Ks + (jb + 16 * kt + fr) * 72 + 8 * fq;
                const bf16x8 k0 = *(const LAS bf16x8*)kp, k1 = *(const LAS bf16x8*)(kp + 32);
                s[kt] = mfma16(k0, q0, (f32x4){tb0 + c, tb1 + c, tb2 + c, tb3 + c}); s[kt] = mfma16(k1, q1, s[kt]);
                const bool lo = odd ? (kt == 1) : (kt == 0), hi = odd ? (kt == 9) : (kt == 8);
#pragma unroll
                for (int i = 0; i < 4; ++i) {
                    if (lo) s[kt][i] = (4 * fq + i >= fr) ? s[kt][i] : -1e30f;
                    if (hi) s[kt][i] = (4 * fq + i <= fr) ? s[kt][i] : -1e30f;
                    mx = fmaxf(mx, s[kt][i]); }
            }
        } else {
#pragma unroll
            for (int kt = 0; kt < 10; ++kt) { const LAS bf16_t* kp = Ks + (jb + 16 * kt + fr) * 72 + 8 * fq;
                const bf16x8 k0 = *(const LAS bf16x8*)kp, k1 = *(const LAS bf16x8*)(kp + 32);
                s[kt] = mfma16(k0, q0, (f32x4){0.f, 0.f, 0.f, 0.f}); s[kt] = mfma16(k1, q1, s[kt]); }
#pragma unroll
            for (int kt = 0; kt < 10; ++kt)
#pragma unroll
                for (int i = 0; i < 4; ++i) { const int j = jb + 16 * kt + 4 * fq + i, delta = iq + 128 - j;
                    const bool valid = (delta >= 0) && (delta <= 128) && (j >= 128);
                    const float v = s[kt][i] - slope2 * (float)delta;
                    s[kt][i] = valid ? v : -1e30f; mx = fmaxf(mx, s[kt][i]); }
        }
        mx = fmaxf(mx, __shfl_xor(mx, 16)); mx = fmaxf(mx, __shfl_xor(mx, 32));
        float sum = 0.f;
#pragma unroll
        for (int kt = 0; kt < 10; ++kt) {
            if (qb > 0 && (odd ? (kt == 0) : (kt == 9))) continue;
#pragma unroll
            for (int i = 0; i < 4; ++i) { const float pv = __builtin_amdgcn_exp2f(s[kt][i] - mx); s[kt][i] = pv; sum += pv; }
        }
        sum += __shfl_xor(sum, 16); sum += __shfl_xor(sum, 32);
        const float inv = 1.0f / (sum + __builtin_amdgcn_exp2f(sink2 - mx));
        bf16x8 pf[5];
#pragma unroll
        for (int G = 0; G < 5; ++G) pf[G] = pack8(s[2 * G], s[2 * G + 1]);
#pragma unroll
        for (int dt = 0; dt < 4; ++dt) {
            f32x4 o = (f32x4){0.f, 0.f, 0.f, 0.f};
#pragma unroll
            for (int G = 0; G < 5; ++G) { const LAS bf16_t* vp = Vt + (16 * dt + fr) * 264 + jb + 32 * G + 4 * fq;
                const u32x2 lo = *(const LAS u32x2*)vp, hi = *(const LAS u32x2*)(vp + 16);
                const u32x4 w = (u32x4){lo.x, lo.y, hi.x, hi.y};
                o = mfma16(__builtin_bit_cast(bf16x8, w), pf[G], o); }
            st_bf4(MIX + (rowbase + iq) * 1024 + h * 64 + 16 * dt + 4 * fq, o * inv);
        }
    }
    __syncthreads();
}

DI void sattn_item(const Params& p, int layer, int j, LAS unsigned char* lds, int tid, int wid, int lane) {
    RELAUNDER();
    LAS float* Kc = (LAS float*)lds;
    LAS float* Vc = Kc + 129 * 132;
    LAS float* Ps = Vc + 129 * 132;
    LAS float* Qs = Ps + 8 * 132;
    const size_t cbase = ((size_t)(layer * 128 + j)) * 128 * 128;
    const f32x4* ck = (const f32x4*)(p.ck + cbase); const f32x4* cv = (const f32x4*)(p.cv + cbase);
    f32x4* sk = (f32x4*)(p.out + O_SK + cbase); f32x4* sv = (f32x4*)(p.out + O_SV + cbase);
#pragma unroll
    for (int i = 0; i < 8; ++i) { const int idx = tid + 512 * i, s = idx >> 5, c4 = idx & 31;
        const f32x4 kv = __builtin_nontemporal_load(ck + idx), vv = __builtin_nontemporal_load(cv + idx);
        *(LAS f32x4*)(Kc + s * 132 + 4 * c4) = kv; *(LAS f32x4*)(Vc + s * 132 + 4 * c4) = vv;
        if (s >= 1) { __builtin_nontemporal_store(kv, sk + (idx - 32)); __builtin_nontemporal_store(vv, sv + (idx - 32)); } }
    if (tid < 32) *(LAS f32x4*)(Kc + 128 * 132 + 4 * tid) = sk[127 * 32 + tid];
    else if (tid < 64) *(LAS f32x4*)(Vc + 128 * 132 + 4 * (tid - 32)) = sv[127 * 32 + (tid - 32)];
    const bf16_t* QKV = (const bf16_t*)(p.ws + WS_QKV);
    Qs[tid] = bf2f(QKV[(size_t)(TP + j) * 768 + tid]);
    __syncthreads();
    const int h = wid, kvh = h >> 2;
    const float slope = exp2f(-(float)(h + 1)), sink2 = p.sinks[layer * 8 + h] * LOG2E;
    float sc[3];
#pragma unroll
    for (int r = 0; r < 3; ++r) {
        const int s = (r < 2) ? lane + 64 * r : 128;
        const LAS f32x4* kp = (const LAS f32x4*)(Kc + s * 132 + kvh * 64); const LAS f32x4* qp = (const LAS f32x4*)(Qs + h * 64);
        float d = 0.f;
#pragma unroll
        for (int i = 0; i < 16; ++i) { const f32x4 a = kp[i], q = qp[i]; d += (a.x * q.x + a.y * q.y) + (a.z * q.z + a.w * q.w); }
        const float delta = (float)(128 - s);
        sc[r] = d - slope * LOG2E * delta;
        if (r == 2 && lane != 0) sc[r] = -1e30f;
    }
    float mx = fmaxf(fmaxf(sc[0], sc[1]), fmaxf(sc[2], sink2));
#pragma unroll
    for (int o = 1; o < 64; o <<= 1) mx = fmaxf(mx, __shfl_xor(mx, o));
    float sum = 0.f;
#pragma unroll
    for (int r = 0; r < 3; ++r) { sc[r] = __builtin_amdgcn_exp2f(sc[r] - mx); sum += sc[r]; }
#pragma unroll
    for (int o = 1; o < 64; o <<= 1) sum += __shfl_xor(sum, o);
    const float inv = 1.0f / (sum + __builtin_amdgcn_exp2f(sink2 - mx));
    Ps[h * 132 + lane] = sc[0]; Ps[h * 132 + 64 + lane] = sc[1]; if (lane == 0) Ps[h * 132 + 128] = sc[2];
    lds_wait();
    float o = 0.f;
#pragma unroll 8
    for (int s = 0; s < 129; ++s) o += Ps[h * 132 + s] * Vc[s * 132 + kvh * 64 + lane];
    bf16_t* MIX = (bf16_t*)(p.ws + WS_MIX);
    MIX[(size_t)(TP + j) * 1024 + h * 64 + lane] = (bf16_t)(pk2(o * inv, 0.f) & 0xffffu);
    __syncthreads();
}

DI float fsigmoid(float x) { return __builtin_amdgcn_rcpf(1.0f + __builtin_amdgcn_exp2f(-LOG2E * x)); }
DI void rglru_item(const Params& p, int layer, int item, LAS unsigned char* lds, int tid, int wid, int lane) {
    RELAUNDER();
    LAS float* XC = (LAS float*)lds;
    const bf16_t* U2 = (const bf16_t*)(p.ws + WS_U2);
    const int ti = item >> 1, chalf = item & 1;
    const bool smp = (ti == 128);
    const int b = ti >> 5, ch = ti & 31;
    {
        const int cq = tid & 31, tg = tid >> 5, cqg = chalf * 32 + cq;
        const f32x4 cb = ((const f32x4*)(p.conv_b + layer * 256))[cqg];
        f32x4 cw[4];
#pragma unroll
        for (int t = 0; t < 4; ++t) cw[t] = ((const f32x4*)(p.conv_w + (layer * 4 + t) * 256))[cqg];
        if (!smp) {
            f32x4 x[11];
#pragma unroll
            for (int k = 0; k < 11; ++k) { const int t = ch * 128 + 8 * tg - 3 + k;
                x[k] = (t >= 0) ? ld_bf4(U2 + ((size_t)b * 4096 + t) * 768 + 4 * cqg) : (f32x4){0.f, 0.f, 0.f, 0.f}; }
#pragma unroll
            for (int k = 0; k < 8; ++k) { const f32x4 xc = cb + cw[0] * x[k] + cw[1] * x[k + 1] + cw[2] * x[k + 2] + cw[3] * x[k + 3];
                *(LAS f32x4*)(XC + (8 * tg + k) * 132 + 4 * cq) = xc; }
            if (ch == 31 && tg == 15) { f32x4* pc = (f32x4*)(p.out + O_PC + (size_t)(layer * 4 + b) * 3 * 256);
                pc[0 * 64 + cqg] = x[8]; pc[1 * 64 + cqg] = x[9]; pc[2 * 64 + cqg] = x[10]; }
        } else {
#pragma unroll 4
            for (int k = 0; k < 8; ++k) { const int j = 8 * tg + k;
                const f32x4* scp = (const f32x4*)(p.sc + (size_t)(layer * 128 + j) * 3 * 256);
                const f32x4 s0 = scp[cqg], s1 = scp[64 + cqg], s2 = scp[128 + cqg], xr = ld_bf4(U2 + (size_t)(TP + j) * 768 + 4 * cqg);
                const f32x4 xc = cb + cw[0] * s0 + cw[1] * s1 + cw[2] * s2 + cw[3] * xr;
                *(LAS f32x4*)(XC + j * 132 + 4 * cq) = xc;
                f32x4* oc = (f32x4*)(p.out + O_SC + (size_t)(layer * 128 + j) * 3 * 256);
                oc[cqg] = s1; oc[64 + cqg] = s2; oc[128 + cqg] = xr; }
        }
    }
    __syncthreads();
    const int nl = wid >> 2, n = 2 * chalf + nl, fr = lane & 15, fq = lane >> 4;
    const int d = 16 * (wid & 3) + fr, cl = 64 * nl + d, c = 128 * chalf + cl;
    const bf16_t* GaT = (const bf16_t*)(p.ws + WS_GAT); const bf16_t* GxT = (const bf16_t*)(p.ws + WS_GXT);
    bf16x8 wa[2], wx[2];
#pragma unroll
    for (int ks = 0; ks < 2; ++ks) { const size_t o = ((size_t)((layer * 4 + n) * 64 + d)) * 64 + 32 * ks + 8 * fq; wa[ks] = *(const bf16x8*)(GaT + o); wx[ks] = *(const bf16x8*)(GxT + o); }
    const float ba = p.ga_b[layer * 256 + c], bx = p.gx_b[layer * 256 + c];
    const float spv = -8.0f * LOG2E * log1pf(__expf(-p.lam[layer * 256 + c]));
    float Ac = 1.f, Bc = 0.f;
    unsigned* HC = (unsigned*)(p.ws + WS_HL);
    bf16_t* MIX = (bf16_t*)(p.ws + WS_MIX);
    for (int tt = 0; tt < 8; ++tt) {
        bf16x8 af[2];
#pragma unroll
        for (int ks = 0; ks < 2; ++ks) { const LAS f32x4* src = (const LAS f32x4*)(XC + (16 * tt + fr) * 132 + 64 * nl + 32 * ks + 8 * fq); af[ks] = pack8(src[0], src[1]); }
        f32x4 ar = (f32x4){0.f, 0.f, 0.f, 0.f}, ai = (f32x4){0.f, 0.f, 0.f, 0.f};
#pragma unroll
        for (int ks = 0; ks < 2; ++ks) { ar = mfma16(af[ks], wa[ks], ar); ai = mfma16(af[ks], wx[ks], ai); }
        float av[4], bv[4];
#pragma unroll
        for (int i = 0; i < 4; ++i) { const int t = 16 * tt + 4 * fq + i; const float xcv = XC[t * 132 + cl];
            const float r = fsigmoid(ar[i] + ba), ig = fsigmoid(ai[i] + bx);
            const float a = __builtin_amdgcn_exp2f(spv * r);
            av[i] = a; bv[i] = __builtin_amdgcn_sqrtf(fmaxf(1.0f - a * a, 0.f)) * (ig * xcv); }
        if (smp) {
#pragma unroll
            for (int i = 0; i < 4; ++i) { const int j = 16 * tt + 4 * fq + i;
                const float h0 = p.sh[(size_t)(layer * 128 + j) * 256 + c];
                const float hv = av[i] * h0 + bv[i];
                p.out[O_SH + (size_t)(layer * 128 + j) * 256 + c] = hv;
                const float gr = bf2f(U2[(size_t)(TP + j) * 768 + 256 + c]);
                MIX[(size_t)(TP + j) * 1024 + 512 + c] = (bf16_t)(pk2(hv * gelu_tanh(gr), 0.f) & 0xffffu); }
        } else {
            float A4 = 1.f, B4 = 0.f;
#pragma unroll
            for (int i = 0; i < 4; ++i) { B4 = av[i] * B4 + bv[i]; A4 *= av[i]; }
            { const float A1 = __shfl_up(A4, 16), B1 = __shfl_up(B4, 16); if (fq >= 1) { B4 = A4 * B1 + B4; A4 = A4 * A1; } }
            { const float A2 = __shfl_up(A4, 32), B2 = __shfl_up(B4, 32); if (fq >= 2) { B4 = A4 * B2 + B4; A4 = A4 * A2; } }
            float Ae = __shfl_up(A4, 16), Be = __shfl_up(B4, 16); if (fq == 0) { Ae = 1.f; Be = 0.f; }
            const float At = __shfl(A4, 48 + fr), Bt = __shfl(B4, 48 + fr);
            float Ain = Ac * Ae, hin = Ae * Bc + Be;
#pragma unroll
            for (int i = 0; i < 4; ++i) { hin = av[i] * hin + bv[i]; Ain *= av[i];
                const size_t o = ((size_t)b * 4096 + ch * 128 + 16 * tt + 4 * fq + i) * 256 + c;
                HC[o] = pk2(hin, Ain); }
            Bc = At * Bc + Bt; Ac *= At;
        }
    }
    if (!smp && fq == 0) { ((float*)(p.ws + WS_AGA))[ti * 256 + c] = Ac; ((float*)(p.ws + WS_AGB))[ti * 256 + c] = Bc; }
    __syncthreads();
}

DI void rowsum_rows(const bf16_t* WT, const float* gain, const float* bias, int nrows, float* cs, float* bw, int gw, int NGW, int lane) {
    f32x4 r4[4];
#pragma unroll
    for (int j = 0; j < 4; ++j) { const f32x4 g4 = ((const f32x4*)gain)[lane * 4 + j], b4 = ((const f32x4*)bias)[lane * 4 + j]; r4[j] = b4 / g4; }
    for (int n = gw; n < nrows; n += NGW) {
        const u32x4* wp = (const u32x4*)(WT + (size_t)n * 1024 + 16 * lane);
        const u32x4 w0 = wp[0], w1 = wp[1];
        float s = 0.f, t = 0.f;
        const unsigned ww[8] = {w0.x, w0.y, w0.z, w0.w, w1.x, w1.y, w1.z, w1.w};
#pragma unroll
        for (int q = 0; q < 8; ++q) { const float lo = __uint_as_float(ww[q] << 16), hi = __uint_as_float(ww[q] & 0xffff0000u);
            s += lo + hi; t += lo * r4[q >> 1][(q & 1) * 2] + hi * r4[q >> 1][(q & 1) * 2 + 1]; }
#pragma unroll
        for (int o = 1; o < 64; o <<= 1) { s += __shfl_xor(s, o); t += __shfl_xor(t, o); }
        if (lane == 0) { cs[n] = s; bw[n] = t; }
    }
}

DI void fixup_item(const Params& p, int layer, int item, int tid) {
    tid = launder_v(tid);
    const int ti = item >> 2, qr = item & 3;
    const int b = ti >> 5, ch = ti & 31, c = tid & 255, half = tid >> 8;
    const float* AGA = (const float*)(p.ws + WS_AGA); const float* AGB = (const float*)(p.ws + WS_AGB);
    float carry = 0.f;
    {
        float ca[31], cb[31];
#pragma unroll
        for (int j = 0; j < 31; ++j) { const bool on = j < ch; ca[j] = on ? AGA[(b * 32 + j) * 256 + c] : 1.f; cb[j] = on ? AGB[(b * 32 + j) * 256 + c] : 0.f; }
#pragma unroll
        for (int j = 0; j < 31; ++j) carry = ca[j] * carry + cb[j];
    }
    const unsigned* HC = (const unsigned*)(p.ws + WS_HL); const bf16_t* U2 = (const bf16_t*)(p.ws + WS_U2);
    bf16_t* MIX = (bf16_t*)(p.ws + WS_MIX);
    const size_t row0 = (size_t)b * 4096 + ch * 128 + qr * 32 + half * 16;
    unsigned hc[16]; float grv[16];
#pragma unroll
    for (int k = 0; k < 16; ++k) { hc[k] = __builtin_nontemporal_load(HC + (row0 + k) * 256 + c); grv[k] = bf2f(__builtin_nontemporal_load(U2 + (row0 + k) * 768 + 256 + c)); }
    float h = 0.f;
#pragma unroll
    for (int k = 0; k < 16; ++k) { h = __uint_as_float(hc[k] << 16) + __uint_as_float(hc[k] & 0xffff0000u) * carry; MIX[(row0 + k) * 1024 + 512 + c] = (bf16_t)(pk2(h * gelu_tanh(grv[k]), 0.f) & 0xffffu); }
    if (ch == 31 && qr == 3 && half == 1) p.out[O_PH + (size_t)(layer * 4 + b) * 256 + c] = AGA[(b * 32 + 31) * 256 + c] * carry + AGB[(b * 32 + 31) * 256 + c];
}

DI void st_bf4_lds(LAS bf16_t* dst, f32x4 v) { u32x2 w; w.x = pk2(v.x, v.y); w.y = pk2(v.z, v.w); *(LAS u32x2*)dst = w; }
DI void pool_item(const Params& p, int layer, int ti, LAS unsigned char* lds, int tid, int wid, int lane) {
    RELAUNDER();
    LAS float* Zs = (LAS float*)lds;
    LAS bf16_t* Ds = (LAS bf16_t*)(lds + 48128);
    LAS bf16_t* Pw = (LAS bf16_t*)(lds + 115712);
    LAS float* Sc = (LAS float*)(lds + 152576);
    const bf16_t* U2 = (const bf16_t*)(p.ws + WS_U2);
    const bool smp = (ti >= 128);
    const int b = ti >> 5, ch = ti & 31;
    const int cq = tid & 63, gq = cq >> 4, tg = tid >> 6;
    const float wf = (float)(2 << gq);
    {
        const bf16_t* PwT = (const bf16_t*)(p.ws + WS_PWT) + (size_t)layer * 4 * 64 * 64;
#pragma unroll
        for (int i = 0; i < 4; ++i) { const int idx = tid + 512 * i, rowi = idx >> 3, c8 = idx & 7;
            *(LAS u32x4*)(Pw + rowi * 72 + 8 * c8) = *(const u32x4*)(PwT + (size_t)rowi * 64 + 8 * c8); }
        if (tid < 64) *(LAS f32x4*)(Sc + 4 * tid) = ((const f32x4*)(p.pool_scale + layer * 256))[tid];
    }
    if (!smp) {
        if (ch == 31) {
            for (int idx = tid; idx < 15 * 64; idx += NTHR) { const int r = idx >> 6, c4 = idx & 63;
                ((f32x4*)(p.out + O_PP + ((size_t)(layer * 4 + b) * 15 + r) * 256))[c4] = ld_bf4(U2 + ((size_t)b * 4096 + 4081 + r) * 768 + 512 + 4 * c4); }
        }
        f32x4 pf[6];
#pragma unroll
        for (int i = 0; i < 6; ++i) { const int e = tid + 512 * i, r = e >> 6, c4 = e & 63, t = ch * 128 - 15 + r;
            pf[i] = (e < 47 * 64 && t >= 0) ? ld_bf4(U2 + ((size_t)b * 4096 + t) * 768 + 512 + 4 * c4) : (f32x4){0.f, 0.f, 0.f, 0.f}; }
        for (int q = 0; q < 4; ++q) {
#pragma unroll
            for (int i = 0; i < 6; ++i) { const int e = tid + 512 * i; if (e < 47 * 64) *(LAS f32x4*)(Zs + 4 * e) = pf[i]; }
            __syncthreads();
            if (q < 3) {
#pragma unroll
                for (int i = 0; i < 6; ++i) { const int e = tid + 512 * i, r = e >> 6, c4 = e & 63, t = ch * 128 + 32 * (q + 1) - 15 + r;
                    pf[i] = (e < 47 * 64 && t >= 0) ? ld_bf4(U2 + ((size_t)b * 4096 + t) * 768 + 512 + 4 * c4) : (f32x4){0.f, 0.f, 0.f, 0.f}; }
            }
            f32x4 v[19], zs[4], res[4];
#pragma unroll
            for (int k = 0; k < 19; ++k) v[k] = *(const LAS f32x4*)(Zs + (4 * tg + k) * 256 + 4 * cq);
#pragma unroll
            for (int j = 0; j < 4; ++j) zs[j] = v[15 + j];
#pragma unroll
            for (int k = 18; k >= 1; --k) v[k] += v[k - 1];
#pragma unroll
            for (int j = 0; j < 4; ++j) res[j] = v[15 + j];
#pragma unroll
            for (int k = 18; k >= 3; --k) v[k] += v[k - 2];
#pragma unroll
            for (int j = 0; j < 4; ++j) res[j] = (gq >= 1) ? v[15 + j] : res[j];
#pragma unroll
            for (int k = 18; k >= 7; --k) v[k] += v[k - 4];
#pragma unroll
            for (int j = 0; j < 4; ++j) res[j] = (gq >= 2) ? v[15 + j] : res[j];
#pragma unroll
            for (int k = 18; k >= 15; --k) v[k] += v[k - 8];
#pragma unroll
            for (int j = 0; j < 4; ++j) res[j] = (gq >= 3) ? v[15 + j] : res[j];
#pragma unroll
            for (int j = 0; j < 4; ++j) { const int tl = 32 * q + 4 * tg + j; const float rc = __builtin_amdgcn_rcpf(fminf((float)(ch * 128 + tl + 1), wf));
                const f32x4 diff = res[j] * rc - zs[j];
                st_bf4_lds(Ds + tl * 264 + 4 * cq, diff); }
            __syncthreads();
        }
    } else {
        const int j0 = 32 * (ti - 128);
        const float rw = 1.0f / wf;
#pragma unroll 2
        for (int k = 0; k < 4; ++k) { const int jl = 4 * tg + k, j = j0 + jl;
            const f32x4* sp = (const f32x4*)(p.spool + (size_t)(layer * 128 + j) * 15 * 256);
            f32x4 st[15];
#pragma unroll
            for (int r = 0; r < 15; ++r) st[r] = sp[r * 64 + cq];
            const f32x4 z = ld_bf4(U2 + (size_t)(TP + j) * 768 + 512 + 4 * cq);
            const f32x4 s2 = z + st[14];
            const f32x4 s4 = s2 + (st[13] + st[12]);
            const f32x4 s8 = s4 + ((st[11] + st[10]) + (st[9] + st[8]));
            const f32x4 s16 = s8 + (((st[7] + st[6]) + (st[5] + st[4])) + ((st[3] + st[2]) + (st[1] + st[0])));
            const f32x4 rs = (gq == 0) ? s2 : ((gq == 1) ? s4 : ((gq == 2) ? s8 : s16));
            const f32x4 diff = rs * rw - z;
            st_bf4_lds(Ds + jl * 264 + 4 * cq, diff);
            f32x4* op = (f32x4*)(p.out + O_SP + (size_t)(layer * 128 + j) * 15 * 256);
#pragma unroll
            for (int r = 0; r < 14; ++r) op[r * 64 + cq] = st[r + 1];
            op[14 * 64 + cq] = z; }
        __syncthreads();
    }
    const int fr = lane & 15, fq = lane >> 4;
    bf16_t* MIX = (bf16_t*)(p.ws + WS_MIX);
    if (!smp || wid < 2) {
        const size_t row = smp ? (size_t)(TP + 32 * (ti - 128) + 16 * wid + fr) : ((size_t)b * 4096 + ch * 128 + 16 * wid + fr);
#pragma unroll
        for (int g = 0; g < 4; ++g) {
            bf16x8 bfr[2];
#pragma unroll
            for (int ks = 0; ks < 2; ++ks) bfr[ks] = *(const LAS bf16x8*)(Ds + (16 * wid + fr) * 264 + 64 * g + 32 * ks + 8 * fq);
#pragma unroll
            for (int dt = 0; dt < 4; ++dt) {
                f32x4 o = (f32x4){0.f, 0.f, 0.f, 0.f};
#pragma unroll
                for (int ks = 0; ks < 2; ++ks) { const bf16x8 a = *(const LAS bf16x8*)(Pw + (g * 64 + 16 * dt + fr) * 72 + 32 * ks + 8 * fq); o = mfma16(a, bfr[ks], o); }
                const int c = 64 * g + 16 * dt + 4 * fq;
                const f32x4 sc4 = *(const LAS f32x4*)(Sc + c);
                st_bf4(MIX + row * 1024 + 768 + c, o * sc4);
            }
        }
    }
    __syncthreads();
}

DI void final_ln(const Params& p, int vb, int G, int tid) {
    int wid, lane; RELAUNDER();
    const float* part = (const float*)(p.ws + WS_ST2); const float* part_s = (const float*)(p.ws + WS_STS2);
    const bf16_t* YB = (const bf16_t*)(p.ws + WS_YB);
    const f32x4* g = (const f32x4*)(p.ln2_g + 1024); const f32x4* bb = (const f32x4*)(p.ln2_b + 1024);
    f32x4 g4[4], b4[4];
#pragma unroll
    for (int j = 0; j < 4; ++j) { g4[j] = g[lane + 64 * j]; b4[j] = bb[lane + 64 * j]; }
    const int gw = vb * 8 + wid, NGW = G * 8;
    for (int row0 = gw; row0 < MT; row0 += 4 * NGW) {
        f32x4 y[4][4]; float mu[4], rs[4];
#pragma unroll
        for (int r = 0; r < 4; ++r) { const int row = (row0 + r * NGW < MT) ? row0 + r * NGW : row0;
#pragma unroll
            for (int j = 0; j < 4; ++j) y[r][j] = ld_bf4_nt(YB + (size_t)row * 1024 + 4 * (lane + 64 * j));
            row_stats_any(part, part_s, row, lane >> 4, mu[r], rs[r]); }
#pragma unroll
        for (int r = 0; r < 4; ++r) { const int row = row0 + r * NGW;
            if (row < MT) { f32x4* op = (f32x4*)(p.out + (size_t)row * 1024);
#pragma unroll
                for (int j = 0; j < 4; ++j) __builtin_nontemporal_store((y[r][j] - mu[r]) * rs[r] * g4[j] + b4[j], op + lane + 64 * j); } }
    }
}

#define XB_TMO      128
#define XB_XCNT(j)  (256  + 64 * (j))
#define XB_XSUB(j)  (1280 + 64 * (j))
#define XB_XGEN(j)  (2304 + 64 * (j))
#define XB_TOP      3328
#define XB_TOPGEN   3392
#define XCD_BAR_WORDS 3456
#define XB_SPIN_CAP (1u << 22)
DI unsigned xb_ld(unsigned* p)              { return __hip_atomic_load(p, __ATOMIC_RELAXED, __HIP_MEMORY_SCOPE_AGENT); }
DI unsigned xb_add(unsigned* p, unsigned v) { return __hip_atomic_fetch_add(p, v, __ATOMIC_RELAXED, __HIP_MEMORY_SCOPE_AGENT); }
DI unsigned xb_xcc_id() { return (unsigned)__builtin_amdgcn_s_getreg((3 << 11) | 20) & 0xFu; }
#define XB_SPIN(cond, bar) do { unsigned _sp = 0; while (cond) { __builtin_amdgcn_s_sleep(1); \
    if ((++_sp & 255u) == 0u) { if (xb_ld(&(bar)[XB_TMO])) break; if (_sp > XB_SPIN_CAP) { atomicAdd(&(bar)[XB_TMO], 1u); break; } } } } while (0)
DI void xcd_barrier_complete(unsigned* bar, unsigned x, unsigned& nloc, unsigned& nx) {
    const unsigned G = gridDim.x;
    unsigned sum, cnt, mine, sp = 0u;
    for (;;) {
        sum = 0u; cnt = 0u; mine = 0u;
#pragma unroll
        for (unsigned j = 0; j < 16; ++j) { const unsigned c = xb_ld(&bar[XB_XCNT(j)]); sum += c; cnt += (c > 0u) ? 1u : 0u; mine = (j == x) ? c : mine; }
        if (sum == G) break;
        __builtin_amdgcn_s_sleep(1);
        if ((++sp & 255u) == 0u) { if (xb_ld(&bar[XB_TMO])) break; if (sp > XB_SPIN_CAP) { atomicAdd(&bar[XB_TMO], 1u); break; } }
    }
    nloc = mine > 0u ? mine : 1u; nx = cnt > 0u ? cnt : 1u;
}
DI void xcd_barrier(unsigned* bar, volatile LAS unsigned* st) {
    asm volatile("s_waitcnt vmcnt(0)" ::: "memory");
    __syncthreads();
    if (threadIdx.x == 0) {
        const unsigned x = xb_xcc_id();
        __builtin_amdgcn_s_waitcnt(0);
        unsigned nloc = st[0], nx = st[1];
        if (nloc == 0u) { xcd_barrier_complete(bar, x, nloc, nx); st[0] = nloc; st[1] = nx; }
        const unsigned old = xb_add(&bar[XB_XSUB(x)], 1u);
        const unsigned gen = old / nloc;
        if (old + 1u == (gen + 1u) * nloc) {
            __builtin_amdgcn_fence(__ATOMIC_RELEASE, "agent");
            asm volatile("s_waitcnt vmcnt(0)" ::: "memory");
            const unsigned og = xb_add(&bar[XB_TOP], 1u);
            const unsigned tg = og / nx;
            if (og + 1u == (tg + 1u) * nx) xb_add(&bar[XB_TOPGEN], 1u);
            else XB_SPIN(xb_ld(&bar[XB_TOPGEN]) == tg, bar);
            __builtin_amdgcn_fence(__ATOMIC_ACQUIRE, "agent");
            xb_add(&bar[XB_XGEN(x)], 1u);
            asm volatile("s_waitcnt vmcnt(0)" ::: "memory");
        } else {
            XB_SPIN(xb_ld(&bar[XB_XGEN(x)]) == gen, bar);
            __builtin_amdgcn_fence(__ATOMIC_ACQUIRE, "agent");
            asm volatile("s_waitcnt vmcnt(0)" ::: "memory");
        }
    }
    __syncthreads();
}

DI int launder_i_unused(int x) { asm volatile("" : "+s"(x)); return x; }

__global__ void __launch_bounds__(NTHR, 2) hybrid_fwd(Params p_unused) {
    extern __shared__ __attribute__((aligned(16))) unsigned char smem[];
    LAS unsigned char* lds = (LAS unsigned char*)smem;
    cg::grid_group grid = cg::this_grid();
    const int tid = threadIdx.x, wid = __builtin_amdgcn_readfirstlane(tid >> 6), lane = tid & 63;
    const int vb = blockIdx.x, G = gridDim.x;
    volatile LAS unsigned* xst = (volatile LAS unsigned*)(lds + LDS_BYTES - 16);
    { unsigned* bar0 = (unsigned*)(kparams().ws + WS_BAR); if (tid == 0) { xst[0] = 0u; xst[1] = 0u; (void)xb_add(&bar0[XB_XCNT(xb_xcc_id())], 1u); } }
    __syncthreads();

#if !(PHOFF & 1)
    for (int rep = 0; rep < REP_PREP; ++rep) { const Params p = kparams(); phase_prep(p, lds, tid, wid, lane, vb, G); }
#endif
    if (kparams().out == nullptr) grid.sync();
    GSYNC();

#pragma nounroll
    for (int l0 = 0; l0 < 2; ++l0) {
#if !(PHOFF & 2)
        for (int rep = 0; rep < REP_G1; ++rep) {
            const Params p = kparams(); const int l = launder_i(l0); unsigned char* ws = p.ws;
            gemm_all<FIn>(lds, (const bf16_t*)(ws + WS_YB), (const bf16_t*)(ws + WS_WIN) + (size_t)l * 1536 * 1024, NIN, 1024, l, 0, vb, G, tid);
        }
#endif
        GSYNC();
        for (int rep = 0; rep < REP_MIX; ++rep) {
            const int l = launder_i(l0);
            unsigned* qctr = (unsigned*)(kparams().ws + WS_QCTR) + 64 * l;
            int it = vb;
            for (;;) {
                if (it >= 774) break;
#if !(PHOFF & 4)
                if (it < 256) for (int r2 = 0; r2 < REP_ATT; ++r2) { const Params p = kparams(); attn_item(p, l, it, lds, tid, wid, lane); }
#endif
#if !(PHOFF & 8)
                if (it >= 256 && it < 514) for (int r2 = 0; r2 < REP_RG; ++r2) { const Params p = kparams(); rglru_item(p, l, (it < 258) ? (it) : (it - 258), lds, tid, wid, lane); }
#endif
#if !(PHOFF & 16)
                if (it >= 514 && it < 646) for (int r2 = 0; r2 < REP_POOL; ++r2) { const Params p = kparams(); pool_item(p, l, it - 514, lds, tid, wid, lane); }
#endif
#if !(PHOFF & 32)
                if (it >= 646) for (int r2 = 0; r2 < REP_SATT; ++r2) { const Params p = kparams(); sattn_item(p, l, it - 646, lds, tid, wid, lane); }
#endif
                if (tid == 0) xst[2] = G + xb_add(qctr, 1u);
                __syncthreads();
                it = __builtin_amdgcn_readfirstlane((int)xst[2]);
                __syncthreads();
            }
        }
        GSYNC();
#if !(PHOFF & 64)
        for (int rep = 0; rep < REP_FIX; ++rep) { const Params p = kparams(); const int l = launder_i(l0); for (int it = vb; it < 512; it += G) fixup_item(p, l, it, tid); }
#endif
        {
            const Params p = kparams(); const int l = launder_i(l0); unsigned char* ws = p.ws;
            const int tid2 = launder_v(tid), lane2 = tid2 & 63, gw = vb * 8 + (tid2 >> 6), NGW = G * 8;
            rowsum_rows((const bf16_t*)(ws + WS_W1) + (size_t)l * 4096 * 1024, p.ln1_g + l * 1024, p.ln1_b + l * 1024, 4096, (float*)(ws + WS_CS1) + l * 4096, (float*)(ws + WS_BW1) + l * 4096, gw, NGW, lane2);
            if (l == 0) rowsum_rows((const bf16_t*)(ws + WS_WIN) + (size_t)1536 * 1024, p.ln2_g, p.ln2_b, 1536, (float*)(ws + WS_CSIN) + 1536, (float*)(ws + WS_BWIN) + 1536, gw, NGW, lane2);
        }
        GSYNC();
#if !(PHOFF & 128)
        for (int rep = 0; rep < REP_G2; ++rep) {
            const Params p = kparams(); const int l = launder_i(l0); unsigned char* ws = p.ws;
#if REP_G2 > 1
            if (rep < REP_G2 - 1) gemm_all<FResT<true>>(lds, (const bf16_t*)(ws + WS_MIX), (const bf16_t*)(ws + WS_WOUT) + (size_t)l * 1024 * 1024, 1024, 1024, l, 0, vb, G, tid); else
#endif
            gemm_all<FRes>(lds, (const bf16_t*)(ws + WS_MIX), (const bf16_t*)(ws + WS_WOUT) + (size_t)l * 1024 * 1024, 1024, 1024, l, 0, vb, G, tid);
        }
#endif
        GSYNC();
#if !(PHOFF & 256)
        for (int rep = 0; rep < REP_G3; ++rep) {
            const Params p = kparams(); const int l = launder_i(l0); unsigned char* ws = p.ws;
            gemm_all<FFF1>(lds, (const bf16_t*)(ws + WS_YB), (const bf16_t*)(ws + WS_W1) + (size_t)l * 4096 * 1024, DFF, 1024, l, 0, vb, G, tid);
        }
#endif
        GSYNC();
#if !(PHOFF & 512)
        for (int rep = 0; rep < REP_G4; ++rep) {
            const Params p = kparams(); const int l = launder_i(l0); unsigned char* ws = p.ws;
#if REP_G4 > 1
            if (rep < REP_G4 - 1) gemm_all<FResT<true>>(lds, (const bf16_t*)(ws + WS_HID), (const bf16_t*)(ws + WS_W2) + (size_t)l * 1024 * 4096, 1024, 4096, l, 1, vb, G, tid); else
#endif
            gemm_all<FRes>(lds, (const bf16_t*)(ws + WS_HID), (const bf16_t*)(ws + WS_W2) + (size_t)l * 1024 * 4096, 1024, 4096, l, 1, vb, G, tid);
        }
#endif
        GSYNC();
    }
    { const Params p = kparams(); final_ln(p, vb, G, tid); }
}

extern "C" void kernel_launch(void* const* d_in, const int* in_sizes, int n_in, void* d_out, int out_size, void* d_ws, size_t ws_size, hipStream_t stream) {
    static int grid_blocks = 0;
    if (!grid_blocks) {
        int dev = 0, cus = 0, per_cu = 0;
        hipGetDevice(&dev);
        hipDeviceGetAttribute(&cus, hipDeviceAttributeMultiprocessorCount, dev);
        hipFuncSetAttribute((const void*)hybrid_fwd, hipFuncAttributeMaxDynamicSharedMemorySize, LDS_BYTES);
        hipOccupancyMaxActiveBlocksPerMultiprocessor(&per_cu, (const void*)hybrid_fwd, NTHR, LDS_BYTES);
        if (per_cu < 1) per_cu = 1;
        grid_blocks = cus * per_cu;
        if (ws_size < WS_END) fprintf(stderr, "kernel_launch: workspace too small: %zu < %zu\n", ws_size, (size_t)WS_END);
        fprintf(stderr, "kernel_launch: grid %d (cus %d x %d)\n", grid_blocks, cus, per_cu);
    }
    if (hipMemsetAsync((char*)d_ws + WS_BAR, 0, XCD_BAR_WORDS * 4 + 1024, stream) != hipSuccess) fprintf(stderr, "memset failed\n");
    Params p{};
    const float** pp = (const float**)&p;
    for (int i = 0; i < 25; ++i) pp[i] = (const float*)d_in[i];
    p.out = (float*)d_out; p.ws = (unsigned char*)d_ws;
    void* args[] = {&p};
    hipError_t e = hipLaunchCooperativeKernel((const void*)hybrid_fwd, dim3(grid_blocks), dim3(NTHR), args, LDS_BYTES, stream);
    if (e != hipSuccess) fprintf(stderr, "cooperative launch failed: %s (grid %d)\n", hipGetErrorString(e), grid_blocks);
}
```

```cpp
#include <hip/hip_runtime.h>
#include <hip/hip_cooperative_groups.h>
#include <cstdio>
namespace cg = cooperative_groups;

#define LAS __attribute__((address_space(3)))
typedef unsigned short bf16_t;
typedef short bf16x8 __attribute__((ext_vector_type(8)));
typedef float f32x4 __attribute__((ext_vector_type(4)));
typedef float f32x2 __attribute__((ext_vector_type(2)));
typedef unsigned u32x4 __attribute__((ext_vector_type(4)));
typedef unsigned u32x2 __attribute__((ext_vector_type(2)));
#define DI __device__ __forceinline__
#ifndef PHOFF
#define PHOFF 0
#endif
#ifndef REP_SYNC
#define REP_SYNC 1
#endif
#ifndef REP_MIX
#define REP_MIX 1
#endif
#ifndef REP_G3
#define REP_G3 1
#endif
#ifndef REP_PREP
#define REP_PREP 1
#endif
#ifndef REP_FIX
#define REP_FIX 1
#endif
#ifndef REP_ATT
#define REP_ATT 1
#endif
#ifndef REP_RG
#define REP_RG 1
#endif
#ifndef REP_POOL
#define REP_POOL 1
#endif
#ifndef REP_SATT
#define REP_SATT 1
#endif
#ifndef REP_G2
#define REP_G2 1
#endif
#ifndef REP_G4
#define REP_G4 1
#endif
#ifndef REP_G1
#define REP_G1 1
#endif
#define GSYNC() do { for (int _r = 0; _r < REP_SYNC; ++_r) { unsigned* _bar = (unsigned*)(kparams().ws + WS_BAR); xcd_barrier(_bar, xst); } } while (0)

constexpr int DM = 1024, TP = 16384, TS = 128, MT = TP + TS, NIN = 1536, DFF = 4096;
constexpr int NTHR = 512;
constexpr float LOG2E = 1.4426950408889634f;
constexpr float ALPHA = 1.4142135623730951f;
constexpr float QSCALE = 0.125f * 1.4426950408889634f;
constexpr float LN_EPS = 1e-5f;
constexpr size_t O_YP = 0, O_YS = 16777216, O_PK = 16908288, O_PV = 17039360, O_PH = 17170432, O_PC = 17172480, O_PP = 17178624,
                 O_SK = 17209344, O_SV = 21403648, O_SH = 25597952, O_SC = 25663488, O_SP = 25860096;
constexpr size_t WS_WIN = 0;
constexpr size_t WS_WOUT = WS_WIN + 2ull * 1536 * 1024 * 2;
constexpr size_t WS_W1 = WS_WOUT + 2ull * 1024 * 1024 * 2;
constexpr size_t WS_W2 = WS_W1 + 2ull * 4096 * 1024 * 2;
constexpr size_t WS_YB = WS_W2 + 2ull * 4096 * 1024 * 2;
constexpr size_t WS_MIX = WS_YB + (size_t)MT * 1024 * 2;
constexpr size_t WS_HID = WS_MIX + (size_t)MT * 1024 * 2;
constexpr size_t WS_QKV = WS_HID;
constexpr size_t WS_U2 = WS_QKV + (size_t)MT * 768 * 2;
constexpr size_t WS_HL = WS_U2 + (size_t)MT * 768 * 4;
constexpr size_t WS_CA = WS_HL + (size_t)TP * 256 * 4;
constexpr size_t WS_ST1 = WS_HID + (size_t)MT * 4096 * 2;
constexpr size_t WS_ST2 = WS_ST1 + (size_t)MT * 32 * 4;
constexpr size_t WS_CSIN = WS_ST2 + (size_t)MT * 32 * 4;
constexpr size_t WS_BWIN = WS_CSIN + 2 * 1536 * 4;
constexpr size_t WS_CS1 = WS_BWIN + 2 * 1536 * 4;
constexpr size_t WS_BW1 = WS_CS1 + 2 * 4096 * 4;
constexpr size_t WS_GAT = WS_BW1 + 2 * 4096 * 4;
constexpr size_t WS_GXT = WS_GAT + 2 * 4 * 64 * 64 * 2;
constexpr size_t WS_PWT = WS_GXT + 2 * 4 * 64 * 64 * 2;
constexpr size_t WS_AGA = WS_PWT + 2 * 4 * 64 * 64 * 2;
constexpr size_t WS_AGB = WS_AGA + 128 * 256 * 4;
constexpr size_t WS_STS1 = WS_AGB + 128 * 256 * 4;
constexpr size_t WS_STS2 = WS_STS1 + 128 * 128 * 4;
constexpr size_t WS_BAR = WS_STS2 + 128 * 128 * 4;
constexpr size_t WS_QCTR = WS_BAR + 3456 * 4;
constexpr size_t WS_END = WS_QCTR + 1024;
static_assert(WS_CA + (size_t)TP * 256 * 4 <= WS_ST1, "alias region overflow");
static_assert(WS_END <= 268435456ull, "workspace budget");
constexpr int LDS_BYTES = 163840;

struct Params {
    const float* xp; const float* xs; const float* ck; const float* cv; const float* sh; const float* sc; const float* spool;
    const float* w_in; const float* sinks; const float* conv_w; const float* conv_b; const float* ga_w; const float* ga_b; const float* gx_w; const float* gx_b; const float* lam;
    const float* pool_w; const float* pool_scale; const float* w_out; const float* ln1_g; const float* ln1_b; const float* w_ff1; const float* w_ff2; const float* ln2_g; const float* ln2_b;
    float* out; unsigned char* ws;
};

DI unsigned pk2(float lo, float hi) { unsigned r; asm volatile("v_cvt_pk_bf16_f32 %0, %1, %2" : "=v"(r) : "v"(lo), "v"(hi)); return r; }
DI float bf2f(bf16_t b) { return __uint_as_float(((unsigned)b) << 16); }
DI float bfround(float x) { return __uint_as_float(pk2(x, 0.f) << 16); }
DI f32x4 mfma16(bf16x8 a, bf16x8 b, f32x4 c) { return __builtin_amdgcn_mfma_f32_16x16x32_bf16(a, b, c, 0, 0, 0); }
DI int launder_v(int x) { asm volatile("" : "+v"(x)); return x; }
DI int launder_i(int x) { asm volatile("" : "+s"(x)); return x; }
#define RELAUNDER() do { tid = launder_v(tid); lane = tid & 63; wid = __builtin_amdgcn_readfirstlane(tid >> 6); } while (0)
DI void lds_wait() { asm volatile("s_waitcnt lgkmcnt(0)" ::: "memory"); }
DI float sigmoidf_(float x) { return 1.0f / (1.0f + __expf(-x)); }
DI float gelu_tanh(float x) { const float u = 0.7978845608028654f * (x + 0.044715f * x * x * x); return x * __builtin_amdgcn_rcpf(1.0f + __builtin_amdgcn_exp2f(-2.0f * 1.4426950408889634f * u)); }
DI bf16x8 pack8(f32x4 lo, f32x4 hi) { u32x4 w; w.x = pk2(lo.x, lo.y); w.y = pk2(lo.z, lo.w); w.z = pk2(hi.x, hi.y); w.w = pk2(hi.z, hi.w); return __builtin_bit_cast(bf16x8, w); }
DI f32x4 ld_bf4_nt(const bf16_t* p) { const u32x2 w = __builtin_nontemporal_load((const u32x2*)p); return (f32x4){__uint_as_float(w.x << 16), __uint_as_float(w.x & 0xffff0000u), __uint_as_float(w.y << 16), __uint_as_float(w.y & 0xffff0000u)}; }
DI f32x4 ld_bf4(const bf16_t* p) { const u32x2 w = *(const u32x2*)p; return (f32x4){__uint_as_float(w.x << 16), __uint_as_float(w.x & 0xffff0000u), __uint_as_float(w.y << 16), __uint_as_float(w.y & 0xffff0000u)}; }
DI void st_bf4(bf16_t* dst, f32x4 v) { u32x2 w; w.x = pk2(v.x, v.y); w.y = pk2(v.z, v.w); *(u32x2*)dst = w; }

namespace pg8 {
constexpr int BM = 256, BK = 64, HALF = 128, HTB = HALF * BK * 2, STAGE_BYTES = 8 * HTB, NXCD = 8, WGM = 8;
DI int lds_byte(int r, int c) { const int st = (r >> 4) * 2 + (c >> 5), rr = r & 15, cc = c & 31, ob = rr * 64 + cc * 2; return st * 1024 + (ob ^ (((ob >> 9) & 1) << 5)); }
DI void stage_rc(int b, int& R, int& C) { const int st = b / 1024, sb = b % 1024, swz = sb ^ (((sb >> 9) & 1) << 5); R = (st >> 1) * 16 + swz / 64; C = (st & 1) * 32 + (swz % 64) / 2; }
DI int perm32(int rho) { const int n = rho >> 4, i = rho & 15; return 8 * (i >> 2) + 4 * n + (i & 3); }
struct Unit { int pm, pn; };
struct Gemm { const bf16_t* A; const bf16_t* Bt; int M, N, K; };
struct StaticOrder {
    int nM, nN, nwg, G, c;
    DI void init(int M, int N, int G_, int c_) { nM = M / BM; nN = N / BM; nwg = nM * nN; G = G_; c = c_; }
    DI bool next(int i, Unit& u) const {
        const long L = (long)i * G + c; if (L >= nwg) return false;
        int wgid = (int)L; { const int q = nwg / NXCD, r = nwg % NXCD, xcd = wgid % NXCD, off = wgid / NXCD; wgid = (xcd < r ? xcd * (q + 1) : r * (q + 1) + (xcd - r) * q) + off; }
        const int nig = WGM * nN, gid = wgid / nig, fm = gid * WGM, gsz = (nM - fm) < WGM ? (nM - fm) : WGM;
        u.pm = fm + ((wgid % nig) % gsz); u.pn = (wgid % nig) / gsz; return true;
    }
};

template <class Epi>
DI void gemm_phase(LAS unsigned char* lds, const Gemm g, const StaticOrder& S, const Epi& E, int tid) {
    const int wid = __builtin_amdgcn_readfirstlane(tid >> 6), lane = tid & 63, wr = wid >> 2, wc = wid & 3, fr = lane & 15, fq = lane >> 4;
    const int K = g.K, nt = K / BK;
    unsigned voffA[2], voffB[2];
#pragma unroll
    for (int i = 0; i < 2; ++i) { int R, C; stage_rc(tid * 16 + i * 8192, R, C); const int Rb = (R & ~31) + perm32(R & 31); voffA[i] = (unsigned)(R * K + C) * 2u; voffB[i] = (unsigned)(Rb * K + C) * 2u; }
    const size_t kstep = (size_t)(BK * 2);
    const size_t hstep = (size_t)HALF * K * 2;
    const size_t tstep = 2 * hstep;
    const unsigned ldsw = (unsigned)wid * 1024u;
    const int aoff = lds_byte(wr * 64 + fr, fq * 8), boff = lds_byte(wc * 32 + fr, fq * 8);
#define PG8_SA(b, h) (((b) * 2 + (h)) * HTB)
#define PG8_SB(b, h) ((4 + (b) * 2 + (h)) * HTB)
#define PG8_STAGE(bufoff, gbase, voff) do { _Pragma("unroll") for (int _i = 0; _i < 2; ++_i) \
        __builtin_amdgcn_global_load_lds((const unsigned*)((const char*)(gbase) + (voff)[_i]), (LAS unsigned*)(lds + (bufoff) + ldsw + _i * 8192), 16, 0, 0); } while (0)
#define PG8_LDA(dst, b, h) do { _Pragma("unroll") for (int m = 0; m < 4; ++m) _Pragma("unroll") for (int k = 0; k < 2; ++k) dst[m][k] = *(const LAS bf16x8*)(lds + PG8_SA(b, h) + aoff + m * 2048 + k * 1024); } while (0)
#define PG8_LDB(dst, b, h) do { _Pragma("unroll") for (int n = 0; n < 2; ++n) _Pragma("unroll") for (int k = 0; k < 2; ++k) dst[n][k] = *(const LAS bf16x8*)(lds + PG8_SB(b, h) + boff + n * 2048 + k * 1024); } while (0)
#define PG8_MMA(ai, bj, At, Bt) do { __builtin_amdgcn_s_setprio(1); _Pragma("unroll") for (int m = 0; m < 4; ++m) _Pragma("unroll") for (int n = 0; n < 2; ++n) _Pragma("unroll") for (int k = 0; k < 2; ++k) \
        acc[ai][bj][m][n] = __builtin_amdgcn_mfma_f32_16x16x32_bf16(Bt[n][k], At[m][k], acc[ai][bj][m][n], 0, 0, 0); __builtin_amdgcn_s_setprio(0); } while (0)
#define PG8_WAIT_V(n) asm volatile("s_waitcnt vmcnt(" #n ")" ::: "memory")
#define PG8_WAIT_L(n) asm volatile("s_waitcnt lgkmcnt(" #n ")" ::: "memory")
#define PG8_BAR __builtin_amdgcn_s_barrier()
#define PG8_SCHED __builtin_amdgcn_sched_barrier(0)
    Unit cur, nxt; int ui = 0;
    if (!S.next(0, cur)) return;
    f32x4 acc[2][2][4][2];
#pragma unroll
    for (int a = 0; a < 2; ++a)
#pragma unroll
        for (int b = 0; b < 2; ++b)
#pragma unroll
            for (int m = 0; m < 4; ++m)
#pragma unroll
                for (int n = 0; n < 2; ++n) acc[a][b][m][n] = (f32x4){0.f, 0.f, 0.f, 0.f};
    bf16x8 At[4][2], B0[2][2], B1[2][2];
    const char* cA = (const char*)g.A + (size_t)cur.pm * tstep; const char* cB = (const char*)g.Bt + (size_t)cur.pn * tstep;
    PG8_STAGE(PG8_SB(0, 0), cB, voffB); PG8_STAGE(PG8_SA(0, 0), cA, voffA); PG8_STAGE(PG8_SB(0, 1), cB + hstep, voffB); PG8_STAGE(PG8_SA(0, 1), cA + hstep, voffA);
    if (wr == 1) PG8_BAR;
    PG8_WAIT_V(4); PG8_BAR;
    PG8_STAGE(PG8_SB(1, 0), cB + kstep, voffB); PG8_STAGE(PG8_SA(1, 0), cA + kstep, voffA); PG8_STAGE(PG8_SB(1, 1), cB + hstep + kstep, voffB);
    PG8_WAIT_V(6); PG8_BAR;
    for (;;) {
        const bool has_next = S.next(ui + 1, nxt);
        const char* nA = has_next ? (const char*)g.A + (size_t)nxt.pm * tstep : cA; const char* nB = has_next ? (const char*)g.Bt + (size_t)nxt.pn * tstep : cB;
        for (int t = 0; t < nt; t += 2) {
            const bool last = (t == nt - 2);
            const char* a1 = cA + (size_t)(t + 1) * kstep;
            const char* a2 = last ? nA : cA + (size_t)(t + 2) * kstep; const char* b2 = last ? nB : cB + (size_t)(t + 2) * kstep;
            const char* a3 = a2 + kstep; const char* b3 = b2 + kstep;
            PG8_LDB(B0, 0, 0); PG8_SCHED; PG8_LDA(At, 0, 0); PG8_STAGE(PG8_SA(1, 1), a1 + hstep, voffA);
            PG8_WAIT_L(8); PG8_BAR; PG8_WAIT_L(0); PG8_MMA(0, 0, At, B0); PG8_BAR; PG8_SCHED;
            PG8_LDB(B1, 0, 1); PG8_STAGE(PG8_SB(0, 0), b2, voffB);
            PG8_BAR; PG8_WAIT_L(0); PG8_MMA(0, 1, At, B1); PG8_BAR;
            PG8_LDA(At, 0, 1); PG8_STAGE(PG8_SA(0, 0), a2, voffA);
            PG8_BAR; PG8_WAIT_L(0); PG8_MMA(1, 0, At, B0); PG8_BAR; PG8_SCHED;
            PG8_STAGE(PG8_SB(0, 1), b2 + hstep, voffB);
            PG8_WAIT_V(6); PG8_BAR; PG8_MMA(1, 1, At, B1); PG8_BAR;
            PG8_LDB(B0, 1, 0); PG8_SCHED; PG8_LDA(At, 1, 0); PG8_STAGE(PG8_SA(0, 1), a2 + hstep, voffA);
            PG8_WAIT_L(8); PG8_BAR; PG8_WAIT_L(0); PG8_MMA(0, 0, At, B0); PG8_BAR; PG8_SCHED;
            PG8_LDB(B1, 1, 1); PG8_STAGE(PG8_SB(1, 0), b3, voffB);
            PG8_BAR; PG8_WAIT_L(0); PG8_MMA(0, 1, At, B1); PG8_BAR;
            PG8_LDA(At, 1, 1); PG8_STAGE(PG8_SA(1, 0), a3, voffA);
            PG8_BAR; PG8_WAIT_L(0); PG8_MMA(1, 0, At, B0); PG8_BAR; PG8_SCHED;
            PG8_STAGE(PG8_SB(1, 1), b3 + hstep, voffB);
            PG8_WAIT_V(6); PG8_BAR; PG8_MMA(1, 1, At, B1); PG8_BAR;
        }
        E(acc, cur, ui, wr, wc, fr, fq);
        if (!has_next) break;
#pragma unroll
        for (int a = 0; a < 2; ++a)
#pragma unroll
            for (int b = 0; b < 2; ++b)
#pragma unroll
                for (int m = 0; m < 4; ++m)
#pragma unroll
                    for (int n = 0; n < 2; ++n) acc[a][b][m][n] = (f32x4){0.f, 0.f, 0.f, 0.f};
        cur = nxt; cA = nA; cB = nB; ++ui;
    }
    PG8_WAIT_V(0);
    if (wr == 0) PG8_BAR;
    PG8_BAR;
#undef PG8_SA
#undef PG8_SB
#undef PG8_STAGE
#undef PG8_LDA
#undef PG8_LDB
#undef PG8_MMA
#undef PG8_WAIT_V
#undef PG8_WAIT_L
#undef PG8_BAR
#undef PG8_SCHED
}
}

typedef const __attribute__((address_space(4))) Params* KParamsPtr;
DI Params kparams() {
#if defined(__HIP_DEVICE_COMPILE__)
    const __attribute__((address_space(4))) char* q = (const __attribute__((address_space(4))) char*)__builtin_amdgcn_kernarg_segment_ptr();
    asm volatile("" : "+s"(q));
    KParamsPtr kp = (KParamsPtr)q;
    Params r;
    r.xp = kp->xp; r.xs = kp->xs; r.ck = kp->ck; r.cv = kp->cv; r.sh = kp->sh; r.sc = kp->sc; r.spool = kp->spool;
    r.w_in = kp->w_in; r.sinks = kp->sinks; r.conv_w = kp->conv_w; r.conv_b = kp->conv_b; r.ga_w = kp->ga_w; r.ga_b = kp->ga_b; r.gx_w = kp->gx_w; r.gx_b = kp->gx_b; r.lam = kp->lam;
    r.pool_w = kp->pool_w; r.pool_scale = kp->pool_scale; r.w_out = kp->w_out; r.ln1_g = kp->ln1_g; r.ln1_b = kp->ln1_b; r.w_ff1 = kp->w_ff1; r.w_ff2 = kp->w_ff2; r.ln2_g = kp->ln2_g; r.ln2_b = kp->ln2_b;
    r.out = kp->out; r.ws = kp->ws;
    return r;
#else
    return Params{};
#endif
}

struct RowCtx { float mu, rstd; };
DI void row_stats(const float* part, int row, int fq, float& mu, float& rstd) {
    const f32x4* p = (const f32x4*)(part + (size_t)row * 32 + fq * 8);
    const f32x4 a = p[0], b = p[1];
    float s = (a.x + a.z) + (b.x + b.z), ss = (a.y + a.w) + (b.y + b.w);
    s += __shfl_xor(s, 16); s += __shfl_xor(s, 32); ss += __shfl_xor(ss, 16); ss += __shfl_xor(ss, 32);
    mu = s * (1.0f / 1024.0f); const float var = ss * (1.0f / 1024.0f) - mu * mu; rstd = rsqrtf(fmaxf(var, 0.f) + LN_EPS);
}

DI void row_stats_s(const float* part_s, int srow, int fq, float& mu, float& rstd) {
    const f32x4* p = (const f32x4*)(part_s + (size_t)srow * 128 + fq * 32);
    float s = 0.f, ss = 0.f;
#pragma unroll
    for (int i = 0; i < 8; ++i) { const f32x4 a = p[i]; s += a.x + a.z; ss += a.y + a.w; }
    s += __shfl_xor(s, 16); s += __shfl_xor(s, 32); ss += __shfl_xor(ss, 16); ss += __shfl_xor(ss, 32);
    mu = s * (1.0f / 1024.0f); const float var = ss * (1.0f / 1024.0f) - mu * mu; rstd = rsqrtf(fmaxf(var, 0.f) + LN_EPS);
}
DI void row_stats_any(const float* part, const float* part_s, int row, int fq, float& mu, float& rstd) {
    if (row < TP) row_stats(part, row, fq, mu, rstd); else row_stats_s(part_s, row - TP, fq, mu, rstd);
}

struct ColCtx { f32x4 a, b; };
DI void st_bf8(bf16_t* dst, f32x4 v0, f32x4 v1) { u32x4 w; w.x = pk2(v0.x, v0.y); w.y = pk2(v0.z, v0.w); w.z = pk2(v1.x, v1.y); w.w = pk2(v1.z, v1.w); *(u32x4*)dst = w; }
struct FIn {
    static constexpr bool STATS = false, PRELOAD = false, DEFERRED_PREP = true, STAGGER = false;
    const float* part; const float* part_s; const float* cs; const float* bw; int fold; int layer; bf16_t* QKV; bf16_t* U2; float* out; float* part_out; float* part_out_s;
    DI bool is_dry() const { return false; }
    DI const float* stats_src() const { return fold ? part : nullptr; }
    static DI FIn make(const Params& p, int l, int) { unsigned char* ws = p.ws;
        return FIn{(const float*)(ws + WS_ST2), (const float*)(ws + WS_STS2), (const float*)(ws + WS_CSIN) + l * 1536, (const float*)(ws + WS_BWIN) + l * 1536, l, l, (bf16_t*)(ws + WS_QKV), (bf16_t*)(ws + WS_U2), p.out, nullptr, nullptr}; }
    template <bool SMP> DI RowCtx row_begin(int row, int fq) const { RowCtx r{0.f, 1.f}; if (fold) { if (SMP) row_stats_s(part_s, row - TP, fq, r.mu, r.rstd); else row_stats(part, row, fq, r.mu, r.rstd); } return r; }
    DI ColCtx col_begin(int col) const { ColCtx c; c.a = *(const f32x4*)(cs + col); c.b = *(const f32x4*)(bw + col); return c; }
    DI f32x4 row_load8(int, int) const { return (f32x4){0.f, 0.f, 0.f, 0.f}; }
    DI f32x4 row_load4(int, int) const { return (f32x4){0.f, 0.f, 0.f, 0.f}; }
    DI f32x4 compute(int, int col, f32x4 a, const RowCtx& rc, const ColCtx& cc, float, float) const {
        f32x4 v = a;
        if (fold) v = (a - rc.mu * cc.a) * rc.rstd + cc.b;
        return v;
    }
    DI float* kv_dst(int row, int col) const {
        float* dst = nullptr; const int c7 = (col - 512) & 127; const bool isk = col < 640;
        if (row < TP) { const int t = row & 4095; if (t >= 3968) dst = out + (isk ? O_PK : O_PV) + ((size_t)((layer * 4 + (row >> 12)) * 128 + (t - 3968))) * 128 + c7; }
        else { dst = out + (isk ? O_SK : O_SV) + ((size_t)((layer * 128 + (row - TP)) * 128 + 127)) * 128 + c7; }
        return dst;
    }
    DI void store8(int row, int col, f32x4 v0, f32x4 v1) const {
        if (col < 512) st_bf8(QKV + (size_t)row * 768 + col, v0 * QSCALE, v1 * QSCALE);
        else if (col < 768) { st_bf8(QKV + (size_t)row * 768 + col, v0, v1); float* dst = kv_dst(row, col); if (dst) { *(f32x4*)dst = v0; *(f32x4*)(dst + 4) = v1; } }
        else st_bf8(U2 + (size_t)row * 768 + (col - 768), v0, v1);
    }
    DI void store4(int row, int col, f32x4 v) const {
        if (col < 512) st_bf4(QKV + (size_t)row * 768 + col, v * QSCALE);
        else if (col < 768) { st_bf4(QKV + (size_t)row * 768 + col, v); float* dst = kv_dst(row, col); if (dst) *(f32x4*)dst = v; }
        else st_bf4(U2 + (size_t)row * 768 + (col - 768), v);
    }
};
struct FFF1 {
    static constexpr bool STATS = false, PRELOAD = false, DEFERRED_PREP = false, STAGGER = true;
    const float* part; const float* part_s; const float* cs; const float* bw; bf16_t* HID; float* part_out; float* part_out_s;
    DI bool is_dry() const { return false; }
    DI const float* stats_src() const { return part; }
    static DI FFF1 make(const Params& p, int l, int) { unsigned char* ws = p.ws;
        return FFF1{(const float*)(ws + WS_ST1), (const float*)(ws + WS_STS1), (const float*)(ws + WS_CS1) + l * 4096, (const float*)(ws + WS_BW1) + l * 4096, (bf16_t*)(ws + WS_HID), nullptr, nullptr}; }
    template <bool SMP> DI RowCtx row_begin(int row, int fq) const { RowCtx r; if (SMP) row_stats_s(part_s, row - TP, fq, r.mu, r.rstd); else row_stats(part, row, fq, r.mu, r.rstd); return r; }
    DI ColCtx col_begin(int col) const { ColCtx c; c.a = *(const f32x4*)(cs + col); c.b = *(const f32x4*)(bw + col); return c; }
    DI f32x4 row_load8(int, int) const { return (f32x4){0.f, 0.f, 0.f, 0.f}; }
    DI f32x4 row_load4(int, int) const { return (f32x4){0.f, 0.f, 0.f, 0.f}; }
    DI f32x4 compute(int, int, f32x4 a, const RowCtx& rc, const ColCtx& cc, float, float) const {
        f32x4 v = (a - rc.mu * cc.a) * rc.rstd + cc.b;
        v.x = fmaxf(v.x, 0.f); v.y = fmaxf(v.y, 0.f); v.z = fmaxf(v.z, 0.f); v.w = fmaxf(v.w, 0.f); return v * v;
    }
    DI void store8(int row, int col, f32x4 v0, f32x4 v1) const { st_bf8(HID + (size_t)row * 4096 + col, v0, v1); }
    DI void store4(int row, int col, f32x4 v) const { st_bf4(HID + (size_t)row * 4096 + col, v); }
};
template <bool DRY> struct FResT {
    static constexpr bool STATS = true, PRELOAD = true, DEFERRED_PREP = false, STAGGER = false;
    int raw; const float* part; const float* part_s; const float* g; const float* b; float* Y; bf16_t* YB; float* part_out; float* part_out_s;
    static DI FResT make(const Params& p, int l, int which) { unsigned char* ws = p.ws;
        if (which == 0) return FResT{l == 0 ? 1 : 0, (const float*)(ws + WS_ST2), (const float*)(ws + WS_STS2), p.ln2_g, p.ln2_b, nullptr, (bf16_t*)(ws + WS_YB), (float*)(ws + WS_ST1), (float*)(ws + WS_STS1)};
        return FResT{0, (const float*)(ws + WS_ST1), (const float*)(ws + WS_STS1), p.ln1_g + l * 1024, p.ln1_b + l * 1024, nullptr, (bf16_t*)(ws + WS_YB), (float*)(ws + WS_ST2), (float*)(ws + WS_STS2)}; }
    DI bool is_dry() const { return DRY; }
    DI const float* stats_src() const { return raw ? nullptr : part; }
    template <bool SMP> DI RowCtx row_begin(int row, int fq) const { RowCtx r{0.f, 1.f}; if (!raw) { if (SMP) row_stats_s(part_s, row - TP, fq, r.mu, r.rstd); else row_stats(part, row, fq, r.mu, r.rstd); } return r; }
    DI ColCtx col_begin(int col) const { ColCtx c; c.a = *(const f32x4*)(g + col); c.b = *(const f32x4*)(b + col); return c; }
    DI f32x4 row_load8(int row, int col) const { const u32x4 w = *(const u32x4*)(YB + (size_t)row * 1024 + col); return __builtin_bit_cast(f32x4, w); }
    DI f32x4 row_load4(int row, int col) const { const u32x2 w = *(const u32x2*)(YB + (size_t)row * 1024 + col); return (f32x4){__uint_as_float(w.x), __uint_as_float(w.y), 0.f, 0.f}; }
    DI f32x4 compute(int, int, f32x4 a, const RowCtx& rc, const ColCtx& cc, float p0, float p1) const {
        const unsigned w0 = __float_as_uint(p0), w1 = __float_as_uint(p1);
        const f32x4 x = (f32x4){__uint_as_float(w0 << 16), __uint_as_float(w0 & 0xffff0000u), __uint_as_float(w1 << 16), __uint_as_float(w1 & 0xffff0000u)};
        const f32x4 r = raw ? x : ((x - rc.mu) * rc.rstd * cc.a + cc.b);
        return ALPHA * r + a;
    }
    DI void store8(int row, int col, f32x4 v0, f32x4 v1) const {
        if (!DRY) { st_bf8(YB + (size_t)row * 1024 + col, v0, v1); if (Y) { float* d = Y + (size_t)row * 1024 + col; *(f32x4*)d = v0; *(f32x4*)(d + 4) = v1; } }
    }
    DI void store4(int row, int col, f32x4 v) const {
        if (!DRY) { st_bf4(YB + (size_t)row * 1024 + col, v); if (Y) *(f32x4*)(Y + (size_t)row * 1024 + col) = v; }
    }
};
typedef FResT<false> FRes;

constexpr int STAT_TAB_OFF = 131072;
template <class F> struct EpiWrap {
    int l, which; LAS unsigned char* lds;
    DI void operator()(const f32x4 (&acc)[2][2][4][2], const pg8::Unit& u, int ui, int wr, int wc, int fr, int fq) const {
        const Params p = kparams();
        const F f = F::make(p, launder_i(l), which);
        const bool has_stats = f.stats_src() != nullptr;
        const LAS f32x2* tab = (const LAS f32x2*)(lds + STAT_TAB_OFF) + ui * 256 + wr * 64 + fr;
        const int rbase = u.pm * 256 + wr * 64 + fr, cbase = u.pn * 256 + wc * 32 + 8 * fq;
        ColCtx cc[2][2];
#pragma unroll
        for (int bj = 0; bj < 2; ++bj)
#pragma unroll
            for (int n = 0; n < 2; ++n) cc[bj][n] = f.col_begin(cbase + bj * 128 + 4 * n);
#pragma unroll
        for (int ai = 0; ai < 2; ++ai) {
            RowCtx rc[4]; float s[4], ss[4];
#pragma unroll
            for (int m = 0; m < 4; ++m) { const f32x2 t = has_stats ? tab[ai * 128 + m * 16] : (f32x2){0.f, 1.f}; rc[m].mu = t.x; rc[m].rstd = t.y; s[m] = 0.f; ss[m] = 0.f; }
#pragma unroll
            for (int bj = 0; bj < 2; ++bj) {
                const int col8 = cbase + bj * 128;
                f32x4 pre, nxt = f.row_load8(rbase + ai * 128, col8);
#pragma unroll
                for (int m = 0; m < 4; ++m) {
                    const int row = rbase + ai * 128 + m * 16;
                    pre = nxt;
                    if (F::PRELOAD && m < 3) nxt = f.row_load8(row + 16, col8);
                    const f32x4 y0 = f.compute(row, col8, acc[ai][bj][m][0], rc[m], cc[bj][0], pre.x, pre.y);
                    const f32x4 y1 = f.compute(row, col8 + 4, acc[ai][bj][m][1], rc[m], cc[bj][1], pre.z, pre.w);
                    if (F::STATS) { s[m] += ((y0.x + y0.y) + (y0.z + y0.w)) + ((y1.x + y1.y) + (y1.z + y1.w));
                        ss[m] += ((y0.x * y0.x + y0.y * y0.y) + (y0.z * y0.z + y0.w * y0.w)) + ((y1.x * y1.x + y1.y * y1.y) + (y1.z * y1.z + y1.w * y1.w)); }
                    f.store8(row, col8, y0, y1);
                }
            }
            if (F::STATS) {
#pragma unroll
                for (int m = 0; m < 4; ++m) {
                    float a = s[m], b = ss[m];
                    a += __shfl_xor(a, 16); a += __shfl_xor(a, 32); b += __shfl_xor(b, 16); b += __shfl_xor(b, 32);
                    if (fq == 0 && !f.is_dry()) *(f32x2*)(f.part_out + (size_t)(rbase + ai * 128 + m * 16) * 32 + (u.pn * 4 + wc) * 2) = (f32x2){a, b};
                }
            }
        }
    }
};

template <class F>
DI void sgemm_unit(LAS unsigned char* lds, const bf16_t* A, const bf16_t* Wt, int K, int col0, const F& f, int wid, int lane) {
    const int fr = lane & 15, fq = lane >> 4;
    const int kw = K >> 3;
    const bf16_t* ap = A + (size_t)fr * K + wid * kw + 8 * fq;
    const bf16_t* wp = Wt + (size_t)(col0 + fr) * K + wid * kw + 8 * fq;
    const int row = TP + wid * 16 + fr;
    const RowCtx rc = f.template row_begin<true>(row, fq);
    const ColCtx cc = f.col_begin(col0 + 4 * fq);
    const f32x4 pre = f.row_load4(row, col0 + 4 * fq);
    f32x4 acc[8];
#pragma unroll
    for (int i = 0; i < 8; ++i) acc[i] = (f32x4){0.f, 0.f, 0.f, 0.f};
#pragma unroll 2
    for (int k = 0; k < kw; k += 32) {
        const bf16x8 w = *(const bf16x8*)(wp + k);
#pragma unroll
        for (int mt = 0; mt < 8; ++mt) { const bf16x8 a = *(const bf16x8*)(ap + (size_t)mt * 16 * K + k); acc[mt] = mfma16(w, a, acc[mt]); }
    }
    LAS f32x4* red = (LAS f32x4*)lds;
#pragma unroll
    for (int mt = 0; mt < 8; ++mt) red[(wid * 8 + mt) * 64 + lane] = acc[mt];
    __syncthreads();
    f32x4 tot = (f32x4){0.f, 0.f, 0.f, 0.f};
#pragma unroll
    for (int s = 0; s < 8; ++s) tot += red[(s * 8 + wid) * 64 + lane];
    const f32x4 y = f.compute(row, col0 + 4 * fq, tot, rc, cc, pre.x, pre.y);
    f.store4(row, col0 + 4 * fq, y);
    if (F::STATS) {
        float s = (y.x + y.y) + (y.z + y.w), ss = (y.x * y.x + y.y * y.y) + (y.z * y.z + y.w * y.w);
        s += __shfl_xor(s, 16); s += __shfl_xor(s, 32); ss += __shfl_xor(ss, 16); ss += __shfl_xor(ss, 32);
        if (fq == 0 && !f.is_dry()) *(f32x2*)(f.part_out_s + (size_t)(row - TP) * 128 + (col0 >> 4) * 2) = (f32x2){s, ss};
    }
    __syncthreads();
}

DI void prep_deferred(const Params& p, int slot, LAS unsigned char* lds, int tid, int widx, int NW);
template <class F>
DI void gemm_all(LAS unsigned char* lds, const bf16_t* A, const bf16_t* Wt, int N, int K, int l, int which, int vb, int G, int tid) {
    int wid, lane; RELAUNDER();
    pg8::Gemm g{A, Wt, TP, N, K}; pg8::StaticOrder S; S.init(TP, N, G, vb);
    {
        const Params p = kparams();
        const F f = F::make(p, launder_i(l), which);
        const float* part = f.stats_src();
        if (part) {
            LAS f32x2* tab = (LAS f32x2*)(lds + STAT_TAB_OFF);
            const int r = tid >> 1, hlf = tid & 1;
            f32x4 v[4][4]; bool ok[4];
#pragma unroll
            for (int i = 0; i < 4; ++i) { pg8::Unit u; ok[i] = S.next(i, u); const int row = (ok[i] ? u.pm : 0) * 256 + r;
                const f32x4* pp = (const f32x4*)(part + (size_t)row * 32 + hlf * 16);
#pragma unroll
                for (int j = 0; j < 4; ++j) v[i][j] = pp[j]; }
#pragma unroll
            for (int i = 0; i < 4; ++i) {
                float s = 0.f, ss = 0.f;
#pragma unroll
                for (int j = 0; j < 4; ++j) { s += v[i][j].x + v[i][j].z; ss += v[i][j].y + v[i][j].w; }
                s += __shfl_xor(s, 1); ss += __shfl_xor(ss, 1);
                const float mu = s * (1.0f / 1024.0f), var = ss * (1.0f / 1024.0f) - mu * mu, rstd = rsqrtf(fmaxf(var, 0.f) + LN_EPS);
                if (hlf == 0) tab[i * 256 + r] = (f32x2){mu, rstd};
            }
        }
        __syncthreads();
    }
    const int nsu_ = N / 16;
    const bool s_first = false;
    if (F::STAGGER && (((vb >> 3) & 1) != 0) && (G & 15) == 0) {
        const Params p = kparams();
        prep_deferred(p, launder_i(l) + 1, lds, tid, ((vb >> 4) << 3) | (vb & 7), G >> 1);
        __syncthreads();
    }
    EpiWrap<F> E{l, which, lds};
    pg8::gemm_phase<EpiWrap<F>>(lds, g, S, E, tid);
    if (F::DEFERRED_PREP) {
        const int nwg = (TP / 256) * (N / 256), first = (nwg > G && nwg < 2 * G) ? (nwg - G) : 0;
        if (vb >= first) { const Params p = kparams(); prep_deferred(p, launder_i(l) + 3, lds, tid, vb - first, G - first); __syncthreads(); }
    }
    const int nsu = N / 16;
    const int su0 = G - 1 - vb;
    if (su0 < nsu && !s_first) {
        const Params p = kparams();
        const F f = F::make(p, launder_i(l), which);
        for (int su = su0; su < nsu; su += G) sgemm_unit<F>(lds, A + (size_t)TP * K, Wt, K, su * 16, f, wid, lane);
    }
}

DI void transpose_tile_load(const float* W, const float* gain, int N, int k0, int n0, int tid, f32x4 (&v)[8]) {
#pragma unroll
    for (int i = 0; i < 8; ++i) { const int e = tid + 512 * i, row = e >> 5, c4 = e & 31;
        f32x4 x = __builtin_nontemporal_load((const f32x4*)(W + (size_t)(k0 + row) * N + n0 + 4 * c4));
        if (gain) x = x * gain[k0 + row];
        v[i] = x; }
}
DI void transpose_tile_store(LAS float* T, bf16_t* WT, int K, int k0, int n0, int tid, const f32x4 (&v)[8]) {
#pragma unroll
    for (int i = 0; i < 8; ++i) { const int e = tid + 512 * i, row = e >> 5, c4 = e & 31; LAS float* d = T + row * 129 + 4 * c4; d[0] = v[i].x; d[1] = v[i].y; d[2] = v[i].z; d[3] = v[i].w; }
    __syncthreads();
#pragma unroll
    for (int i = 0; i < 4; ++i) { const int e = tid + 512 * i, n = e >> 4, c8 = e & 15; const LAS float* s = T + (8 * c8) * 129 + n;
        u32x4 o; o.x = pk2(s[0], s[129]); o.y = pk2(s[2 * 129], s[3 * 129]); o.z = pk2(s[4 * 129], s[5 * 129]); o.w = pk2(s[6 * 129], s[7 * 129]);
        *(u32x4*)(WT + (size_t)(n0 + n) * K + k0 + 8 * c8) = o; }
    __syncthreads();
}
struct TrJob { const float* W; const float* gain; bf16_t* WT; int K, N, k0, n0; };
DI TrJob tr_job(const Params& p, int which, int l, int item) {
    unsigned char* ws = p.ws; TrJob j;
    if (which == 0) { j.W = p.w_in + (size_t)l * 1024 * 1536; j.gain = l ? p.ln2_g : nullptr; j.WT = (bf16_t*)(ws + WS_WIN) + (size_t)l * 1536 * 1024; j.K = 1024; j.N = 1536; }
    else if (which == 1) { j.W = p.w_out + (size_t)l * 1024 * 1024; j.gain = nullptr; j.WT = (bf16_t*)(ws + WS_WOUT) + (size_t)l * 1024 * 1024; j.K = 1024; j.N = 1024; }
    else if (which == 2) { j.W = p.w_ff1 + (size_t)l * 1024 * 4096; j.gain = p.ln1_g + l * 1024; j.WT = (bf16_t*)(ws + WS_W1) + (size_t)l * 4096 * 1024; j.K = 1024; j.N = 4096; }
    else { j.W = p.w_ff2 + (size_t)l * 4096 * 1024; j.gain = nullptr; j.WT = (bf16_t*)(ws + WS_W2) + (size_t)l * 1024 * 4096; j.K = 4096; j.N = 1024; }
    const int nb = j.N / 128; j.k0 = (item / nb) * 128; j.n0 = (item % nb) * 128; return j;
}
DI TrJob tr_slot_job(const Params& p, int slot, int it) {
    if (slot == 0) { if (it < 96) return tr_job(p, 0, 0, it); return tr_job(p, 0, 1, it - 96); }
    if (slot <= 2) return tr_job(p, 3, slot - 1, it);
    if (it < 64) return tr_job(p, 1, slot - 3, it);
    return tr_job(p, 2, slot - 3, it - 64);
}
DI void transpose_slot(const Params& p, int slot, LAS unsigned char* lds, int tid, int widx, int NW) {
    const int nit = slot == 0 ? 192 : (slot <= 2 ? 256 : 320);
    LAS float* T = (LAS float*)lds;
    f32x4 v[8];
    int it = widx;
    if (it < nit) { const TrJob j = tr_slot_job(p, slot, it); transpose_tile_load(j.W, j.gain, j.N, j.k0, j.n0, tid, v); }
    for (; it < nit; it += NW) {
        const TrJob j = tr_slot_job(p, slot, it);
#pragma unroll
        for (int i = 0; i < 8; ++i) { const int e = tid + 512 * i, row = e >> 5, c4 = e & 31; LAS float* d = T + row * 129 + 4 * c4; d[0] = v[i].x; d[1] = v[i].y; d[2] = v[i].z; d[3] = v[i].w; }
        __syncthreads();
        if (it + NW < nit) { const TrJob jn = tr_slot_job(p, slot, it + NW); transpose_tile_load(jn.W, jn.gain, jn.N, jn.k0, jn.n0, tid, v); }
#pragma unroll
        for (int i = 0; i < 4; ++i) { const int e = tid + 512 * i, n = e >> 4, c8 = e & 15; const LAS float* s = T + (8 * c8) * 129 + n;
            u32x4 o; o.x = pk2(s[0], s[129]); o.y = pk2(s[2 * 129], s[3 * 129]); o.z = pk2(s[4 * 129], s[5 * 129]); o.w = pk2(s[6 * 129], s[7 * 129]);
            *(u32x4*)(j.WT + (size_t)(j.n0 + n) * j.K + j.k0 + 8 * c8) = o; }
        __syncthreads();
    }
}
DI void colsum_item(const float* W, const float* gain, const float* bias, int N, int c0, float* cs, float* bw, LAS float* red, int wid, int lane) {
    float s1 = 0.f, s2 = 0.f;
    const float* wp = W + (size_t)(wid * 128) * N + c0 + lane;
#pragma unroll 32
    for (int k = 0; k < 128; ++k) { const float w = wp[(size_t)k * N]; const int kk = wid * 128 + k; s1 += bfround(gain[kk] * w); s2 += bias[kk] * w; }
    red[wid * 128 + lane] = s1; red[wid * 128 + 64 + lane] = s2;
    __syncthreads();
    if (wid == 0) { float a = 0.f, b = 0.f;
#pragma unroll
        for (int w = 0; w < 8; ++w) { a += red[w * 128 + lane]; b += red[w * 128 + 64 + lane]; }
        cs[c0 + lane] = a; bw[c0 + lane] = b; }
    __syncthreads();
}
DI void prep_deferred(const Params& p, int slot, LAS unsigned char* lds, int tid, int widx, int NW) {
    tid = launder_v(tid);
    transpose_slot(p, slot, lds, tid, widx, NW);
}
DI void phase_prep(const Params& p, LAS unsigned char* lds, int tid, int wid, int lane, int vb, int G) {
    RELAUNDER();
    unsigned char* ws = p.ws;
    const int gw = vb * 8 + wid, NGW = G * 8;
    transpose_slot(p, 0, lds, tid, vb, G);
    bf16_t* YB = (bf16_t*)(ws + WS_YB);
    for (int m0 = gw; m0 < MT; m0 += 4 * NGW) {
        f32x4 v[4][4];
#pragma unroll
        for (int r = 0; r < 4; ++r) { const int m = m0 + r * NGW; const int mm = m < MT ? m : m0;
            const f32x4* src = (const f32x4*)(mm < TP ? p.xp + (size_t)mm * 1024 : p.xs + (size_t)(mm - TP) * 1024);
#pragma unroll
            for (int j = 0; j < 4; ++j) v[r][j] = __builtin_nontemporal_load(src + lane + 64 * j); }
#pragma unroll
        for (int r = 0; r < 4; ++r) { const int m = m0 + r * NGW;
            if (m < MT) {
#pragma unroll
                for (int j = 0; j < 4; ++j) st_bf4(YB + (size_t)m * 1024 + 4 * (lane + 64 * j), v[r][j]); } }
    }
#pragma unroll
    for (int which = 0; which < 3; ++which) {
        const float* src = which == 0 ? p.ga_w : (which == 1 ? p.gx_w : p.pool_w);
        bf16_t* dst = (bf16_t*)(ws + (which == 0 ? WS_GAT : (which == 1 ? WS_GXT : WS_PWT)));
        for (int r = vb * NTHR + tid; r < 32768; r += G * NTHR) {
            const int ln = r >> 12, d = (r >> 6) & 63, c = r & 63;
            dst[r] = (bf16_t)(pk2(src[(ln << 12) + c * 64 + d], 0.f) & 0xffffu);
        }
    }
    __syncthreads();
}

DI void attn_item(const Params& p, int layer, int item, LAS unsigned char* lds, int tid, int wid, int lane) {
    RELAUNDER();
    const int kvh = item & 1, qb = (item >> 1) & 31, b = item >> 6;
    const bf16_t* QKV = (const bf16_t*)(p.ws + WS_QKV); bf16_t* MIX = (bf16_t*)(p.ws + WS_MIX);
    LAS bf16_t* Ks = (LAS bf16_t*)lds;
    LAS bf16_t* Vt = (LAS bf16_t*)(lds + 36864);
    {
        const int key = tid >> 1, half = tid & 1; const int tok = qb * 128 - 128 + key;
        u32x4 kv[4], vv[4];
        if (tok >= 0) { const bf16_t* src = QKV + ((size_t)b * 4096 + tok) * 768 + 512 + kvh * 64 + half * 32;
#pragma unroll
            for (int i = 0; i < 4; ++i) { kv[i] = ((const u32x4*)src)[i]; vv[i] = ((const u32x4*)(src + 128))[i]; } }
        else {
#pragma unroll
            for (int i = 0; i < 4; ++i) { kv[i] = (u32x4){0u, 0u, 0u, 0u}; vv[i] = (u32x4){0u, 0u, 0u, 0u}; } }
#pragma unroll
        for (int i = 0; i < 4; ++i) *(LAS u32x4*)(Ks + key * 72 + half * 32 + 8 * i) = kv[i];
#pragma unroll
        for (int i = 0; i < 4; ++i)
#pragma unroll
            for (int e = 0; e < 8; ++e) { const int d = half * 32 + 8 * i + e; Vt[d * 264 + key] = (bf16_t)((vv[i][e >> 1] >> (16 * (e & 1))) & 0xffffu); }
    }
    __syncthreads();
    const int g = wid >> 1, qh = wid & 1, h = kvh * 4 + g, fr = lane & 15, fq = lane >> 4;
    const float slope2 = exp2f(-(float)(h + 1)) * LOG2E, sink2 = p.sinks[layer * 8 + h] * LOG2E;
    const size_t rowbase = (size_t)b * 4096 + qb * 128;
    bf16x8 qall[4][2];
#pragma unroll
    for (int qt = 0; qt < 4; ++qt) { const bf16_t* qp = QKV + (rowbase + qh * 64 + qt * 16 + fr) * 768 + h * 64 + 8 * fq; qall[qt][0] = *(const bf16x8*)qp; qall[qt][1] = *(const bf16x8*)(qp + 32); }
#pragma unroll
    for (int qt = 0; qt < 4; ++qt) {
        const int i0 = qh * 64 + qt * 16, jb = 32 * ((qh * 4 + qt) >> 1), iq = i0 + fr;
        const bf16x8 q0 = qall[qt][0], q1 = qall[qt][1];
        f32x4 s[10];
        float mx = sink2;
        const bool odd = (qt & 1) != 0;
        if (qb > 0) {
            const float t0 = -slope2 * (float)(iq + 128 - jb - 4 * fq);
            const float tb0 = t0, tb1 = t0 + slope2, tb2 = t0 + 2.0f * slope2, tb3 = t0 + 3.0f * slope2;
#pragma unroll
            for (int kt = 0; kt < 10; ++kt) {
                const bool dead = odd ? (kt == 0) : (kt == 9);
                if (dead) { s[kt] = (f32x4){0.f, 0.f, 0.f, 0.f}; continue; }
                const float c = slope2 * (float)(16 * kt);
                const LAS bf16_t* kp = Ks + (jb + 16 * kt + fr) * 72 + 8 * fq;
                const bf16x8 k0 = *(const LAS bf16x8*)kp, k1 = *(const LAS bf16x8*)(kp + 32);
                s[kt] = mfma16(k0, q0, (f32x4){tb0 + c, tb1 + c, tb2 + c, tb3 + c}); s[kt] = mfma16(k1, q1, s[kt]);
                const bool lo = odd ? (kt == 1) : (kt == 0), hi = odd ? (kt == 9) : (kt == 8);
#pragma unroll
                for (int i = 0; i < 4; ++i) {
                    if (lo) s[kt][i] = (4 * fq + i >= fr) ? s[kt][i] : -1e30f;
                    if (hi) s[kt][i] = (4 * fq + i <= fr) ? s[kt][i] : -1e30f;
                    mx = fmaxf(mx, s[kt][i]); }
            }
        } else {
#pragma unroll
            for (int kt = 0; kt < 10; ++kt) { const LAS bf16_t* kp = Ks + (jb + 16 * kt + fr) * 72 + 8 * fq;
                const bf16x8 k0 = *(const LAS bf16x8*)kp, k1 = *(const LAS bf16x8*)(kp + 32);
                s[kt] = mfma16(k0, q0, (f32x4){0.f, 0.f, 0.f, 0.f}); s[kt] = mfma16(k1, q1, s[kt]); }
#pragma unroll
            for (int kt = 0; kt < 10; ++kt)
#pragma unroll
                for (int i = 0; i < 4; ++i) { const int j = jb + 16 * kt + 4 * fq + i, delta = iq + 128 - j;
                    const bool valid = (delta >= 0) && (delta <= 128) && (j >= 128);
                    const float v = s[kt][i] - slope2 * (float)delta;
                    s[kt][i] = valid ? v : -1e30f; mx = fmaxf(mx, s[kt][i]); }
        }
        mx = fmaxf(mx, __shfl_xor(mx, 16)); mx = fmaxf(mx, __shfl_xor(mx, 32));
        float sum = 0.f;
#pragma unroll
        for (int kt = 0; kt < 10; ++kt) {
            if (qb > 0 && (odd ? (kt == 0) : (kt == 9))) continue;
#pragma unroll
            for (int i = 0; i < 4; ++i) { const float pv = __builtin_amdgcn_exp2f(s[kt][i] - mx); s[kt][i] = pv; sum += pv; }
        }
        sum += __shfl_xor(sum, 16); sum += __shfl_xor(sum, 32);
        const float inv = 1.0f / (sum + __builtin_amdgcn_exp2f(sink2 - mx));
        bf16x8 pf[5];
#pragma unroll
        for (int G = 0; G < 5; ++G) pf[G] = pack8(s[2 * G], s[2 * G + 1]);
#pragma unroll
        for (int dt = 0; dt < 4; ++dt) {
            f32x4 o = (f32x4){0.f, 0.f, 0.f, 0.f};
#pragma unroll
            for (int G = 0; G < 5; ++G) { const LAS bf16_t* vp = Vt + (16 * dt + fr) * 264 + jb + 32 * G + 4 * fq;
                const u32x2 lo = *(const LAS u32x2*)vp, hi = *(const LAS u32x2*)(vp + 16);
                const u32x4 w = (u32x4){lo.x, lo.y, hi.x, hi.y};
                o = mfma16(__builtin_bit_cast(bf16x8, w), pf[G], o); }
            st_bf4(MIX + (rowbase + iq) * 1024 + h * 64 + 16 * dt + 4 * fq, o * inv);
        }
    }
    __syncthreads();
}

DI void sattn_item(const Params& p, int layer, int j, LAS unsigned char* lds, int tid, int wid, int lane) {
    RELAUNDER();
    LAS float* Kc = (LAS float*)lds;
    LAS float* Vc = Kc + 129 * 132;
    LAS float* Ps = Vc + 129 * 132;
    LAS float* Qs = Ps + 8 * 132;
    const size_t cbase = ((size_t)(layer * 128 + j)) * 128 * 128;
    const f32x4* ck = (const f32x4*)(p.ck + cbase); const f32x4* cv = (const f32x4*)(p.cv + cbase);
    f32x4* sk = (f32x4*)(p.out + O_SK + cbase); f32x4* sv = (f32x4*)(p.out + O_SV + cbase);
#pragma unroll
    for (int i = 0; i < 8; ++i) { const int idx = tid + 512 * i, s = idx >> 5, c4 = idx & 31;
        const f32x4 kv = __builtin_nontemporal_load(ck + idx), vv = __builtin_nontemporal_load(cv + idx);
        *(LAS f32x4*)(Kc + s * 132 + 4 * c4) = kv; *(LAS f32x4*)(Vc + s * 132 + 4 * c4) = vv;
        if (s >= 1) { __builtin_nontemporal_store(kv, sk + (idx - 32)); __builtin_nontemporal_store(vv, sv + (idx - 32)); } }
    if (tid < 32) *(LAS f32x4*)(Kc + 128 * 132 + 4 * tid) = sk[127 * 32 + tid];
    else if (tid < 64) *(LAS f32x4*)(Vc + 128 * 132 + 4 * (tid - 32)) = sv[127 * 32 + (tid - 32)];
    const bf16_t* QKV = (const bf16_t*)(p.ws + WS_QKV);
    Qs[tid] = bf2f(QKV[(size_t)(TP + j) * 768 + tid]);
    __syncthreads();
    const int h = wid, kvh = h >> 2;
    const float slope = exp2f(-(float)(h + 1)), sink2 = p.sinks[layer * 8 + h] * LOG2E;
    float sc[3];
#pragma unroll
    for (int r = 0; r < 3; ++r) {
        const int s = (r < 2) ? lane + 64 * r : 128;
        const LAS f32x4* kp = (const LAS f32x4*)(Kc + s * 132 + kvh * 64); const LAS f32x4* qp = (const LAS f32x4*)(Qs + h * 64);
        float d = 0.f;
#pragma unroll
        for (int i = 0; i < 16; ++i) { const f32x4 a = kp[i], q = qp[i]; d += (a.x * q.x + a.y * q.y) + (a.z * q.z + a.w * q.w); }
        const float delta = (float)(128 - s);
        sc[r] = d - slope * LOG2E * delta;
        if (r == 2 && lane != 0) sc[r] = -1e30f;
    }
    float mx = fmaxf(fmaxf(sc[0], sc[1]), fmaxf(sc[2], sink2));
#pragma unroll
    for (int o = 1; o < 64; o <<= 1) mx = fmaxf(mx, __shfl_xor(mx, o));
    float sum = 0.f;
#pragma unroll
    for (int r = 0; r < 3; ++r) { sc[r] = __builtin_amdgcn_exp2f(sc[r] - mx); sum += sc[r]; }
#pragma unroll
    for (int o = 1; o < 64; o <<= 1) sum += __shfl_xor(sum, o);
    const float inv = 1.0f / (sum + __builtin_amdgcn_exp2f(sink2 - mx));
    Ps[h * 132 + lane] = sc[0]; Ps[h * 132 + 64 + lane] = sc[1]; if (lane == 0) Ps[h * 132 + 128] = sc[2];
    lds_wait();
    float o = 0.f;
#pragma unroll 8
    for (int s = 0; s < 129; ++s) o += Ps[h * 132 + s] * Vc[s * 132 + kvh * 64 + lane];
    bf16_t* MIX = (bf16_t*)(p.ws + WS_MIX);
    MIX[(size_t)(TP + j) * 1024 + h * 64 + lane] = (bf16_t)(pk2(o * inv, 0.f) & 0xffffu);
    __syncthreads();
}

DI float fsigmoid(float x) { return __builtin_amdgcn_rcpf(1.0f + __builtin_amdgcn_exp2f(-LOG2E * x)); }
DI void rglru_item(const Params& p, int layer, int item, LAS unsigned char* lds, int tid, int wid, int lane) {
    RELAUNDER();
    LAS float* XC = (LAS float*)lds;
    const bf16_t* U2 = (const bf16_t*)(p.ws + WS_U2);
    const int ti = item >> 1, chalf = item & 1;
    const bool smp = (ti == 128);
    const int b = ti >> 5, ch = ti & 31;
    {
        const int cq = tid & 31, tg = tid >> 5, cqg = chalf * 32 + cq;
        const f32x4 cb = ((const f32x4*)(p.conv_b + layer * 256))[cqg];
        f32x4 cw[4];
#pragma unroll
        for (int t = 0; t < 4; ++t) cw[t] = ((const f32x4*)(p.conv_w + (layer * 4 + t) * 256))[cqg];
        if (!smp) {
            f32x4 x[11];
#pragma unroll
            for (int k = 0; k < 11; ++k) { const int t = ch * 128 + 8 * tg - 3 + k;
                x[k] = (t >= 0) ? ld_bf4(U2 + ((size_t)b * 4096 + t) * 768 + 4 * cqg) : (f32x4){0.f, 0.f, 0.f, 0.f}; }
#pragma unroll
            for (int k = 0; k < 8; ++k) { const f32x4 xc = cb + cw[0] * x[k] + cw[1] * x[k + 1] + cw[2] * x[k + 2] + cw[3] * x[k + 3];
                *(LAS f32x4*)(XC + (8 * tg + k) * 132 + 4 * cq) = xc; }
            if (ch == 31 && tg == 15) { f32x4* pc = (f32x4*)(p.out + O_PC + (size_t)(layer * 4 + b) * 3 * 256);
                pc[0 * 64 + cqg] = x[8]; pc[1 * 64 + cqg] = x[9]; pc[2 * 64 + cqg] = x[10]; }
        } else {
#pragma unroll 4
            for (int k = 0; k < 8; ++k) { const int j = 8 * tg + k;
                const f32x4* scp = (const f32x4*)(p.sc + (size_t)(layer * 128 + j) * 3 * 256);
                const f32x4 s0 = scp[cqg], s1 = scp[64 + cqg], s2 = scp[128 + cqg], xr = ld_bf4(U2 + (size_t)(TP + j) * 768 + 4 * cqg);
                const f32x4 xc = cb + cw[0] * s0 + cw[1] * s1 + cw[2] * s2 + cw[3] * xr;
                *(LAS f32x4*)(XC + j * 132 + 4 * cq) = xc;
                f32x4* oc = (f32x4*)(p.out + O_SC + (size_t)(layer * 128 + j) * 3 * 256);
                oc[cqg] = s1; oc[64 + cqg] = s2; oc[128 + cqg] = xr; }
        }
    }
    __syncthreads();
    const int nl = wid >> 2, n = 2 * chalf + nl, fr = lane & 15, fq = lane >> 4;
    const int d = 16 * (wid & 3) + fr, cl = 64 * nl + d, c = 128 * chalf + cl;
    const bf16_t* GaT = (const bf16_t*)(p.ws + WS_GAT); const bf16_t* GxT = (const bf16_t*)(p.ws + WS_GXT);
    bf16x8 wa[2], wx[2];
#pragma unroll
    for (int ks = 0; ks < 2; ++ks) { const size_t o = ((size_t)((layer * 4 + n) * 64 + d)) * 64 + 32 * ks + 8 * fq; wa[ks] = *(const bf16x8*)(GaT + o); wx[ks] = *(const bf16x8*)(GxT + o); }
    const float ba = p.ga_b[layer * 256 + c], bx = p.gx_b[layer * 256 + c];
    const float spv = -8.0f * LOG2E * log1pf(__expf(-p.lam[layer * 256 + c]));
    float Ac = 1.f, Bc = 0.f;
    unsigned* HC = (unsigned*)(p.ws + WS_HL);
    bf16_t* MIX = (bf16_t*)(p.ws + WS_MIX);
    float h0n[4] = {0.f, 0.f, 0.f, 0.f}, grn[4] = {0.f, 0.f, 0.f, 0.f};
    if (smp) {
#pragma unroll
        for (int i = 0; i < 4; ++i) { const int j = 4 * fq + i; h0n[i] = p.sh[(size_t)(layer * 128 + j) * 256 + c]; grn[i] = bf2f(U2[(size_t)(TP + j) * 768 + 256 + c]); }
    }
    for (int tt = 0; tt < 8; ++tt) {
        float h0c[4], grc[4];
#pragma unroll
        for (int i = 0; i < 4; ++i) { h0c[i] = h0n[i]; grc[i] = grn[i]; }
        if (smp && tt < 7) {
#pragma unroll
            for (int i = 0; i < 4; ++i) { const int j = 16 * (tt + 1) + 4 * fq + i; h0n[i] = p.sh[(size_t)(layer * 128 + j) * 256 + c]; grn[i] = bf2f(U2[(size_t)(TP + j) * 768 + 256 + c]); }
        }
        bf16x8 af[2];
#pragma unroll
        for (int ks = 0; ks < 2; ++ks) { const LAS f32x4* src = (const LAS f32x4*)(XC + (16 * tt + fr) * 132 + 64 * nl + 32 * ks + 8 * fq); af[ks] = pack8(src[0], src[1]); }
        f32x4 ar = (f32x4){0.f, 0.f, 0.f, 0.f}, ai = (f32x4){0.f, 0.f, 0.f, 0.f};
#pragma unroll
        for (int ks = 0; ks < 2; ++ks) { ar = mfma16(af[ks], wa[ks], ar); ai = mfma16(af[ks], wx[ks], ai); }
        float av[4], bv[4];
#pragma unroll
        for (int i = 0; i < 4; ++i) { const int t = 16 * tt + 4 * fq + i; const float xcv = XC[t * 132 + cl];
            const float r = fsigmoid(ar[i] + ba), ig = fsigmoid(ai[i] + bx);
            const float a = __builtin_amdgcn_exp2f(spv * r);
            av[i] = a; bv[i] = __builtin_amdgcn_sqrtf(fmaxf(1.0f - a * a, 0.f)) * (ig * xcv); }
        if (smp) {
#pragma unroll
            for (int i = 0; i < 4; ++i) { const int j = 16 * tt + 4 * fq + i;
                const float hv = av[i] * h0c[i] + bv[i];
                p.out[O_SH + (size_t)(layer * 128 + j) * 256 + c] = hv;
                MIX[(size_t)(TP + j) * 1024 + 512 + c] = (bf16_t)(pk2(hv * gelu_tanh(grc[i]), 0.f) & 0xffffu); }
        } else {
            float A4 = 1.f, B4 = 0.f;
#pragma unroll
            for (int i = 0; i < 4; ++i) { B4 = av[i] * B4 + bv[i]; A4 *= av[i]; }
            { const float A1 = __shfl_up(A4, 16), B1 = __shfl_up(B4, 16); if (fq >= 1) { B4 = A4 * B1 + B4; A4 = A4 * A1; } }
            { const float A2 = __shfl_up(A4, 32), B2 = __shfl_up(B4, 32); if (fq >= 2) { B4 = A4 * B2 + B4; A4 = A4 * A2; } }
            float Ae = __shfl_up(A4, 16), Be = __shfl_up(B4, 16); if (fq == 0) { Ae = 1.f; Be = 0.f; }
            const float At = __shfl(A4, 48 + fr), Bt = __shfl(B4, 48 + fr);
            float Ain = Ac * Ae, hin = Ae * Bc + Be;
#pragma unroll
            for (int i = 0; i < 4; ++i) { hin = av[i] * hin + bv[i]; Ain *= av[i];
                const size_t o = ((size_t)b * 4096 + ch * 128 + 16 * tt + 4 * fq + i) * 256 + c;
                HC[o] = pk2(hin, Ain); }
            Bc = At * Bc + Bt; Ac *= At;
        }
    }
    if (!smp && fq == 0) { ((float*)(p.ws + WS_AGA))[ti * 256 + c] = Ac; ((float*)(p.ws + WS_AGB))[ti * 256 + c] = Bc; }
    __syncthreads();
}

DI void rowsum_rows(const bf16_t* WT, const float* gain, const float* bias, int nrows, float* cs, float* bw, int gw, int NGW, int lane) {
    f32x4 r4[4];
#pragma unroll
    for (int j = 0; j < 4; ++j) { const f32x4 g4 = ((const f32x4*)gain)[lane * 4 + j], b4 = ((const f32x4*)bias)[lane * 4 + j]; r4[j] = b4 / g4; }
    for (int n = gw; n < nrows; n += NGW) {
        const u32x4* wp = (const u32x4*)(WT + (size_t)n * 1024 + 16 * lane);
        const u32x4 w0 = wp[0], w1 = wp[1];
        float s = 0.f, t = 0.f;
        const unsigned ww[8] = {w0.x, w0.y, w0.z, w0.w, w1.x, w1.y, w1.z, w1.w};
#pragma unroll
        for (int q = 0; q < 8; ++q) { const float lo = __uint_as_float(ww[q] << 16), hi = __uint_as_float(ww[q] & 0xffff0000u);
            s += lo + hi; t += lo * r4[q >> 1][(q & 1) * 2] + hi * r4[q >> 1][(q & 1) * 2 + 1]; }
#pragma unroll
        for (int o = 1; o < 64; o <<= 1) { s += __shfl_xor(s, o); t += __shfl_xor(t, o); }
        if (lane == 0) { cs[n] = s; bw[n] = t; }
    }
}

DI void fixup_item(const Params& p, int layer, int item, int tid) {
    tid = launder_v(tid);
    const int ti = item >> 2, qr = item & 3;
    const int b = ti >> 5, ch = ti & 31, c = tid & 255, half = tid >> 8;
    const float* AGA = (const float*)(p.ws + WS_AGA); const float* AGB = (const float*)(p.ws + WS_AGB);
    float carry = 0.f;
    {
        float ca[31], cb[31];
#pragma unroll
        for (int j = 0; j < 31; ++j) { const bool on = j < ch; ca[j] = on ? AGA[(b * 32 + j) * 256 + c] : 1.f; cb[j] = on ? AGB[(b * 32 + j) * 256 + c] : 0.f; }
#pragma unroll
        for (int j = 0; j < 31; ++j) carry = ca[j] * carry + cb[j];
    }
    const unsigned* HC = (const unsigned*)(p.ws + WS_HL); const bf16_t* U2 = (const bf16_t*)(p.ws + WS_U2);
    bf16_t* MIX = (bf16_t*)(p.ws + WS_MIX);
    const size_t row0 = (size_t)b * 4096 + ch * 128 + qr * 32 + half * 16;
    unsigned hc[16]; float grv[16];
#pragma unroll
    for (int k = 0; k < 16; ++k) { hc[k] = __builtin_nontemporal_load(HC + (row0 + k) * 256 + c); grv[k] = bf2f(__builtin_nontemporal_load(U2 + (row0 + k) * 768 + 256 + c)); }
    float h = 0.f;
#pragma unroll
    for (int k = 0; k < 16; ++k) { h = __uint_as_float(hc[k] << 16) + __uint_as_float(hc[k] & 0xffff0000u) * carry; MIX[(row0 + k) * 1024 + 512 + c] = (bf16_t)(pk2(h * gelu_tanh(grv[k]), 0.f) & 0xffffu); }
    if (ch == 31 && qr == 3 && half == 1) p.out[O_PH + (size_t)(layer * 4 + b) * 256 + c] = AGA[(b * 32 + 31) * 256 + c] * carry + AGB[(b * 32 + 31) * 256 + c];
}

DI void st_bf4_lds(LAS bf16_t* dst, f32x4 v) { u32x2 w; w.x = pk2(v.x, v.y); w.y = pk2(v.z, v.w); *(LAS u32x2*)dst = w; }
DI void pool_item(const Params& p, int layer, int ti, LAS unsigned char* lds, int tid, int wid, int lane) {
    RELAUNDER();
    LAS float* Zs = (LAS float*)lds;
    LAS bf16_t* Ds = (LAS bf16_t*)(lds + 48128);
    LAS bf16_t* Pw = (LAS bf16_t*)(lds + 115712);
    LAS float* Sc = (LAS float*)(lds + 152576);
    const bf16_t* U2 = (const bf16_t*)(p.ws + WS_U2);
    const bool smp = (ti >= 128);
    const int b = ti >> 5, ch = ti & 31;
    const int cq = tid & 63, gq = cq >> 4, tg = tid >> 6;
    const float wf = (float)(2 << gq);
    {
        const bf16_t* PwT = (const bf16_t*)(p.ws + WS_PWT) + (size_t)layer * 4 * 64 * 64;
#pragma unroll
        for (int i = 0; i < 4; ++i) { const int idx = tid + 512 * i, rowi = idx >> 3, c8 = idx & 7;
            *(LAS u32x4*)(Pw + rowi * 72 + 8 * c8) = *(const u32x4*)(PwT + (size_t)rowi * 64 + 8 * c8); }
        if (tid < 64) *(LAS f32x4*)(Sc + 4 * tid) = ((const f32x4*)(p.pool_scale + layer * 256))[tid];
    }
    if (!smp) {
        if (ch == 31) {
            for (int idx = tid; idx < 15 * 64; idx += NTHR) { const int r = idx >> 6, c4 = idx & 63;
                ((f32x4*)(p.out + O_PP + ((size_t)(layer * 4 + b) * 15 + r) * 256))[c4] = ld_bf4(U2 + ((size_t)b * 4096 + 4081 + r) * 768 + 512 + 4 * c4); }
        }
        f32x4 pf[6];
#pragma unroll
        for (int i = 0; i < 6; ++i) { const int e = tid + 512 * i, r = e >> 6, c4 = e & 63, t = ch * 128 - 15 + r;
            pf[i] = (e < 47 * 64 && t >= 0) ? ld_bf4(U2 + ((size_t)b * 4096 + t) * 768 + 512 + 4 * c4) : (f32x4){0.f, 0.f, 0.f, 0.f}; }
        for (int q = 0; q < 4; ++q) {
#pragma unroll
            for (int i = 0; i < 6; ++i) { const int e = tid + 512 * i; if (e < 47 * 64) *(LAS f32x4*)(Zs + 4 * e) = pf[i]; }
            __syncthreads();
            if (q < 3) {
#pragma unroll
                for (int i = 0; i < 6; ++i) { const int e = tid + 512 * i, r = e >> 6, c4 = e & 63, t = ch * 128 + 32 * (q + 1) - 15 + r;
                    pf[i] = (e < 47 * 64 && t >= 0) ? ld_bf4(U2 + ((size_t)b * 4096 + t) * 768 + 512 + 4 * c4) : (f32x4){0.f, 0.f, 0.f, 0.f}; }
            }
            f32x4 v[19], zs[4], res[4];
#pragma unroll
            for (int k = 0; k < 19; ++k) v[k] = *(const LAS f32x4*)(Zs + (4 * tg + k) * 256 + 4 * cq);
#pragma unroll
            for (int j = 0; j < 4; ++j) zs[j] = v[15 + j];
#pragma unroll
            for (int k = 18; k >= 1; --k) v[k] += v[k - 1];
#pragma unroll
            for (int j = 0; j < 4; ++j) res[j] = v[15 + j];
#pragma unroll
            for (int k = 18; k >= 3; --k) v[k] += v[k - 2];
#pragma unroll
            for (int j = 0; j < 4; ++j) res[j] = (gq >= 1) ? v[15 + j] : res[j];
#pragma unroll
            for (int k = 18; k >= 7; --k) v[k] += v[k - 4];
#pragma unroll
            for (int j = 0; j < 4; ++j) res[j] = (gq >= 2) ? v[15 + j] : res[j];
#pragma unroll
            for (int k = 18; k >= 15; --k) v[k] += v[k - 8];
#pragma unroll
            for (int j = 0; j < 4; ++j) res[j] = (gq >= 3) ? v[15 + j] : res[j];
#pragma unroll
            for (int j = 0; j < 4; ++j) { const int tl = 32 * q + 4 * tg + j; const float rc = __builtin_amdgcn_rcpf(fminf((float)(ch * 128 + tl + 1), wf));
                const f32x4 diff = res[j] * rc - zs[j];
                st_bf4_lds(Ds + tl * 264 + 4 * cq, diff); }
            __syncthreads();
        }
    } else {
        const int j0 = 32 * (ti - 128);
        const float rw = 1.0f / wf;
#pragma unroll 2
        for (int k = 0; k < 4; ++k) { const int jl = 4 * tg + k, j = j0 + jl;
            const f32x4* sp = (const f32x4*)(p.spool + (size_t)(layer * 128 + j) * 15 * 256);
            f32x4 st[15];
#pragma unroll
            for (int r = 0; r < 15; ++r) st[r] = sp[r * 64 + cq];
            const f32x4 z = ld_bf4(U2 + (size_t)(TP + j) * 768 + 512 + 4 * cq);
            const f32x4 s2 = z + st[14];
            const f32x4 s4 = s2 + (st[13] + st[12]);
            const f32x4 s8 = s4 + ((st[11] + st[10]) + (st[9] + st[8]));
            const f32x4 s16 = s8 + (((st[7] + st[6]) + (st[5] + st[4])) + ((st[3] + st[2]) + (st[1] + st[0])));
            const f32x4 rs = (gq == 0) ? s2 : ((gq == 1) ? s4 : ((gq == 2) ? s8 : s16));
            const f32x4 diff = rs * rw - z;
            st_bf4_lds(Ds + jl * 264 + 4 * cq, diff);
            f32x4* op = (f32x4*)(p.out + O_SP + (size_t)(layer * 128 + j) * 15 * 256);
#pragma unroll
            for (int r = 0; r < 14; ++r) op[r * 64 + cq] = st[r + 1];
            op[14 * 64 + cq] = z; }
        __syncthreads();
    }
    const int fr = lane & 15, fq = lane >> 4;
    bf16_t* MIX = (bf16_t*)(p.ws + WS_MIX);
    if (!smp || wid < 2) {
        const size_t row = smp ? (size_t)(TP + 32 * (ti - 128) + 16 * wid + fr) : ((size_t)b * 4096 + ch * 128 + 16 * wid + fr);
#pragma unroll
        for (int g = 0; g < 4; ++g) {
            bf16x8 bfr[2];
#pragma unroll
            for (int ks = 0; ks < 2; ++ks) bfr[ks] = *(const LAS bf16x8*)(Ds + (16 * wid + fr) * 264 + 64 * g + 32 * ks + 8 * fq);
#pragma unroll
            for (int dt = 0; dt < 4; ++dt) {
                f32x4 o = (f32x4){0.f, 0.f, 0.f, 0.f};
#pragma unroll
                for (int ks = 0; ks < 2; ++ks) { const bf16x8 a = *(const LAS bf16x8*)(Pw + (g * 64 + 16 * dt + fr) * 72 + 32 * ks + 8 * fq); o = mfma16(a, bfr[ks], o); }
                const int c = 64 * g + 16 * dt + 4 * fq;
                const f32x4 sc4 = *(const LAS f32x4*)(Sc + c);
                st_bf4(MIX + row * 1024 + 768 + c, o * sc4);
            }
        }
    }
    __syncthreads();
}

DI void final_ln(const Params& p, int vb, int G, int tid) {
    int wid, lane; RELAUNDER();
    const float* part = (const float*)(p.ws + WS_ST2); const float* part_s = (const float*)(p.ws + WS_STS2);
    const bf16_t* YB = (const bf16_t*)(p.ws + WS_YB);
    const f32x4* g = (const f32x4*)(p.ln2_g + 1024); const f32x4* bb = (const f32x4*)(p.ln2_b + 1024);
    f32x4 g4[4], b4[4];
#pragma unroll
    for (int j = 0; j < 4; ++j) { g4[j] = g[lane + 64 * j]; b4[j] = bb[lane + 64 * j]; }
    const int gw = vb * 8 + wid, NGW = G * 8;
    for (int row0 = gw; row0 < MT; row0 += 4 * NGW) {
        f32x4 y[4][4]; float mu[4], rs[4];
#pragma unroll
        for (int r = 0; r < 4; ++r) { const int row = (row0 + r * NGW < MT) ? row0 + r * NGW : row0;
#pragma unroll
            for (int j = 0; j < 4; ++j) y[r][j] = ld_bf4_nt(YB + (size_t)row * 1024 + 4 * (lane + 64 * j));
            row_stats_any(part, part_s, row, lane >> 4, mu[r], rs[r]); }
#pragma unroll
        for (int r = 0; r < 4; ++r) { const int row = row0 + r * NGW;
            if (row < MT) { f32x4* op = (f32x4*)(p.out + (size_t)row * 1024);
#pragma unroll
                for (int j = 0; j < 4; ++j) __builtin_nontemporal_store((y[r][j] - mu[r]) * rs[r] * g4[j] + b4[j], op + lane + 64 * j); } }
    }
}

#define XB_TMO      128
#define XB_XCNT(j)  (256  + 64 * (j))
#define XB_XSUB(j)  (1280 + 64 * (j))
#define XB_XGEN(j)  (2304 + 64 * (j))
#define XB_TOP      3328
#define XB_TOPGEN   3392
#define XCD_BAR_WORDS 3456
#define XB_SPIN_CAP (1u << 22)
DI unsigned xb_ld(unsigned* p)              { return __hip_atomic_load(p, __ATOMIC_RELAXED, __HIP_MEMORY_SCOPE_AGENT); }
DI unsigned xb_add(unsigned* p, unsigned v) { return __hip_atomic_fetch_add(p, v, __ATOMIC_RELAXED, __HIP_MEMORY_SCOPE_AGENT); }
DI unsigned xb_xcc_id() { return (unsigned)__builtin_amdgcn_s_getreg((3 << 11) | 20) & 0xFu; }
#define XB_SPIN(cond, bar) do { unsigned _sp = 0; while (cond) { __builtin_amdgcn_s_sleep(1); \
    if ((++_sp & 255u) == 0u) { if (xb_ld(&(bar)[XB_TMO])) break; if (_sp > XB_SPIN_CAP) { atomicAdd(&(bar)[XB_TMO], 1u); break; } } } } while (0)
DI void xcd_barrier_complete(unsigned* bar, unsigned x, unsigned& nloc, unsigned& nx) {
    const unsigned G = gridDim.x;
    unsigned sum, cnt, mine, sp = 0u;
    for (;;) {
        sum = 0u; cnt = 0u; mine = 0u;
#pragma unroll
        for (unsigned j = 0; j < 16; ++j) { const unsigned c = xb_ld(&bar[XB_XCNT(j)]); sum += c; cnt += (c > 0u) ? 1u : 0u; mine = (j == x) ? c : mine; }
        if (sum == G) break;
        __builtin_amdgcn_s_sleep(1);
        if ((++sp & 255u) == 0u) { if (xb_ld(&bar[XB_TMO])) break; if (sp > XB_SPIN_CAP) { atomicAdd(&bar[XB_TMO], 1u); break; } }
    }
    nloc = mine > 0u ? mine : 1u; nx = cnt > 0u ? cnt : 1u;
}
DI void xcd_barrier(unsigned* bar, volatile LAS unsigned* st) {
    asm volatile("s_waitcnt vmcnt(0)" ::: "memory");
    __syncthreads();
    if (threadIdx.x == 0) {
        const unsigned x = xb_xcc_id();
        __builtin_amdgcn_s_waitcnt(0);
        unsigned nloc = st[0], nx = st[1];
        if (nloc == 0u) { xcd_barrier_complete(bar, x, nloc, nx); st[0] = nloc; st[1] = nx; }
        const unsigned old = xb_add(&bar[XB_XSUB(x)], 1u);
        const unsigned gen = old / nloc;
        if (old + 1u == (gen + 1u) * nloc) {
            __builtin_amdgcn_fence(__ATOMIC_RELEASE, "agent");
            asm volatile("s_waitcnt vmcnt(0)" ::: "memory");
            const unsigned og = xb_add(&bar[XB_TOP], 1u);
            const unsigned tg = og / nx;
            if (og + 1u == (tg + 1u) * nx) xb_add(&bar[XB_TOPGEN], 1u);
            else XB_SPIN(xb_ld(&bar[XB_TOPGEN]) == tg, bar);
            __builtin_amdgcn_fence(__ATOMIC_ACQUIRE, "agent");
            xb_add(&bar[XB_XGEN(x)], 1u);
            asm volatile("s_waitcnt vmcnt(0)" ::: "memory");
        } else {
            XB_SPIN(xb_ld(&bar[XB_XGEN(x)]) == gen, bar);
            __builtin_amdgcn_fence(__ATOMIC_ACQUIRE, "agent");
            asm volatile("s_waitcnt vmcnt(0)" ::: "memory");
        }
    }
    __syncthreads();
}

DI int launder_i_unused(int x) { asm volatile("" : "+s"(x)); return x; }

__global__ void __launch_bounds__(NTHR, 2) hybrid_fwd(Params p_unused) {
    extern __shared__ __attribute__((aligned(16))) unsigned char smem[];
    LAS unsigned char* lds = (LAS unsigned char*)smem;
    cg::grid_group grid = cg::this_grid();
    const int tid = threadIdx.x, wid = __builtin_amdgcn_readfirstlane(tid >> 6), lane = tid & 63;
    const int vb = blockIdx.x, G = gridDim.x;
    volatile LAS unsigned* xst = (volatile LAS unsigned*)(lds + LDS_BYTES - 16);
    { unsigned* bar0 = (unsigned*)(kparams().ws + WS_BAR); if (tid == 0) { xst[0] = 0u; xst[1] = 0u; (void)xb_add(&bar0[XB_XCNT(xb_xcc_id())], 1u); } }
    __syncthreads();

#if !(PHOFF & 1)
    for (int rep = 0; rep < REP_PREP; ++rep) { const Params p = kparams(); phase_prep(p, lds, tid, wid, lane, vb, G); }
#endif
    if (kparams().out == nullptr) grid.sync();
    GSYNC();

#pragma nounroll
    for (int l0 = 0; l0 < 2; ++l0) {
#if !(PHOFF & 2)
        for (int rep = 0; rep < REP_G1; ++rep) {
            const Params p = kparams(); const int l = launder_i(l0); unsigned char* ws = p.ws;
            gemm_all<FIn>(lds, (const bf16_t*)(ws + WS_YB), (const bf16_t*)(ws + WS_WIN) + (size_t)l * 1536 * 1024, NIN, 1024, l, 0, vb, G, tid);
        }
#endif
        GSYNC();
        for (int rep = 0; rep < REP_MIX; ++rep) {
            const int l = launder_i(l0);
            unsigned* qctr = (unsigned*)(kparams().ws + WS_QCTR) + 64 * l;
            int it = vb;
            for (;;) {
                if (it >= 774) break;
#if !(PHOFF & 4)
                if (it < 256) for (int r2 = 0; r2 < REP_ATT; ++r2) { const Params p = kparams(); attn_item(p, l, it, lds, tid, wid, lane); }
#endif
#if !(PHOFF & 8)
                if (it >= 256 && it < 514) for (int r2 = 0; r2 < REP_RG; ++r2) { const Params p = kparams(); rglru_item(p, l, (it < 258) ? (it) : (it - 258), lds, tid, wid, lane); }
#endif
#if !(PHOFF & 16)
                if (it >= 514 && it < 646) for (int r2 = 0; r2 < REP_POOL; ++r2) { const Params p = kparams(); pool_item(p, l, it - 514, lds, tid, wid, lane); }
#endif
#if !(PHOFF & 32)
                if (it >= 646) for (int r2 = 0; r2 < REP_SATT; ++r2) { const Params p = kparams(); sattn_item(p, l, it - 646, lds, tid, wid, lane); }
#endif
                if (tid == 0) xst[2] = G + xb_add(qctr, 1u);
                __syncthreads();
                it = __builtin_amdgcn_readfirstlane((int)xst[2]);
                __syncthreads();
            }
        }
        GSYNC();
#if !(PHOFF & 64)
        for (int rep = 0; rep < REP_FIX; ++rep) { const Params p = kparams(); const int l = launder_i(l0); for (int it = vb; it < 512; it += G) fixup_item(p, l, it, tid); }
#endif
        {
            const Params p = kparams(); const int l = launder_i(l0); unsigned char* ws = p.ws;
            const int tid2 = launder_v(tid), lane2 = tid2 & 63, gw = vb * 8 + (tid2 >> 6), NGW = G * 8;
            rowsum_rows((const bf16_t*)(ws + WS_W1) + (size_t)l * 4096 * 1024, p.ln1_g + l * 1024, p.ln1_b + l * 1024, 4096, (float*)(ws + WS_CS1) + l * 4096, (float*)(ws + WS_BW1) + l * 4096, gw, NGW, lane2);
            if (l == 0) rowsum_rows((const bf16_t*)(ws + WS_WIN) + (size_t)1536 * 1024, p.ln2_g, p.ln2_b, 1536, (float*)(ws + WS_CSIN) + 1536, (float*)(ws + WS_BWIN) + 1536, gw, NGW, lane2);
        }
        GSYNC();
#if !(PHOFF & 128)
        for (int rep = 0; rep < REP_G2; ++rep) {
            const Params p = kparams(); const int l = launder_i(l0); unsigned char* ws = p.ws;
#if REP_G2 > 1
            if (rep < REP_G2 - 1) gemm_all<FResT<true>>(lds, (const bf16_t*)(ws + WS_MIX), (const bf16_t*)(ws + WS_WOUT) + (size_t)l * 1024 * 1024, 1024, 1024, l, 0, vb, G, tid); else
#endif
            gemm_all<FRes>(lds, (const bf16_t*)(ws + WS_MIX), (const bf16_t*)(ws + WS_WOUT) + (size_t)l * 1024 * 1024, 1024, 1024, l, 0, vb, G, tid);
        }
#endif
        GSYNC();
#if !(PHOFF & 256)
        for (int rep = 0; rep < REP_G3; ++rep) {
            const Params p = kparams(); const int l = launder_i(l0); unsigned char* ws = p.ws;
            gemm_all<FFF1>(lds, (const bf16_t*)(ws + WS_YB), (const bf16_t*)(ws + WS_W1) + (size_t)l * 4096 * 1024, DFF, 1024, l, 0, vb, G, tid);
        }
#endif
        GSYNC();
#if !(PHOFF & 512)
        for (int rep = 0; rep < REP_G4; ++rep) {
            const Params p = kparams(); const int l = launder_i(l0); unsigned char* ws = p.ws;
#if REP_G4 > 1
            if (rep < REP_G4 - 1) gemm_all<FResT<true>>(lds, (const bf16_t*)(ws + WS_HID), (const bf16_t*)(ws + WS_W2) + (size_t)l * 1024 * 4096, 1024, 4096, l, 1, vb, G, tid); else
#endif
            gemm_all<FRes>(lds, (const bf16_t*)(ws + WS_HID), (const bf16_t*)(ws + WS_W2) + (size_t)l * 1024 * 4096, 1024, 4096, l, 1, vb, G, tid);
        }
#endif
        GSYNC();
    }
    { const Params p = kparams(); final_ln(p, vb, G, tid); }
}

extern "C" void kernel_launch(void* const* d_in, const int* in_sizes, int n_in, void* d_out, int out_size, void* d_ws, size_t ws_size, hipStream_t stream) {
    static int grid_blocks = 0;
    if (!grid_blocks) {
        int dev = 0, cus = 0, per_cu = 0;
        hipGetDevice(&dev);
        hipDeviceGetAttribute(&cus, hipDeviceAttributeMultiprocessorCount, dev);
        hipFuncSetAttribute((const void*)hybrid_fwd, hipFuncAttributeMaxDynamicSharedMemorySize, LDS_BYTES);
        hipOccupancyMaxActiveBlocksPerMultiprocessor(&per_cu, (const void*)hybrid_fwd, NTHR, LDS_BYTES);
        if (per_cu < 1) per_cu = 1;
        grid_blocks = cus * per_cu;
        if (ws_size < WS_END) fprintf(stderr, "kernel_launch: workspace too small: %zu < %zu\n", ws_size, (size_t)WS_END);
        fprintf(stderr, "kernel_launch: grid %d (cus %d x %d)\n", grid_blocks, cus, per_cu);
    }
    if (hipMemsetAsync((char*)d_ws + WS_BAR, 0, XCD_BAR_WORDS * 4 + 1024, stream) != hipSuccess) fprintf(stderr, "memset failed\n");
    Params p{};
    const float** pp = (const float**)&p;
    for (int i = 0; i < 25; ++i) pp[i] = (const float*)d_in[i];
    p.out = (float*)d_out; p.ws = (unsigned char*)d_ws;
    void* args[] = {&p};
    hipError_t e = hipLaunchCooperativeKernel((const void*)hybrid_fwd, dim3(grid_blocks), dim3(NTHR), args, LDS_BYTES, stream);
    if (e != hipSuccess) fprintf(stderr, "cooperative launch failed: %s (grid %d)\n", hipGetErrorString(e), grid_blocks);
}
```

```cpp
#include <hip/hip_runtime.h>
#include <hip/hip_cooperative_groups.h>
#include <cstdio>
namespace cg = cooperative_groups;

#define LAS __attribute__((address_space(3)))
typedef unsigned short bf16_t;
typedef short bf16x8 __attribute__((ext_vector_type(8)));
typedef float f32x4 __attribute__((ext_vector_type(4)));
typedef float f32x2 __attribute__((ext_vector_type(2)));
typedef unsigned u32x4 __attribute__((ext_vector_type(4)));
typedef unsigned u32x2 __attribute__((ext_vector_type(2)));
#define DI __device__ __forceinline__
#ifndef PHOFF
#define PHOFF 0
#endif
#ifndef REP_SYNC
#define REP_SYNC 1
#endif
#ifndef REP_MIX
#define REP_MIX 1
#endif
#ifndef REP_G3
#define REP_G3 1
#endif
#ifndef REP_PREP
#define REP_PREP 1
#endif
#ifndef REP_FIX
#define REP_FIX 1
#endif
#ifndef REP_ATT
#define REP_ATT 1
#endif
#ifndef REP_RG
#define REP_RG 1
#endif
#ifndef REP_POOL
#define REP_POOL 1
#endif
#ifndef REP_SATT
#define REP_SATT 1
#endif
#ifndef REP_G2
#define REP_G2 1
#endif
#ifndef REP_G4
#define REP_G4 1
#endif
#ifndef REP_G1
#define REP_G1 1
#endif
#define GSYNC() do { for (int _r = 0; _r < REP_SYNC; ++_r) { unsigned* _bar = (unsigned*)(kparams().ws + WS_BAR); xcd_barrier(_bar, xst); } } while (0)

constexpr int DM = 1024, TP = 16384, TS = 128, MT = TP + TS, NIN = 1536, DFF = 4096;
constexpr int NTHR = 512;
constexpr float LOG2E = 1.4426950408889634f;
constexpr float ALPHA = 1.4142135623730951f;
constexpr float QSCALE = 0.125f * 1.4426950408889634f;
constexpr float LN_EPS = 1e-5f;
constexpr size_t O_YP = 0, O_YS = 16777216, O_PK = 16908288, O_PV = 17039360, O_PH = 17170432, O_PC = 17172480, O_PP = 17178624,
                 O_SK = 17209344, O_SV = 21403648, O_SH = 25597952, O_SC = 25663488, O_SP = 25860096;
constexpr size_t WS_WIN = 0;
constexpr size_t WS_WOUT = WS_WIN + 2ull * 1536 * 1024 * 2;
constexpr size_t WS_W1 = WS_WOUT + 2ull * 1024 * 1024 * 2;
constexpr size_t WS_W2 = WS_W1 + 2ull * 4096 * 1024 * 2;
constexpr size_t WS_YB = WS_W2 + 2ull * 4096 * 1024 * 2;
constexpr size_t WS_MIX = WS_YB + (size_t)MT * 1024 * 2;
constexpr size_t WS_HID = WS_MIX + (size_t)MT * 1024 * 2;
constexpr size_t WS_QKV = WS_HID;
constexpr size_t WS_U2 = WS_QKV + (size_t)MT * 768 * 2;
constexpr size_t WS_HL = WS_U2 + (size_t)MT * 768 * 4;
constexpr size_t WS_CA = WS_HL + (size_t)TP * 256 * 4;
constexpr size_t WS_ST1 = WS_HID + (size_t)MT * 4096 * 2;
constexpr size_t WS_ST2 = WS_ST1 + (size_t)MT * 32 * 4;
constexpr size_t WS_CSIN = WS_ST2 + (size_t)MT * 32 * 4;
constexpr size_t WS_BWIN = WS_CSIN + 2 * 1536 * 4;
constexpr size_t WS_CS1 = WS_BWIN + 2 * 1536 * 4;
constexpr size_t WS_BW1 = WS_CS1 + 2 * 4096 * 4;
constexpr size_t WS_GAT = WS_BW1 + 2 * 4096 * 4;
constexpr size_t WS_GXT = WS_GAT + 2 * 4 * 64 * 64 * 2;
constexpr size_t WS_PWT = WS_GXT + 2 * 4 * 64 * 64 * 2;
constexpr size_t WS_AGA = WS_PWT + 2 * 4 * 64 * 64 * 2;
constexpr size_t WS_AGB = WS_AGA + 128 * 256 * 4;
constexpr size_t WS_STS1 = WS_AGB + 128 * 256 * 4;
constexpr size_t WS_STS2 = WS_STS1 + 128 * 128 * 4;
constexpr size_t WS_BAR = WS_STS2 + 128 * 128 * 4;
constexpr size_t WS_QCTR = WS_BAR + 3456 * 4;
constexpr size_t WS_END = WS_QCTR + 1024;
static_assert(WS_CA + (size_t)TP * 256 * 4 <= WS_ST1, "alias region overflow");
static_assert(WS_END <= 268435456ull, "workspace budget");
constexpr int LDS_BYTES = 163840;

struct Params {
    const float* xp; const float* xs; const float* ck; const float* cv; const float* sh; const float* sc; const float* spool;
    const float* w_in; const float* sinks; const float* conv_w; const float* conv_b; const float* ga_w; const float* ga_b; const float* gx_w; const float* gx_b; const float* lam;
    const float* pool_w; const float* pool_scale; const float* w_out; const float* ln1_g; const float* ln1_b; const float* w_ff1; const float* w_ff2; const float* ln2_g; const float* ln2_b;
    float* out; unsigned char* ws;
};

DI unsigned pk2(float lo, float hi) { unsigned r; asm volatile("v_cvt_pk_bf16_f32 %0, %1, %2" : "=v"(r) : "v"(lo), "v"(hi)); return r; }
DI float bf2f(bf16_t b) { return __uint_as_float(((unsigned)b) << 16); }
DI float bfround(float x) { return __uint_as_float(pk2(x, 0.f) << 16); }
DI f32x4 mfma16(bf16x8 a, bf16x8 b, f32x4 c) { return __builtin_amdgcn_mfma_f32_16x16x32_bf16(a, b, c, 0, 0, 0); }
DI int launder_v(int x) { asm volatile("" : "+v"(x)); return x; }
DI int launder_i(int x) { asm volatile("" : "+s"(x)); return x; }
#define RELAUNDER() do { tid = launder_v(tid); lane = tid & 63; wid = __builtin_amdgcn_readfirstlane(tid >> 6); } while (0)
DI void lds_wait() { asm volatile("s_waitcnt lgkmcnt(0)" ::: "memory"); }
DI float sigmoidf_(float x) { return 1.0f / (1.0f + __expf(-x)); }
DI float gelu_tanh(float x) { const float u = 0.7978845608028654f * (x + 0.044715f * x * x * x); return x * __builtin_amdgcn_rcpf(1.0f + __builtin_amdgcn_exp2f(-2.0f * 1.4426950408889634f * u)); }
DI bf16x8 pack8(f32x4 lo, f32x4 hi) { u32x4 w; w.x = pk2(lo.x, lo.y); w.y = pk2(lo.z, lo.w); w.z = pk2(hi.x, hi.y); w.w = pk2(hi.z, hi.w); return __builtin_bit_cast(bf16x8, w); }
DI f32x4 ld_bf4_nt(const bf16_t* p) { const u32x2 w = __builtin_nontemporal_load((const u32x2*)p); return (f32x4){__uint_as_float(w.x << 16), __uint_as_float(w.x & 0xffff0000u), __uint_as_float(w.y << 16), __uint_as_float(w.y & 0xffff0000u)}; }
DI f32x4 ld_bf4(const bf16_t* p) { const u32x2 w = *(const u32x2*)p; return (f32x4){__uint_as_float(w.x << 16), __uint_as_float(w.x & 0xffff0000u), __uint_as_float(w.y << 16), __uint_as_float(w.y & 0xffff0000u)}; }
DI void st_bf4(bf16_t* dst, f32x4 v) { u32x2 w; w.x = pk2(v.x, v.y); w.y = pk2(v.z, v.w); *(u32x2*)dst = w; }

namespace pg8 {
constexpr int BM = 256, BK = 64, HALF = 128, HTB = HALF * BK * 2, STAGE_BYTES = 8 * HTB, NXCD = 8, WGM = 8;
DI int lds_byte(int r, int c) { const int st = (r >> 4) * 2 + (c >> 5), rr = r & 15, cc = c & 31, ob = rr * 64 + cc * 2; return st * 1024 + (ob ^ (((ob >> 9) & 1) << 5)); }
DI void stage_rc(int b, int& R, int& C) { const int st = b / 1024, sb = b % 1024, swz = sb ^ (((sb >> 9) & 1) << 5); R = (st >> 1) * 16 + swz / 64; C = (st & 1) * 32 + (swz % 64) / 2; }
DI int perm32(int rho) { const int n = rho >> 4, i = rho & 15; return 8 * (i >> 2) + 4 * n + (i & 3); }
struct Unit { int pm, pn; };
struct Gemm { const bf16_t* A; const bf16_t* Bt; int M, N, K; };
struct StaticOrder {
    int nM, nN, nwg, G, c;
    DI void init(int M, int N, int G_, int c_) { nM = M / BM; nN = N / BM; nwg = nM * nN; G = G_; c = c_; }
    DI bool next(int i, Unit& u) const {
        const long L = (long)i * G + c; if (L >= nwg) return false;
        int wgid = (int)L; { const int q = nwg / NXCD, r = nwg % NXCD, xcd = wgid % NXCD, off = wgid / NXCD; wgid = (xcd < r ? xcd * (q + 1) : r * (q + 1) + (xcd - r) * q) + off; }
        const int nig = WGM * nN, gid = wgid / nig, fm = gid * WGM, gsz = (nM - fm) < WGM ? (nM - fm) : WGM;
        u.pm = fm + ((wgid % nig) % gsz); u.pn = (wgid % nig) / gsz; return true;
    }
};

template <class Epi>
DI void gemm_phase(LAS unsigned char* lds, const Gemm g, const StaticOrder& S, const Epi& E, int tid) {
    const int wid = __builtin_amdgcn_readfirstlane(tid >> 6), lane = tid & 63, wr = wid >> 2, wc = wid & 3, fr = lane & 15, fq = lane >> 4;
    const int K = g.K, nt = K / BK;
    unsigned voffA[2], voffB[2];
#pragma unroll
    for (int i = 0; i < 2; ++i) { int R, C; stage_rc(tid * 16 + i * 8192, R, C); const int Rb = (R & ~31) + perm32(R & 31); voffA[i] = (unsigned)(R * K + C) * 2u; voffB[i] = (unsigned)(Rb * K + C) * 2u; }
    const size_t kstep = (size_t)(BK * 2);
    const size_t hstep = (size_t)HALF * K * 2;
    const size_t tstep = 2 * hstep;
    const unsigned ldsw = (unsigned)wid * 1024u;
    const int aoff = lds_byte(wr * 64 + fr, fq * 8), boff = lds_byte(wc * 32 + fr, fq * 8);
#define PG8_SA(b, h) (((b) * 2 + (h)) * HTB)
#define PG8_SB(b, h) ((4 + (b) * 2 + (h)) * HTB)
#define PG8_STAGE(bufoff, gbase, voff) do { _Pragma("unroll") for (int _i = 0; _i < 2; ++_i) \
        __builtin_amdgcn_global_load_lds((const unsigned*)((const char*)(gbase) + (voff)[_i]), (LAS unsigned*)(lds + (bufoff) + ldsw + _i * 8192), 16, 0, 0); } while (0)
#define PG8_LDA(dst, b, h) do { _Pragma("unroll") for (int m = 0; m < 4; ++m) _Pragma("unroll") for (int k = 0; k < 2; ++k) dst[m][k] = *(const LAS bf16x8*)(lds + PG8_SA(b, h) + aoff + m * 2048 + k * 1024); } while (0)
#define PG8_LDB(dst, b, h) do { _Pragma("unroll") for (int n = 0; n < 2; ++n) _Pragma("unroll") for (int k = 0; k < 2; ++k) dst[n][k] = *(const LAS bf16x8*)(lds + PG8_SB(b, h) + boff + n * 2048 + k * 1024); } while (0)
#define PG8_MMA(ai, bj, At, Bt) do { __builtin_amdgcn_s_setprio(1); _Pragma("unroll") for (int m = 0; m < 4; ++m) _Pragma("unroll") for (int n = 0; n < 2; ++n) _Pragma("unroll") for (int k = 0; k < 2; ++k) \
        acc[ai][bj][m][n] = __builtin_amdgcn_mfma_f32_16x16x32_bf16(Bt[n][k], At[m][k], acc[ai][bj][m][n], 0, 0, 0); __builtin_amdgcn_s_setprio(0); } while (0)
#define PG8_WAIT_V(n) asm volatile("s_waitcnt vmcnt(" #n ")" ::: "memory")
#define PG8_WAIT_L(n) asm volatile("s_waitcnt lgkmcnt(" #n ")" ::: "memory")
#define PG8_BAR __builtin_amdgcn_s_barrier()
#define PG8_SCHED __builtin_amdgcn_sched_barrier(0)
    Unit cur, nxt; int ui = 0;
    if (!S.next(0, cur)) return;
    f32x4 acc[2][2][4][2];
#pragma unroll
    for (int a = 0; a < 2; ++a)
#pragma unroll
        for (int b = 0; b < 2; ++b)
#pragma unroll
            for (int m = 0; m < 4; ++m)
#pragma unroll
                for (int n = 0; n < 2; ++n) acc[a][b][m][n] = (f32x4){0.f, 0.f, 0.f, 0.f};
    bf16x8 At[4][2], B0[2][2], B1[2][2];
    const char* cA = (const char*)g.A + (size_t)cur.pm * tstep; const char* cB = (const char*)g.Bt + (size_t)cur.pn * tstep;
    PG8_STAGE(PG8_SB(0, 0), cB, voffB); PG8_STAGE(PG8_SA(0, 0), cA, voffA); PG8_STAGE(PG8_SB(0, 1), cB + hstep, voffB); PG8_STAGE(PG8_SA(0, 1), cA + hstep, voffA);
    if (wr == 1) PG8_BAR;
    PG8_WAIT_V(4); PG8_BAR;
    PG8_STAGE(PG8_SB(1, 0), cB + kstep, voffB); PG8_STAGE(PG8_SA(1, 0), cA + kstep, voffA); PG8_STAGE(PG8_SB(1, 1), cB + hstep + kstep, voffB);
    PG8_WAIT_V(6); PG8_BAR;
    for (;;) {
        const bool has_next = S.next(ui + 1, nxt);
        const char* nA = has_next ? (const char*)g.A + (size_t)nxt.pm * tstep : cA; const char* nB = has_next ? (const char*)g.Bt + (size_t)nxt.pn * tstep : cB;
        for (int t = 0; t < nt; t += 2) {
            const bool last = (t == nt - 2);
            const char* a1 = cA + (size_t)(t + 1) * kstep;
            const char* a2 = last ? nA : cA + (size_t)(t + 2) * kstep; const char* b2 = last ? nB : cB + (size_t)(t + 2) * kstep;
            const char* a3 = a2 + kstep; const char* b3 = b2 + kstep;
            PG8_LDB(B0, 0, 0); PG8_SCHED; PG8_LDA(At, 0, 0); PG8_STAGE(PG8_SA(1, 1), a1 + hstep, voffA);
            PG8_WAIT_L(8); PG8_BAR; PG8_WAIT_L(0); PG8_MMA(0, 0, At, B0); PG8_BAR; PG8_SCHED;
            PG8_LDB(B1, 0, 1); PG8_STAGE(PG8_SB(0, 0), b2, voffB);
            PG8_BAR; PG8_WAIT_L(0); PG8_MMA(0, 1, At, B1); PG8_BAR;
            PG8_LDA(At, 0, 1); PG8_STAGE(PG8_SA(0, 0), a2, voffA);
            PG8_BAR; PG8_WAIT_L(0); PG8_MMA(1, 0, At, B0); PG8_BAR; PG8_SCHED;
            PG8_STAGE(PG8_SB(0, 1), b2 + hstep, voffB);
            PG8_WAIT_V(6); PG8_BAR; PG8_MMA(1, 1, At, B1); PG8_BAR;
            PG8_LDB(B0, 1, 0); PG8_SCHED; PG8_LDA(At, 1, 0); PG8_STAGE(PG8_SA(0, 1), a2 + hstep, voffA);
            PG8_WAIT_L(8); PG8_BAR; PG8_WAIT_L(0); PG8_MMA(0, 0, At, B0); PG8_BAR; PG8_SCHED;
            PG8_LDB(B1, 1, 1); PG8_STAGE(PG8_SB(1, 0), b3, voffB);
            PG8_BAR; PG8_WAIT_L(0); PG8_MMA(0, 1, At, B1); PG8_BAR;
            PG8_LDA(At, 1, 1); PG8_STAGE(PG8_SA(1, 0), a3, voffA);
            PG8_BAR; PG8_WAIT_L(0); PG8_MMA(1, 0, At, B0); PG8_BAR; PG8_SCHED;
            PG8_STAGE(PG8_SB(1, 1), b3 + hstep, voffB);
            PG8_WAIT_V(6); PG8_BAR; PG8_MMA(1, 1, At, B1); PG8_BAR;
        }
        E(acc, cur, ui, wr, wc, fr, fq);
        if (!has_next) break;
#pragma unroll
        for (int a = 0; a < 2; ++a)
#pragma unroll
            for (int b = 0; b < 2; ++b)
#pragma unroll
                for (int m = 0; m < 4; ++m)
#pragma unroll
                    for (int n = 0; n < 2; ++n) acc[a][b][m][n] = (f32x4){0.f, 0.f, 0.f, 0.f};
        cur = nxt; cA = nA; cB = nB; ++ui;
    }
    PG8_WAIT_V(0);
    if (wr == 0) PG8_BAR;
    PG8_BAR;
#undef PG8_SA
#undef PG8_SB
#undef PG8_STAGE
#undef PG8_LDA
#undef PG8_LDB
#undef PG8_MMA
#undef PG8_WAIT_V
#undef PG8_WAIT_L
#undef PG8_BAR
#undef PG8_SCHED
}
}

typedef const __attribute__((address_space(4))) Params* KParamsPtr;
DI Params kparams() {
#if defined(__HIP_DEVICE_COMPILE__)
    const __attribute__((address_space(4))) char* q = (const __attribute__((address_space(4))) char*)__builtin_amdgcn_kernarg_segment_ptr();
    asm volatile("" : "+s"(q));
    KParamsPtr kp = (KParamsPtr)q;
    Params r;
    r.xp = kp->xp; r.xs = kp->xs; r.ck = kp->ck; r.cv = kp->cv; r.sh = kp->sh; r.sc = kp->sc; r.spool = kp->spool;
    r.w_in = kp->w_in; r.sinks = kp->sinks; r.conv_w = kp->conv_w; r.conv_b = kp->conv_b; r.ga_w = kp->ga_w; r.ga_b = kp->ga_b; r.gx_w = kp->gx_w; r.gx_b = kp->gx_b; r.lam = kp->lam;
    r.pool_w = kp->pool_w; r.pool_scale = kp->pool_scale; r.w_out = kp->w_out; r.ln1_g = kp->ln1_g; r.ln1_b = kp->ln1_b; r.w_ff1 = kp->w_ff1; r.w_ff2 = kp->w_ff2; r.ln2_g = kp->ln2_g; r.ln2_b = kp->ln2_b;
    r.out = kp->out; r.ws = kp->ws;
    return r;
#else
    return Params{};
#endif
}

struct RowCtx { float mu, rstd; };
DI void row_stats(const float* part, int row, int fq, float& mu, float& rstd) {
    const f32x4* p = (const f32x4*)(part + (size_t)row * 32 + fq * 8);
    const f32x4 a = p[0], b = p[1];
    float s = (a.x + a.z) + (b.x + b.z), ss = (a.y + a.w) + (b.y + b.w);
    s += __shfl_xor(s, 16); s += __shfl_xor(s, 32); ss += __shfl_xor(ss, 16); ss += __shfl_xor(ss, 32);
    mu = s * (1.0f / 1024.0f); const float var = ss * (1.0f / 1024.0f) - mu * mu; rstd = rsqrtf(fmaxf(var, 0.f) + LN_EPS);
}

DI void row_stats_s(const float* part_s, int srow, int fq, float& mu, float& rstd) {
    const f32x4* p = (const f32x4*)(part_s + (size_t)srow * 128 + fq * 32);
    float s = 0.f, ss = 0.f;
#pragma unroll
    for (int i = 0; i < 8; ++i) { const f32x4 a = p[i]; s += a.x + a.z; ss += a.y + a.w; }
    s += __shfl_xor(s, 16); s += __shfl_xor(s, 32); ss += __shfl_xor(ss, 16); ss += __shfl_xor(ss, 32);
    mu = s * (1.0f / 1024.0f); const float var = ss * (1.0f / 1024.0f) - mu * mu; rstd = rsqrtf(fmaxf(var, 0.f) + LN_EPS);
}
DI void row_stats_any(const float* part, const float* part_s, int row, int fq, float& mu, float& rstd) {
    if (row < TP) row_stats(part, row, fq, mu, rstd); else row_stats_s(part_s, row - TP, fq, mu, rstd);
}

struct ColCtx { f32x4 a, b; };
DI void st_bf8(bf16_t* dst, f32x4 v0, f32x4 v1) { u32x4 w; w.x = pk2(v0.x, v0.y); w.y = pk2(v0.z, v0.w); w.z = pk2(v1.x, v1.y); w.w = pk2(v1.z, v1.w); *(u32x4*)dst = w; }
struct FIn {
    static constexpr bool STATS = false, PRELOAD = false, DEFERRED_PREP = true, STAGGER = false;
    const float* part; const float* part_s; const float* cs; const float* bw; int fold; int layer; bf16_t* QKV; bf16_t* U2; float* out; float* part_out; float* part_out_s;
    DI bool is_dry() const { return false; }
    DI const float* stats_src() const { return fold ? part : nullptr; }
    static DI FIn make(const Params& p, int l, int) { unsigned char* ws = p.ws;
        return FIn{(const float*)(ws + WS_ST2), (const float*)(ws + WS_STS2), (const float*)(ws + WS_CSIN) + l * 1536, (const float*)(ws + WS_BWIN) + l * 1536, l, l, (bf16_t*)(ws + WS_QKV), (bf16_t*)(ws + WS_U2), p.out, nullptr, nullptr}; }
    template <bool SMP> DI RowCtx row_begin(int row, int fq) const { RowCtx r{0.f, 1.f}; if (fold) { if (SMP) row_stats_s(part_s, row - TP, fq, r.mu, r.rstd); else row_stats(part, row, fq, r.mu, r.rstd); } return r; }
    DI ColCtx col_begin(int col) const { ColCtx c; c.a = *(const f32x4*)(cs + col); c.b = *(const f32x4*)(bw + col); return c; }
    DI f32x4 row_load8(int, int) const { return (f32x4){0.f, 0.f, 0.f, 0.f}; }
    DI f32x4 row_load4(int, int) const { return (f32x4){0.f, 0.f, 0.f, 0.f}; }
    DI f32x4 compute(int, int col, f32x4 a, const RowCtx& rc, const ColCtx& cc, float, float) const {
        f32x4 v = a;
        if (fold) v = (a - rc.mu * cc.a) * rc.rstd + cc.b;
        return v;
    }
    DI float* kv_dst(int row, int col) const {
        float* dst = nullptr; const int c7 = (col - 512) & 127; const bool isk = col < 640;
        if (row < TP) { const int t = row & 4095; if (t >= 3968) dst = out + (isk ? O_PK : O_PV) + ((size_t)((layer * 4 + (row >> 12)) * 128 + (t - 3968))) * 128 + c7; }
        else { dst = out + (isk ? O_SK : O_SV) + ((size_t)((layer * 128 + (row - TP)) * 128 + 127)) * 128 + c7; }
        return dst;
    }
    DI void store8(int row, int col, f32x4 v0, f32x4 v1) const {
        if (col < 512) st_bf8(QKV + (size_t)row * 768 + col, v0 * QSCALE, v1 * QSCALE);
        else if (col < 768) { st_bf8(QKV + (size_t)row * 768 + col, v0, v1); float* dst = kv_dst(row, col); if (dst) { *(f32x4*)dst = v0; *(f32x4*)(dst + 4) = v1; } }
        else st_bf8(U2 + (size_t)row * 768 + (col - 768), v0, v1);
    }
    DI void store4(int row, int col, f32x4 v) const {
        if (col < 512) st_bf4(QKV + (size_t)row * 768 + col, v * QSCALE);
        else if (col < 768) { st_bf4(QKV + (size_t)row * 768 + col, v); float* dst = kv_dst(row, col); if (dst) *(f32x4*)dst = v; }
        else st_bf4(U2 + (size_t)row * 768 + (col - 768), v);
    }
};
struct FFF1 {
    static constexpr bool STATS = false, PRELOAD = false, DEFERRED_PREP = false, STAGGER = true;
    const float* part; const float* part_s; const float* cs; const float* bw; bf16_t* HID; float* part_out; float* part_out_s;
    DI bool is_dry() const { return false; }
    DI const float* stats_src() const { return part; }
    static DI FFF1 make(const Params& p, int l, int) { unsigned char* ws = p.ws;
        return FFF1{(const float*)(ws + WS_ST1), (const float*)(ws + WS_STS1), (const float*)(ws + WS_CS1) + l * 4096, (const float*)(ws + WS_BW1) + l * 4096, (bf16_t*)(ws + WS_HID), nullptr, nullptr}; }
    template <bool SMP> DI RowCtx row_begin(int row, int fq) const { RowCtx r; if (SMP) row_stats_s(part_s, row - TP, fq, r.mu, r.rstd); else row_stats(part, row, fq, r.mu, r.rstd); return r; }
    DI ColCtx col_begin(int col) const { ColCtx c; c.a = *(const f32x4*)(cs + col); c.b = *(const f32x4*)(bw + col); return c; }
    DI f32x4 row_load8(int, int) const { return (f32x4){0.f, 0.f, 0.f, 0.f}; }
    DI f32x4 row_load4(int, int) const { return (f32x4){0.f, 0.f, 0.f, 0.f}; }
    DI f32x4 compute(int, int, f32x4 a, const RowCtx& rc, const ColCtx& cc, float, float) const {
        f32x4 v = (a - rc.mu * cc.a) * rc.rstd + cc.b;
        v.x = fmaxf(v.x, 0.f); v.y = fmaxf(v.y, 0.f); v.z = fmaxf(v.z, 0.f); v.w = fmaxf(v.w, 0.f); return v * v;
    }
    DI void store8(int row, int col, f32x4 v0, f32x4 v1) const { st_bf8(HID + (size_t)row * 4096 + col, v0, v1); }
    DI void store4(int row, int col, f32x4 v) const { st_bf4(HID + (size_t)row * 4096 + col, v); }
};
template <bool DRY> struct FResT {
    static constexpr bool STATS = true, PRELOAD = true, DEFERRED_PREP = false, STAGGER = false;
    int raw; const float* part; const float* part_s; const float* g; const float* b; float* Y; bf16_t* YB; float* part_out; float* part_out_s;
    static DI FResT make(const Params& p, int l, int which) { unsigned char* ws = p.ws;
        if (which == 0) return FResT{l == 0 ? 1 : 0, (const float*)(ws + WS_ST2), (const float*)(ws + WS_STS2), p.ln2_g, p.ln2_b, nullptr, (bf16_t*)(ws + WS_YB), (float*)(ws + WS_ST1), (float*)(ws + WS_STS1)};
        return FResT{0, (const float*)(ws + WS_ST1), (const float*)(ws + WS_STS1), p.ln1_g + l * 1024, p.ln1_b + l * 1024, nullptr, (bf16_t*)(ws + WS_YB), (float*)(ws + WS_ST2), (float*)(ws + WS_STS2)}; }
    DI bool is_dry() const { return DRY; }
    DI const float* stats_src() const { return raw ? nullptr : part; }
    template <bool SMP> DI RowCtx row_begin(int row, int fq) const { RowCtx r{0.f, 1.f}; if (!raw) { if (SMP) row_stats_s(part_s, row - TP, fq, r.mu, r.rstd); else row_stats(part, row, fq, r.mu, r.rstd); } return r; }
    DI ColCtx col_begin(int col) const { ColCtx c; c.a = *(const f32x4*)(g + col); c.b = *(const f32x4*)(b + col); return c; }
    DI f32x4 row_load8(int row, int col) const { const u32x4 w = *(const u32x4*)(YB + (size_t)row * 1024 + col); return __builtin_bit_cast(f32x4, w); }
    DI f32x4 row_load4(int row, int col) const { const u32x2 w = *(const u32x2*)(YB + (size_t)row * 1024 + col); return (f32x4){__uint_as_float(w.x), __uint_as_float(w.y), 0.f, 0.f}; }
    DI f32x4 compute(int, int, f32x4 a, const RowCtx& rc, const ColCtx& cc, float p0, float p1) const {
        const unsigned w0 = __float_as_uint(p0), w1 = __float_as_uint(p1);
        const f32x4 x = (f32x4){__uint_as_float(w0 << 16), __uint_as_float(w0 & 0xffff0000u), __uint_as_float(w1 << 16), __uint_as_float(w1 & 0xffff0000u)};
        const f32x4 r = raw ? x : ((x - rc.mu) * rc.rstd * cc.a + cc.b);
        return ALPHA * r + a;
    }
    DI void store8(int row, int col, f32x4 v0, f32x4 v1) const {
        if (!DRY) { st_bf8(YB + (size_t)row * 1024 + col, v0, v1); if (Y) { float* d = Y + (size_t)row * 1024 + col; *(f32x4*)d = v0; *(f32x4*)(d + 4) = v1; } }
    }
    DI void store4(int row, int col, f32x4 v) const {
        if (!DRY) { st_bf4(YB + (size_t)row * 1024 + col, v); if (Y) *(f32x4*)(Y + (size_t)row * 1024 + col) = v; }
    }
};
typedef FResT<false> FRes;

constexpr int STAT_TAB_OFF = 131072;
template <class F> struct EpiWrap {
    int l, which; LAS unsigned char* lds;
    DI void operator()(const f32x4 (&acc)[2][2][4][2], const pg8::Unit& u, int ui, int wr, int wc, int fr, int fq) const {
        const Params p = kparams();
        const F f = F::make(p, launder_i(l), which);
        const bool has_stats = f.stats_src() != nullptr;
        const LAS f32x2* tab = (const LAS f32x2*)(lds + STAT_TAB_OFF) + ui * 256 + wr * 64 + fr;
        const int rbase = u.pm * 256 + wr * 64 + fr, cbase = u.pn * 256 + wc * 32 + 8 * fq;
        ColCtx cc[2][2];
#pragma unroll
        for (int bj = 0; bj < 2; ++bj)
#pragma unroll
            for (int n = 0; n < 2; ++n) cc[bj][n] = f.col_begin(cbase + bj * 128 + 4 * n);
#pragma unroll
        for (int ai = 0; ai < 2; ++ai) {
            RowCtx rc[4]; float s[4], ss[4];
#pragma unroll
            for (int m = 0; m < 4; ++m) { const f32x2 t = has_stats ? tab[ai * 128 + m * 16] : (f32x2){0.f, 1.f}; rc[m].mu = t.x; rc[m].rstd = t.y; s[m] = 0.f; ss[m] = 0.f; }
#pragma unroll
            for (int bj = 0; bj < 2; ++bj) {
                const int col8 = cbase + bj * 128;
                f32x4 pre, nxt = f.row_load8(rbase + ai * 128, col8);
#pragma unroll
                for (int m = 0; m < 4; ++m) {
                    const int row = rbase + ai * 128 + m * 16;
                    pre = nxt;
                    if (F::PRELOAD && m < 3) nxt = f.row_load8(row + 16, col8);
                    const f32x4 y0 = f.compute(row, col8, acc[ai][bj][m][0], rc[m], cc[bj][0], pre.x, pre.y);
                    const f32x4 y1 = f.compute(row, col8 + 4, acc[ai][bj][m][1], rc[m], cc[bj][1], pre.z, pre.w);
                    if (F::STATS) { s[m] += ((y0.x + y0.y) + (y0.z + y0.w)) + ((y1.x + y1.y) + (y1.z + y1.w));
                        ss[m] += ((y0.x * y0.x + y0.y * y0.y) + (y0.z * y0.z + y0.w * y0.w)) + ((y1.x * y1.x + y1.y * y1.y) + (y1.z * y1.z + y1.w * y1.w)); }
                    f.store8(row, col8, y0, y1);
                }
            }
            if (F::STATS) {
#pragma unroll
                for (int m = 0; m < 4; ++m) {
                    float a = s[m], b = ss[m];
                    a += __shfl_xor(a, 16); a += __shfl_xor(a, 32); b += __shfl_xor(b, 16); b += __shfl_xor(b, 32);
                    if (fq == 0 && !f.is_dry()) *(f32x2*)(f.part_out + (size_t)(rbase + ai * 128 + m * 16) * 32 + (u.pn * 4 + wc) * 2) = (f32x2){a, b};
                }
            }
        }
    }
};

template <class F>
DI void sgemm_unit(LAS unsigned char* lds, const bf16_t* A, const bf16_t* Wt, int K, int col0, const F& f, int wid, int lane) {
    const int fr = lane & 15, fq = lane >> 4;
    const int kw = K >> 3;
    const bf16_t* ap = A + (size_t)fr * K + wid * kw + 8 * fq;
    const bf16_t* wp = Wt + (size_t)(col0 + fr) * K + wid * kw + 8 * fq;
    const int row = TP + wid * 16 + fr;
    const RowCtx rc = f.template row_begin<true>(row, fq);
    const ColCtx cc = f.col_begin(col0 + 4 * fq);
    const f32x4 pre = f.row_load4(row, col0 + 4 * fq);
    f32x4 acc[8];
#pragma unroll
    for (int i = 0; i < 8; ++i) acc[i] = (f32x4){0.f, 0.f, 0.f, 0.f};
#pragma unroll 2
    for (int k = 0; k < kw; k += 32) {
        const bf16x8 w = *(const bf16x8*)(wp + k);
#pragma unroll
        for (int mt = 0; mt < 8; ++mt) { const bf16x8 a = *(const bf16x8*)(ap + (size_t)mt * 16 * K + k); acc[mt] = mfma16(w, a, acc[mt]); }
    }
    LAS f32x4* red = (LAS f32x4*)lds;
#pragma unroll
    for (int mt = 0; mt < 8; ++mt) red[(wid * 8 + mt) * 64 + lane] = acc[mt];
    __syncthreads();
    f32x4 tot = (f32x4){0.f, 0.f, 0.f, 0.f};
#pragma unroll
    for (int s = 0; s < 8; ++s) tot += red[(s * 8 + wid) * 64 + lane];
    const f32x4 y = f.compute(row, col0 + 4 * fq, tot, rc, cc, pre.x, pre.y);
    f.store4(row, col0 + 4 * fq, y);
    if (F::STATS) {
        float s = (y.x + y.y) + (y.z + y.w), ss = (y.x * y.x + y.y * y.y) + (y.z * y.z + y.w * y.w);
        s += __shfl_xor(s, 16); s += __shfl_xor(s, 32); ss += __shfl_xor(ss, 16); ss += __shfl_xor(ss, 32);
        if (fq == 0 && !f.is_dry()) *(f32x2*)(f.part_out_s + (size_t)(row - TP) * 128 + (col0 >> 4) * 2) = (f32x2){s, ss};
    }
    __syncthreads();
}

DI void prep_deferred(const Params& p, int slot, LAS unsigned char* lds, int tid, int widx, int NW);
template <class F>
DI void gemm_all(LAS unsigned char* lds, const bf16_t* A, const bf16_t* Wt, int N, int K, int l, int which, int vb, int G, int tid) {
    int wid, lane; RELAUNDER();
    pg8::Gemm g{A, Wt, TP, N, K}; pg8::StaticOrder S; S.init(TP, N, G, vb);
    {
        const Params p = kparams();
        const F f = F::make(p, launder_i(l), which);
        const float* part = f.stats_src();
        if (part) {
            LAS f32x2* tab = (LAS f32x2*)(lds + STAT_TAB_OFF);
            const int r = tid >> 1, hlf = tid & 1;
            f32x4 v[4][4]; bool ok[4];
#pragma unroll
            for (int i = 0; i < 4; ++i) { pg8::Unit u; ok[i] = S.next(i, u); const int row = (ok[i] ? u.pm : 0) * 256 + r;
                const f32x4* pp = (const f32x4*)(part + (size_t)row * 32 + hlf * 16);
#pragma unroll
                for (int j = 0; j < 4; ++j) v[i][j] = pp[j]; }
#pragma unroll
            for (int i = 0; i < 4; ++i) {
                float s = 0.f, ss = 0.f;
#pragma unroll
                for (int j = 0; j < 4; ++j) { s += v[i][j].x + v[i][j].z; ss += v[i][j].y + v[i][j].w; }
                s += __shfl_xor(s, 1); ss += __shfl_xor(ss, 1);
                const float mu = s * (1.0f / 1024.0f), var = ss * (1.0f / 1024.0f) - mu * mu, rstd = rsqrtf(fmaxf(var, 0.f) + LN_EPS);
                if (hlf == 0) tab[i * 256 + r] = (f32x2){mu, rstd};
            }
        }
        __syncthreads();
    }
    const int nsu_ = N / 16;
    const bool s_first = false;
    if (F::STAGGER && (((vb >> 3) & 1) != 0) && (G & 15) == 0) {
        const Params p = kparams();
        prep_deferred(p, launder_i(l) + 1, lds, tid, ((vb >> 4) << 3) | (vb & 7), G >> 1);
        __syncthreads();
    }
    EpiWrap<F> E{l, which, lds};
    pg8::gemm_phase<EpiWrap<F>>(lds, g, S, E, tid);
    if (F::DEFERRED_PREP) {
        const int nwg = (TP / 256) * (N / 256), first = (nwg > G && nwg < 2 * G) ? (nwg - G) : 0;
        if (vb >= first) { const Params p = kparams(); prep_deferred(p, launder_i(l) + 3, lds, tid, vb - first, G - first); __syncthreads(); }
    }
    const int nsu = N / 16;
    const int su0 = G - 1 - vb;
    if (su0 < nsu && !s_first) {
        const Params p = kparams();
        const F f = F::make(p, launder_i(l), which);
        for (int su = su0; su < nsu; su += G) sgemm_unit<F>(lds, A + (size_t)TP * K, Wt, K, su * 16, f, wid, lane);
    }
}

DI void transpose_tile_load(const float* W, const float* gain, int N, int k0, int n0, int tid, f32x4 (&v)[8]) {
#pragma unroll
    for (int i = 0; i < 8; ++i) { const int e = tid + 512 * i, row = e >> 5, c4 = e & 31;
        f32x4 x = __builtin_nontemporal_load((const f32x4*)(W + (size_t)(k0 + row) * N + n0 + 4 * c4));
        if (gain) x = x * gain[k0 + row];
        v[i] = x; }
}
DI void transpose_tile_store(LAS float* T, bf16_t* WT, int K, int k0, int n0, int tid, const f32x4 (&v)[8]) {
#pragma unroll
    for (int i = 0; i < 8; ++i) { const int e = tid + 512 * i, row = e >> 5, c4 = e & 31; LAS float* d = T + row * 129 + 4 * c4; d[0] = v[i].x; d[1] = v[i].y; d[2] = v[i].z; d[3] = v[i].w; }
    __syncthreads();
#pragma unroll
    for (int i = 0; i < 4; ++i) { const int e = tid + 512 * i, n = e >> 4, c8 = e & 15; const LAS float* s = T + (8 * c8) * 129 + n;
        u32x4 o; o.x = pk2(s[0], s[129]); o.y = pk2(s[2 * 129], s[3 * 129]); o.z = pk2(s[4 * 129], s[5 * 129]); o.w = pk2(s[6 * 129], s[7 * 129]);
        *(u32x4*)(WT + (size_t)(n0 + n) * K + k0 + 8 * c8) = o; }
    __syncthreads();
}
struct TrJob { const float* W; const float* gain; bf16_t* WT; int K, N, k0, n0; };
DI TrJob tr_job(const Params& p, int which, int l, int item) {
    unsigned char* ws = p.ws; TrJob j;
    if (which == 0) { j.W = p.w_in + (size_t)l * 1024 * 1536; j.gain = l ? p.ln2_g : nullptr; j.WT = (bf16_t*)(ws + WS_WIN) + (size_t)l * 1536 * 1024; j.K = 1024; j.N = 1536; }
    else if (which == 1) { j.W = p.w_out + (size_t)l * 1024 * 1024; j.gain = nullptr; j.WT = (bf16_t*)(ws + WS_WOUT) + (size_t)l * 1024 * 1024; j.K = 1024; j.N = 1024; }
    else if (which == 2) { j.W = p.w_ff1 + (size_t)l * 1024 * 4096; j.gain = p.ln1_g + l * 1024; j.WT = (bf16_t*)(ws + WS_W1) + (size_t)l * 4096 * 1024; j.K = 1024; j.N = 4096; }
    else { j.W = p.w_ff2 + (size_t)l * 4096 * 1024; j.gain = nullptr; j.WT = (bf16_t*)(ws + WS_W2) + (size_t)l * 1024 * 4096; j.K = 4096; j.N = 1024; }
    const int nb = j.N / 128; j.k0 = (item / nb) * 128; j.n0 = (item % nb) * 128; return j;
}
DI TrJob tr_slot_job(const Params& p, int slot, int it) {
    if (slot == 0) { if (it < 96) return tr_job(p, 0, 0, it); return tr_job(p, 0, 1, it - 96); }
    if (slot <= 2) return tr_job(p, 3, slot - 1, it);
    if (it < 64) return tr_job(p, 1, slot - 3, it);
    return tr_job(p, 2, slot - 3, it - 64);
}
DI void transpose_slot(const Params& p, int slot, LAS unsigned char* lds, int tid, int widx, int NW) {
    const int nit = slot == 0 ? 192 : (slot <= 2 ? 256 : 320);
    LAS float* T = (LAS float*)lds;
    f32x4 v[8];
    int it = widx;
    if (it < nit) { const TrJob j = tr_slot_job(p, slot, it); transpose_tile_load(j.W, j.gain, j.N, j.k0, j.n0, tid, v); }
    for (; it < nit; it += NW) {
        const TrJob j = tr_slot_job(p, slot, it);
#pragma unroll
        for (int i = 0; i < 8; ++i) { const int e = tid + 512 * i, row = e >> 5, c4 = e & 31; LAS float* d = T + row * 129 + 4 * c4; d[0] = v[i].x; d[1] = v[i].y; d[2] = v[i].z; d[3] = v[i].w; }
        __syncthreads();
        if (it + NW < nit) { const TrJob jn = tr_slot_job(p, slot, it + NW); transpose_tile_load(jn.W, jn.gain, jn.N, jn.k0, jn.n0, tid, v); }
#pragma unroll
        for (int i = 0; i < 4; ++i) { const int e = tid + 512 * i, n = e >> 4, c8 = e & 15; const LAS float* s = T + (8 * c8) * 129 + n;
            u32x4 o; o.x = pk2(s[0], s[129]); o.y = pk2(s[2 * 129], s[3 * 129]); o.z = pk2(s[4 * 129], s[5 * 129]); o.w = pk2(s[6 * 129], s[7 * 129]);
            *(u32x4*)(j.WT + (size_t)(j.n0 + n) * j.K + j.k0 + 8 * c8) = o; }
        __syncthreads();
    }
}
DI void colsum_item(const float* W, const float* gain, const float* bias, int N, int c0, float* cs, float* bw, LAS float* red, int wid, int lane) {
    float s1 = 0.f, s2 = 0.f;
    const float* wp = W + (size_t)(wid * 128) * N + c0 + lane;
#pragma unroll 32
    for (int k = 0; k < 128; ++k) { const float w = wp[(size_t)k * N]; const int kk = wid * 128 + k; s1 += bfround(gain[kk] * w); s2 += bias[kk] * w; }
    red[wid * 128 + lane] = s1; red[wid * 128 + 64 + lane] = s2;
    __syncthreads();
    if (wid == 0) { float a = 0.f, b = 0.f;
#pragma unroll
        for (int w = 0; w < 8; ++w) { a += red[w * 128 + lane]; b += red[w * 128 + 64 + lane]; }
        cs[c0 + lane] = a; bw[c0 + lane] = b; }
    __syncthreads();
}
DI void prep_deferred(const Params& p, int slot, LAS unsigned char* lds, int tid, int widx, int NW) {
    tid = launder_v(tid);
    transpose_slot(p, slot, lds, tid, widx, NW);
}
DI void phase_prep(const Params& p, LAS unsigned char* lds, int tid, int wid, int lane, int vb, int G) {
    RELAUNDER();
    unsigned char* ws = p.ws;
    const int gw = vb * 8 + wid, NGW = G * 8;
    transpose_slot(p, 0, lds, tid, vb, G);
    bf16_t* YB = (bf16_t*)(ws + WS_YB);
    for (int m0 = gw; m0 < MT; m0 += 4 * NGW) {
        f32x4 v[4][4];
#pragma unroll
        for (int r = 0; r < 4; ++r) { const int m = m0 + r * NGW; const int mm = m < MT ? m : m0;
            const f32x4* src = (const f32x4*)(mm < TP ? p.xp + (size_t)mm * 1024 : p.xs + (size_t)(mm - TP) * 1024);
#pragma unroll
            for (int j = 0; j < 4; ++j) v[r][j] = __builtin_nontemporal_load(src + lane + 64 * j); }
#pragma unroll
        for (int r = 0; r < 4; ++r) { const int m = m0 + r * NGW;
            if (m < MT) {
#pragma unroll
                for (int j = 0; j < 4; ++j) st_bf4(YB + (size_t)m * 1024 + 4 * (lane + 64 * j), v[r][j]); } }
    }
#pragma unroll
    for (int which = 0; which < 3; ++which) {
        const float* src = which == 0 ? p.ga_w : (which == 1 ? p.gx_w : p.pool_w);
        bf16_t* dst = (bf16_t*)(ws + (which == 0 ? WS_GAT : (which == 1 ? WS_GXT : WS_PWT)));
        for (int r = vb * NTHR + tid; r < 32768; r += G * NTHR) {
            const int ln = r >> 12, d = (r >> 6) & 63, c = r & 63;
            dst[r] = (bf16_t)(pk2(src[(ln << 12) + c * 64 + d], 0.f) & 0xffffu);
        }
    }
    __syncthreads();
}

DI void attn_item(const Params& p, int layer, int item, LAS unsigned char* lds, int tid, int wid, int lane) {
    RELAUNDER();
    const int kvh = item & 1, qb = (item >> 1) & 31, b = item >> 6;
    const bf16_t* QKV = (const bf16_t*)(p.ws + WS_QKV); bf16_t* MIX = (bf16_t*)(p.ws + WS_MIX);
    LAS bf16_t* Ks = (LAS bf16_t*)lds;
    LAS bf16_t* Vt = (LAS bf16_t*)(lds + 36864);
    {
        const int key = tid >> 1, half = tid & 1; const int tok = qb * 128 - 128 + key;
        u32x4 kv[4], vv[4];
        if (tok >= 0) { const bf16_t* src = QKV + ((size_t)b * 4096 + tok) * 768 + 512 + kvh * 64 + half * 32;
#pragma unroll
            for (int i = 0; i < 4; ++i) { kv[i] = ((const u32x4*)src)[i]; vv[i] = ((const u32x4*)(src + 128))[i]; } }
        else {
#pragma unroll
            for (int i = 0; i < 4; ++i) { kv[i] = (u32x4){0u, 0u, 0u, 0u}; vv[i] = (u32x4){0u, 0u, 0u, 0u}; } }
#pragma unroll
        for (int i = 0; i < 4; ++i) *(LAS u32x4*)(Ks + key * 72 + half * 32 + 8 * i) = kv[i];
#pragma unroll
        for (int i = 0; i < 4; ++i)
#pragma unroll
            for (int e = 0; e < 8; ++e) { const int d = half * 32 + 8 * i + e; Vt[d * 264 + key] = (bf16_t)((vv[i][e >> 1] >> (16 * (e & 1))) & 0xffffu); }
    }
    __syncthreads();
    const int g = wid >> 1, qh = wid & 1, h = kvh * 4 + g, fr = lane & 15, fq = lane >> 4;
    const float slope2 = exp2f(-(float)(h + 1)) * LOG2E, sink2 = p.sinks[layer * 8 + h] * LOG2E;
    const size_t rowbase = (size_t)b * 4096 + qb * 128;
    bf16x8 qall[4][2];
#pragma unroll
    for (int qt = 0; qt < 4; ++qt) { const bf16_t* qp = QKV + (rowbase + qh * 64 + qt * 16 + fr) * 768 + h * 64 + 8 * fq; qall[qt][0] = *(const bf16x8*)qp; qall[qt][1] = *(const bf16x8*)(qp + 32); }
#pragma unroll
    for (int qt = 0; qt < 4; ++qt) {
        const int i0 = qh * 64 + qt * 16, jb = 32 * ((qh * 4 + qt) >> 1), iq = i0 + fr;
        const bf16x8 q0 = qall[qt][0], q1 = qall[qt][1];
        f32x4 s[10];
        float mx = sink2;
        const bool odd = (qt & 1) != 0;
        if (qb > 0) {
            const float t0 = -slope2 * (float)(iq + 128 - jb - 4 * fq);
            const float tb0 = t0, tb1 = t0 + slope2, tb2 = t0 + 2.0f * slope2, tb3 = t0 + 3.0f * slope2;
#pragma unroll
            for (int kt = 0; kt < 10; ++kt) {
                const bool dead = odd ? (kt == 0) : (kt == 9);
                if (dead) { s[kt] = (f32x4){0.f, 0.f, 0.f, 0.f}; continue; }
                const float c = slope2 * (float)(16 * kt);
                const LAS bf16_t* kp = Ks + (jb + 16 * kt + fr) * 72 + 8 * fq;
                const bf16x8 k0 = *(const LAS bf16x8*)kp, k1 = *(const LAS bf16x8*)(kp + 32);
                s[kt] = mfma16(k0, q0, (f32x4){tb0 + c, tb1 + c, tb2 + c, tb3 + c}); s[kt] = mfma16(k1, q1, s[kt]);
                const bool lo = odd ? (kt == 1) : (kt == 0), hi = odd ? (kt == 9) : (kt == 8);
#pragma unroll
                for (int i = 0; i < 4; ++i) {
                    if (lo) s[kt][i] = (4 * fq + i >= fr) ? s[kt][i] : -1e30f;
                    if (hi) s[kt][i] = (4 * fq + i <= fr) ? s[kt][i] : -1e30f;
                    mx = fmaxf(mx, s[kt][i]); }
            }
        } else {
#pragma unroll
            for (int kt = 0; kt < 10; ++kt) { const LAS bf16_t* kp = Ks + (jb + 16 * kt + fr) * 72 + 8 * fq;
                const bf16x8 k0 = *(const LAS bf16x8*)kp, k1 = *(const LAS bf16x8*)(kp + 32);
                s[kt] = mfma16(k0, q0, (f32x4){0.f, 0.f, 0.f, 0.f}); s[kt] = mfma16(k1, q1, s[kt]); }
#pragma unroll
            for (int kt = 0; kt < 10; ++kt)
#pragma unroll
                for (int i = 0; i < 4; ++i) { const int j = jb + 16 * kt + 4 * fq + i, delta = iq + 128 - j;
                    const bool valid = (delta >= 0) && (delta <= 128) && (j >= 128);
                    const float v = s[kt][i] - slope2 * (float)delta;
                    s[kt][i] = valid ? v : -1e30f; mx = fmaxf(mx, s[kt][i]); }
        }
        mx = fmaxf(mx, __shfl_xor(mx, 16)); mx = fmaxf(mx, __shfl_xor(mx, 32));
        float sum = 0.f;
#pragma unroll
        for (int kt = 0; kt < 10; ++kt) {
            if (qb > 0 && (odd ? (kt == 0) : (kt == 9))) continue;
#pragma unroll
            for (int i = 0; i < 4; ++i) { const float pv = __builtin_amdgcn_exp2f(s[kt][i] - mx); s[kt][i] = pv; sum += pv; }
        }
        sum += __shfl_xor(sum, 16); sum += __shfl_xor(sum, 32);
        const float inv = 1.0f / (sum + __builtin_amdgcn_exp2f(sink2 - mx));
        bf16x8 pf[5];
#pragma unroll
        for (int G = 0; G < 5; ++G) pf[G] = pack8(s[2 * G], s[2 * G + 1]);
#pragma unroll
        for (int dt = 0; dt < 4; ++dt) {
            f32x4 o = (f32x4){0.f, 0.f, 0.f, 0.f};
#pragma unroll
            for (int G = 0; G < 5; ++G) { const LAS bf16_t* vp = Vt + (16 * dt + fr) * 264 + jb + 32 * G + 4 * fq;
                const u32x2 lo = *(const LAS u32x2*)vp, hi = *(const LAS u32x2*)(vp + 16);
                const u32x4 w = (u32x4){lo.x, lo.y, hi.x, hi.y};
                o = mfma16(__builtin_bit_cast(bf16x8, w), pf[G], o); }
            st_bf4(MIX + (rowbase + iq) * 1024 + h * 64 + 16 * dt + 4 * fq, o * inv);
        }
    }
    __syncthreads();
}

DI void sattn_item(const Params& p, int layer, int j, LAS unsigned char* lds, int tid, int wid, int lane) {
    RELAUNDER();
    LAS float* Kc = (LAS float*)lds;
    LAS float* Vc = Kc + 129 * 132;
    LAS float* Ps = Vc + 129 * 132;
    LAS float* Qs = Ps + 8 * 132;
    const size_t cbase = ((size_t)(layer * 128 + j)) * 128 * 128;
    const f32x4* ck = (const f32x4*)(p.ck + cbase); const f32x4* cv = (const f32x4*)(p.cv + cbase);
    f32x4* sk = (f32x4*)(p.out + O_SK + cbase); f32x4* sv = (f32x4*)(p.out + O_SV + cbase);
#pragma unroll
    for (int i = 0; i < 8; ++i) { const int idx = tid + 512 * i, s = idx >> 5, c4 = idx & 31;
        const f32x4 kv = __builtin_nontemporal_load(ck + idx), vv = __builtin_nontemporal_load(cv + idx);
        *(LAS f32x4*)(Kc + s * 132 + 4 * c4) = kv; *(LAS f32x4*)(Vc + s * 132 + 4 * c4) = vv;
        if (s >= 1) { __builtin_nontemporal_store(kv, sk + (idx - 32)); __builtin_nontemporal_store(vv, sv + (idx - 32)); } }
    if (tid < 32) *(LAS f32x4*)(Kc + 128 * 132 + 4 * tid) = sk[127 * 32 + tid];
    else if (tid < 64) *(LAS f32x4*)(Vc + 128 * 132 + 4 * (tid - 32)) = sv[127 * 32 + (tid - 32)];
    const bf16_t* QKV = (const bf16_t*)(p.ws + WS_QKV);
    Qs[tid] = bf2f(QKV[(size_t)(TP + j) * 768 + tid]);
    __syncthreads();
    const int h = wid, kvh = h >> 2;
    const float slope = exp2f(-(float)(h + 1)), sink2 = p.sinks[layer * 8 + h] * LOG2E;
    float sc[3];
#pragma unroll
    for (int r = 0; r < 3; ++r) {
        const int s = (r < 2) ? lane + 64 * r : 128;
        const LAS f32x4* kp = (const LAS f32x4*)(Kc + s * 132 + kvh * 64); const LAS f32x4* qp = (const LAS f32x4*)(Qs + h * 64);
        float d = 0.f;
#pragma unroll
        for (int i = 0; i < 16; ++i) { const f32x4 a = kp[i], q = qp[i]; d += (a.x * q.x + a.y * q.y) + (a.z * q.z + a.w * q.w); }
        const float delta = (float)(128 - s);
        sc[r] = d - slope * LOG2E * delta;
        if (r == 2 && lane != 0) sc[r] = -1e30f;
    }
    float mx = fmaxf(fmaxf(sc[0], sc[1]), fmaxf(sc[2], sink2));
#pragma unroll
    for (int o = 1; o < 64; o <<= 1) mx = fmaxf(mx, __shfl_xor(mx, o));
    float sum = 0.f;
#pragma unroll
    for (int r = 0; r < 3; ++r) { sc[r] = __builtin_amdgcn_exp2f(sc[r] - mx); sum += sc[r]; }
#pragma unroll
    for (int o = 1; o < 64; o <<= 1) sum += __shfl_xor(sum, o);
    const float inv = 1.0f / (sum + __builtin_amdgcn_exp2f(sink2 - mx));
    Ps[h * 132 + lane] = sc[0]; Ps[h * 132 + 64 + lane] = sc[1]; if (lane == 0) Ps[h * 132 + 128] = sc[2];
    lds_wait();
    float o = 0.f;
#pragma unroll 8
    for (int s = 0; s < 129; ++s) o += Ps[h * 132 + s] * Vc[s * 132 + kvh * 64 + lane];
    bf16_t* MIX = (bf16_t*)(p.ws + WS_MIX);
    MIX[(size_t)(TP + j) * 1024 + h * 64 + lane] = (bf16_t)(pk2(o * inv, 0.f) & 0xffffu);
    __syncthreads();
}

DI float fsigmoid(float x) { return __builtin_amdgcn_rcpf(1.0f + __builtin_amdgcn_exp2f(-LOG2E * x)); }
DI void rglru_item(const Params& p, int layer, int item, LAS unsigned char* lds, int tid, int wid, int lane) {
    RELAUNDER();
    LAS float* XC = (LAS float*)lds;
    const bf16_t* U2 = (const bf16_t*)(p.ws + WS_U2);
    const int ti = item >> 1, chalf = item & 1;
    const bool smp = (ti == 128);
    const int b = ti >> 5, ch = ti & 31;
    {
        const int cq = tid & 31, tg = tid >> 5, cqg = chalf * 32 + cq;
        const f32x4 cb = ((const f32x4*)(p.conv_b + layer * 256))[cqg];
        f32x4 cw[4];
#pragma unroll
        for (int t = 0; t < 4; ++t) cw[t] = ((const f32x4*)(p.conv_w + (layer * 4 + t) * 256))[cqg];
        if (!smp) {
            f32x4 x[11];
#pragma unroll
            for (int k = 0; k < 11; ++k) { const int t = ch * 128 + 8 * tg - 3 + k;
                x[k] = (t >= 0) ? ld_bf4(U2 + ((size_t)b * 4096 + t) * 768 + 4 * cqg) : (f32x4){0.f, 0.f, 0.f, 0.f}; }
#pragma unroll
            for (int k = 0; k < 8; ++k) { const f32x4 xc = cb + cw[0] * x[k] + cw[1] * x[k + 1] + cw[2] * x[k + 2] + cw[3] * x[k + 3];
                *(LAS f32x4*)(XC + (8 * tg + k) * 132 + 4 * cq) = xc; }
            if (ch == 31 && tg == 15) { f32x4* pc = (f32x4*)(p.out + O_PC + (size_t)(layer * 4 + b) * 3 * 256);
                pc[0 * 64 + cqg] = x[8]; pc[1 * 64 + cqg] = x[9]; pc[2 * 64 + cqg] = x[10]; }
        } else {
#pragma unroll 4
            for (int k = 0; k < 8; ++k) { const int j = 8 * tg + k;
                const f32x4* scp = (const f32x4*)(p.sc + (size_t)(layer * 128 + j) * 3 * 256);
                const f32x4 s0 = scp[cqg], s1 = scp[64 + cqg], s2 = scp[128 + cqg], xr = ld_bf4(U2 + (size_t)(TP + j) * 768 + 4 * cqg);
                const f32x4 xc = cb + cw[0] * s0 + cw[1] * s1 + cw[2] * s2 + cw[3] * xr;
                *(LAS f32x4*)(XC + j * 132 + 4 * cq) = xc;
                f32x4* oc = (f32x4*)(p.out + O_SC + (size_t)(layer * 128 + j) * 3 * 256);
                oc[cqg] = s1; oc[64 + cqg] = s2; oc[128 + cqg] = xr; }
        }
    }
    __syncthreads();
    const int nl = wid >> 2, n = 2 * chalf + nl, fr = lane & 15, fq = lane >> 4;
    const int d = 16 * (wid & 3) + fr, cl = 64 * nl + d, c = 128 * chalf + cl;
    const bf16_t* GaT = (const bf16_t*)(p.ws + WS_GAT); const bf16_t* GxT = (const bf16_t*)(p.ws + WS_GXT);
    bf16x8 wa[2], wx[2];
#pragma unroll
    for (int ks = 0; ks < 2; ++ks) { const size_t o = ((size_t)((layer * 4 + n) * 64 + d)) * 64 + 32 * ks + 8 * fq; wa[ks] = *(const bf16x8*)(GaT + o); wx[ks] = *(const bf16x8*)(GxT + o); }
    const float ba = p.ga_b[layer * 256 + c], bx = p.gx_b[layer * 256 + c];
    const float spv = -8.0f * LOG2E * log1pf(__expf(-p.lam[layer * 256 + c]));
    float Ac = 1.f, Bc = 0.f;
    unsigned* HC = (unsigned*)(p.ws + WS_HL);
    bf16_t* MIX = (bf16_t*)(p.ws + WS_MIX);
    float h0n[4] = {0.f, 0.f, 0.f, 0.f}, grn[4] = {0.f, 0.f, 0.f, 0.f};
    if (smp) {
#pragma unroll
        for (int i = 0; i < 4; ++i) { const int j = 4 * fq + i; h0n[i] = p.sh[(size_t)(layer * 128 + j) * 256 + c]; grn[i] = bf2f(U2[(size_t)(TP + j) * 768 + 256 + c]); }
    }
    for (int tt = 0; tt < 8; ++tt) {
        float h0c[4], grc[4];
#pragma unroll
        for (int i = 0; i < 4; ++i) { h0c[i] = h0n[i]; grc[i] = grn[i]; }
        if (smp && tt < 7) {
#pragma unroll
            for (int i = 0; i < 4; ++i) { const int j = 16 * (tt + 1) + 4 * fq + i; h0n[i] = p.sh[(size_t)(layer * 128 + j) * 256 + c]; grn[i] = bf2f(U2[(size_t)(TP + j) * 768 + 256 + c]); }
        }
        bf16x8 af[2];
#pragma unroll
        for (int ks = 0; ks < 2; ++ks) { const LAS f32x4* src = (const LAS f32x4*)(XC + (16 * tt + fr) * 132 + 64 * nl + 32 * ks + 8 * fq); af[ks] = pack8(src[0], src[1]); }
        f32x4 ar = (f32x4){0.f, 0.f, 0.f, 0.f}, ai = (f32x4){0.f, 0.f, 0.f, 0.f};
#pragma unroll
        for (int ks = 0; ks < 2; ++ks) { ar = mfma16(af[ks], wa[ks], ar); ai = mfma16(af[ks], wx[ks], ai); }
        float av[4], bv[4];
#pragma unroll
        for (int i = 0; i < 4; ++i) { const int t = 16 * tt + 4 * fq + i; const float xcv = XC[t * 132 + cl];
            const float r = fsigmoid(ar[i] + ba), ig = fsigmoid(ai[i] + bx);
            const float a = __builtin_amdgcn_exp2f(spv * r);
            av[i] = a; bv[i] = __builtin_amdgcn_sqrtf(fmaxf(1.0f - a * a, 0.f)) * (ig * xcv); }
        if (smp) {
#pragma unroll
            for (int i = 0; i < 4; ++i) { const int j = 16 * tt + 4 * fq + i;
                const float hv = av[i] * h0c[i] + bv[i];
                p.out[O_SH + (size_t)(layer * 128 + j) * 256 + c] = hv;
                MIX[(size_t)(TP + j) * 1024 + 512 + c] = (bf16_t)(pk2(hv * gelu_tanh(grc[i]), 0.f) & 0xffffu); }
        } else {
            float A4 = 1.f, B4 = 0.f;
#pragma unroll
            for (int i = 0; i < 4; ++i) { B4 = av[i] * B4 + bv[i]; A4 *= av[i]; }
            { const float A1 = __shfl_up(A4, 16), B1 = __shfl_up(B4, 16); if (fq >= 1) { B4 = A4 * B1 + B4; A4 = A4 * A1; } }
            { const float A2 = __shfl_up(A4, 32), B2 = __shfl_up(B4, 32); if (fq >= 2) { B4 = A4 * B2 + B4; A4 = A4 * A2; } }
            float Ae = __shfl_up(A4, 16), Be = __shfl_up(B4, 16); if (fq == 0) { Ae = 1.f; Be = 0.f; }
            const float At = __shfl(A4, 48 + fr), Bt = __shfl(B4, 48 + fr);
            float Ain = Ac * Ae, hin = Ae * Bc + Be;
#pragma unroll
            for (int i = 0; i < 4; ++i) { hin = av[i] * hin + bv[i]; Ain *= av[i];
                const size_t o = ((size_t)b * 4096 + ch * 128 + 16 * tt + 4 * fq + i) * 256 + c;
                HC[o] = pk2(hin, Ain); }
            Bc = At * Bc + Bt; Ac *= At;
        }
    }
    if (!smp && fq == 0) { ((float*)(p.ws + WS_AGA))[ti * 256 + c] = Ac; ((float*)(p.ws + WS_AGB))[ti * 256 + c] = Bc; }
    __syncthreads();
}

DI void rowsum_reduce(const u32x4 w0, const u32x4 w1, const f32x4 (&r4)[4], float& s, float& t) {
    s = 0.f; t = 0.f;
    const unsigned ww[8] = {w0.x, w0.y, w0.z, w0.w, w1.x, w1.y, w1.z, w1.w};
#pragma unroll
    for (int q = 0; q < 8; ++q) { const float lo = __uint_as_float(ww[q] << 16), hi = __uint_as_float(ww[q] & 0xffff0000u);
        s += lo + hi; t += lo * r4[q >> 1][(q & 1) * 2] + hi * r4[q >> 1][(q & 1) * 2 + 1]; }
#pragma unroll
    for (int o = 1; o < 64; o <<= 1) { s += __shfl_xor(s, o); t += __shfl_xor(t, o); }
}
DI void rowsum_rows(const bf16_t* WT, const float* gain, const float* bias, int nrows, float* cs, float* bw, int gw, int NGW, int lane) {
    f32x4 r4[4];
#pragma unroll
    for (int j = 0; j < 4; ++j) { const f32x4 g4 = ((const f32x4*)gain)[lane * 4 + j], b4 = ((const f32x4*)bias)[lane * 4 + j]; r4[j] = b4 / g4; }
    for (int n0 = gw; n0 < nrows; n0 += 2 * NGW) {
        const int n1 = n0 + NGW; const bool has1 = n1 < nrows;
        const u32x4* p0 = (const u32x4*)(WT + (size_t)n0 * 1024 + 16 * lane);
        const u32x4* p1 = (const u32x4*)(WT + (size_t)(has1 ? n1 : n0) * 1024 + 16 * lane);
        const u32x4 a0 = p0[0], a1 = p0[1], b0 = p1[0], b1 = p1[1];
        float s0, t0, s1, t1;
        rowsum_reduce(a0, a1, r4, s0, t0); rowsum_reduce(b0, b1, r4, s1, t1);
        if (lane == 0) { cs[n0] = s0; bw[n0] = t0; if (has1) { cs[n1] = s1; bw[n1] = t1; } }
    }
}

DI void fixup_item(const Params& p, int layer, int item, int tid) {
    tid = launder_v(tid);
    const int ti = item >> 2, qr = item & 3;
    const int b = ti >> 5, ch = ti & 31, c = tid & 255, half = tid >> 8;
    const float* AGA = (const float*)(p.ws + WS_AGA); const float* AGB = (const float*)(p.ws + WS_AGB);
    float carry = 0.f;
    {
        float ca[31], cb[31];
#pragma unroll
        for (int j = 0; j < 31; ++j) { const bool on = j < ch; ca[j] = on ? AGA[(b * 32 + j) * 256 + c] : 1.f; cb[j] = on ? AGB[(b * 32 + j) * 256 + c] : 0.f; }
#pragma unroll
        for (int j = 0; j < 31; ++j) carry = ca[j] * carry + cb[j];
    }
    const unsigned* HC = (const unsigned*)(p.ws + WS_HL); const bf16_t* U2 = (const bf16_t*)(p.ws + WS_U2);
    bf16_t* MIX = (bf16_t*)(p.ws + WS_MIX);
    const size_t row0 = (size_t)b * 4096 + ch * 128 + qr * 32 + half * 16;
    unsigned hc[16]; float grv[16];
#pragma unroll
    for (int k = 0; k < 16; ++k) { hc[k] = __builtin_nontemporal_load(HC + (row0 + k) * 256 + c); grv[k] = bf2f(__builtin_nontemporal_load(U2 + (row0 + k) * 768 + 256 + c)); }
    float h = 0.f;
#pragma unroll
    for (int k = 0; k < 16; ++k) { h = __uint_as_float(hc[k] << 16) + __uint_as_float(hc[k] & 0xffff0000u) * carry; MIX[(row0 + k) * 1024 + 512 + c] = (bf16_t)(pk2(h * gelu_tanh(grv[k]), 0.f) & 0xffffu); }
    if (ch == 31 && qr == 3 && half == 1) p.out[O_PH + (size_t)(layer * 4 + b) * 256 + c] = AGA[(b * 32 + 31) * 256 + c] * carry + AGB[(b * 32 + 31) * 256 + c];
}

DI void st_bf4_lds(LAS bf16_t* dst, f32x4 v) { u32x2 w; w.x = pk2(v.x, v.y); w.y = pk2(v.z, v.w); *(LAS u32x2*)dst = w; }
DI void pool_item(const Params& p, int layer, int ti, LAS unsigned char* lds, int tid, int wid, int lane) {
    RELAUNDER();
    LAS float* Zs = (LAS float*)lds;
    LAS bf16_t* Ds = (LAS bf16_t*)(lds + 48128);
    LAS bf16_t* Pw = (LAS bf16_t*)(lds + 115712);
    LAS float* Sc = (LAS float*)(lds + 152576);
    const bf16_t* U2 = (const bf16_t*)(p.ws + WS_U2);
    const bool smp = (ti >= 128);
    const int b = ti >> 5, ch = ti & 31;
    const int cq = tid & 63, gq = cq >> 4, tg = tid >> 6;
    const float wf = (float)(2 << gq);
    {
        const bf16_t* PwT = (const bf16_t*)(p.ws + WS_PWT) + (size_t)layer * 4 * 64 * 64;
#pragma unroll
        for (int i = 0; i < 4; ++i) { const int idx = tid + 512 * i, rowi = idx >> 3, c8 = idx & 7;
            *(LAS u32x4*)(Pw + rowi * 72 + 8 * c8) = *(const u32x4*)(PwT + (size_t)rowi * 64 + 8 * c8); }
        if (tid < 64) *(LAS f32x4*)(Sc + 4 * tid) = ((const f32x4*)(p.pool_scale + layer * 256))[tid];
    }
    if (!smp) {
        if (ch == 31) {
            for (int idx = tid; idx < 15 * 64; idx += NTHR) { const int r = idx >> 6, c4 = idx & 63;
                ((f32x4*)(p.out + O_PP + ((size_t)(layer * 4 + b) * 15 + r) * 256))[c4] = ld_bf4(U2 + ((size_t)b * 4096 + 4081 + r) * 768 + 512 + 4 * c4); }
        }
        f32x4 pf[6];
#pragma unroll
        for (int i = 0; i < 6; ++i) { const int e = tid + 512 * i, r = e >> 6, c4 = e & 63, t = ch * 128 - 15 + r;
            pf[i] = (e < 47 * 64 && t >= 0) ? ld_bf4(U2 + ((size_t)b * 4096 + t) * 768 + 512 + 4 * c4) : (f32x4){0.f, 0.f, 0.f, 0.f}; }
        for (int q = 0; q < 4; ++q) {
#pragma unroll
            for (int i = 0; i < 6; ++i) { const int e = tid + 512 * i; if (e < 47 * 64) *(LAS f32x4*)(Zs + 4 * e) = pf[i]; }
            __syncthreads();
            if (q < 3) {
#pragma unroll
                for (int i = 0; i < 6; ++i) { const int e = tid + 512 * i, r = e >> 6, c4 = e & 63, t = ch * 128 + 32 * (q + 1) - 15 + r;
                    pf[i] = (e < 47 * 64 && t >= 0) ? ld_bf4(U2 + ((size_t)b * 4096 + t) * 768 + 512 + 4 * c4) : (f32x4){0.f, 0.f, 0.f, 0.f}; }
            }
            f32x4 v[19], zs[4], res[4];
#pragma unroll
            for (int k = 0; k < 19; ++k) v[k] = *(const LAS f32x4*)(Zs + (4 * tg + k) * 256 + 4 * cq);
#pragma unroll
            for (int j = 0; j < 4; ++j) zs[j] = v[15 + j];
#pragma unroll
            for (int k = 18; k >= 1; --k) v[k] += v[k - 1];
#pragma unroll
            for (int j = 0; j < 4; ++j) res[j] = v[15 + j];
#pragma unroll
            for (int k = 18; k >= 3; --k) v[k] += v[k - 2];
#pragma unroll
            for (int j = 0; j < 4; ++j) res[j] = (gq >= 1) ? v[15 + j] : res[j];
#pragma unroll
            for (int k = 18; k >= 7; --k) v[k] += v[k - 4];
#pragma unroll
            for (int j = 0; j < 4; ++j) res[j] = (gq >= 2) ? v[15 + j] : res[j];
#pragma unroll
            for (int k = 18; k >= 15; --k) v[k] += v[k - 8];
#pragma unroll
            for (int j = 0; j < 4; ++j) res[j] = (gq >= 3) ? v[15 + j] : res[j];
#pragma unroll
            for (int j = 0; j < 4; ++j) { const int tl = 32 * q + 4 * tg + j; const float rc = __builtin_amdgcn_rcpf(fminf((float)(ch * 128 + tl + 1), wf));
                const f32x4 diff = res[j] * rc - zs[j];
                st_bf4_lds(Ds + tl * 264 + 4 * cq, diff); }
            __syncthreads();
        }
    } else {
        const int j0 = 32 * (ti - 128);
        const float rw = 1.0f / wf;
#pragma unroll 2
        for (int k = 0; k < 4; ++k) { const int jl = 4 * tg + k, j = j0 + jl;
            const f32x4* sp = (const f32x4*)(p.spool + (size_t)(layer * 128 + j) * 15 * 256);
            f32x4 st[15];
#pragma unroll
            for (int r = 0; r < 15; ++r) st[r] = sp[r * 64 + cq];
            const f32x4 z = ld_bf4(U2 + (size_t)(TP + j) * 768 + 512 + 4 * cq);
            const f32x4 s2 = z + st[14];
            const f32x4 s4 = s2 + (st[13] + st[12]);
            const f32x4 s8 = s4 + ((st[11] + st[10]) + (st[9] + st[8]));
            const f32x4 s16 = s8 + (((st[7] + st[6]) + (st[5] + st[4])) + ((st[3] + st[2]) + (st[1] + st[0])));
            const f32x4 rs = (gq == 0) ? s2 : ((gq == 1) ? s4 : ((gq == 2) ? s8 : s16));
            const f32x4 diff = rs * rw - z;
            st_bf4_lds(Ds + jl * 264 + 4 * cq, diff);
            f32x4* op = (f32x4*)(p.out + O_SP + (size_t)(layer * 128 + j) * 15 * 256);
#pragma unroll
            for (int r = 0; r < 14; ++r) op[r * 64 + cq] = st[r + 1];
            op[14 * 64 + cq] = z; }
        __syncthreads();
    }
    const int fr = lane & 15, fq = lane >> 4;
    bf16_t* MIX = (bf16_t*)(p.ws + WS_MIX);
    if (!smp || wid < 2) {
        const size_t row = smp ? (size_t)(TP + 32 * (ti - 128) + 16 * wid + fr) : ((size_t)b * 4096 + ch * 128 + 16 * wid + fr);
#pragma unroll
        for (int g = 0; g < 4; ++g) {
            bf16x8 bfr[2];
#pragma unroll
            for (int ks = 0; ks < 2; ++ks) bfr[ks] = *(const LAS bf16x8*)(Ds + (16 * wid + fr) * 264 + 64 * g + 32 * ks + 8 * fq);
#pragma unroll
            for (int dt = 0; dt < 4; ++dt) {
                f32x4 o = (f32x4){0.f, 0.f, 0.f, 0.f};
#pragma unroll
                for (int ks = 0; ks < 2; ++ks) { const bf16x8 a = *(const LAS bf16x8*)(Pw + (g * 64 + 16 * dt + fr) * 72 + 32 * ks + 8 * fq); o = mfma16(a, bfr[ks], o); }
                const int c = 64 * g + 16 * dt + 4 * fq;
                const f32x4 sc4 = *(const LAS f32x4*)(Sc + c);
                st_bf4(MIX + row * 1024 + 768 + c, o * sc4);
            }
        }
    }
    __syncthreads();
}

DI void final_ln(const Params& p, int vb, int G, int tid) {
    int wid, lane; RELAUNDER();
    const float* part = (const float*)(p.ws + WS_ST2); const float* part_s = (const float*)(p.ws + WS_STS2);
    const bf16_t* YB = (const bf16_t*)(p.ws + WS_YB);
    const f32x4* g = (const f32x4*)(p.ln2_g + 1024); const f32x4* bb = (const f32x4*)(p.ln2_b + 1024);
    f32x4 g4[4], b4[4];
#pragma unroll
    for (int j = 0; j < 4; ++j) { g4[j] = g[lane + 64 * j]; b4[j] = bb[lane + 64 * j]; }
    const int gw = vb * 8 + wid, NGW = G * 8;
    for (int row0 = gw; row0 < MT; row0 += 4 * NGW) {
        f32x4 y[4][4]; float mu[4], rs[4];
#pragma unroll
        for (int r = 0; r < 4; ++r) { const int row = (row0 + r * NGW < MT) ? row0 + r * NGW : row0;
#pragma unroll
            for (int j = 0; j < 4; ++j) y[r][j] = ld_bf4_nt(YB + (size_t)row * 1024 + 4 * (lane + 64 * j));
            row_stats_any(part, part_s, row, lane >> 4, mu[r], rs[r]); }
#pragma unroll
        for (int r = 0; r < 4; ++r) { const int row = row0 + r * NGW;
            if (row < MT) { f32x4* op = (f32x4*)(p.out + (size_t)row * 1024);
#pragma unroll
                for (int j = 0; j < 4; ++j) __builtin_nontemporal_store((y[r][j] - mu[r]) * rs[r] * g4[j] + b4[j], op + lane + 64 * j); } }
    }
}

#define XB_TMO      128
#define XB_XCNT(j)  (256  + 64 * (j))
#define XB_XSUB(j)  (1280 + 64 * (j))
#define XB_XGEN(j)  (2304 + 64 * (j))
#define XB_TOP      3328
#define XB_TOPGEN   3392
#define XCD_BAR_WORDS 3456
#define XB_SPIN_CAP (1u << 22)
DI unsigned xb_ld(unsigned* p)              { return __hip_atomic_load(p, __ATOMIC_RELAXED, __HIP_MEMORY_SCOPE_AGENT); }
DI unsigned xb_add(unsigned* p, unsigned v) { return __hip_atomic_fetch_add(p, v, __ATOMIC_RELAXED, __HIP_MEMORY_SCOPE_AGENT); }
DI unsigned xb_xcc_id() { return (unsigned)__builtin_amdgcn_s_getreg((3 << 11) | 20) & 0xFu; }
#define XB_SPIN(cond, bar) do { unsigned _sp = 0; while (cond) { __builtin_amdgcn_s_sleep(1); \
    if ((++_sp & 255u) == 0u) { if (xb_ld(&(bar)[XB_TMO])) break; if (_sp > XB_SPIN_CAP) { atomicAdd(&(bar)[XB_TMO], 1u); break; } } } } while (0)
DI void xcd_barrier_complete(unsigned* bar, unsigned x, unsigned& nloc, unsigned& nx) {
    const unsigned G = gridDim.x;
    unsigned sum, cnt, mine, sp = 0u;
    for (;;) {
        sum = 0u; cnt = 0u; mine = 0u;
#pragma unroll
        for (unsigned j = 0; j < 16; ++j) { const unsigned c = xb_ld(&bar[XB_XCNT(j)]); sum += c; cnt += (c > 0u) ? 1u : 0u; mine = (j == x) ? c : mine; }
        if (sum == G) break;
        __builtin_amdgcn_s_sleep(1);
        if ((++sp & 255u) == 0u) { if (xb_ld(&bar[XB_TMO])) break; if (sp > XB_SPIN_CAP) { atomicAdd(&bar[XB_TMO], 1u); break; } }
    }
    nloc = mine > 0u ? mine : 1u; nx = cnt > 0u ? cnt : 1u;
}
DI void xcd_barrier(unsigned* bar, volatile LAS unsigned* st) {
    asm volatile("s_waitcnt vmcnt(0)" ::: "memory");
    __syncthreads();
    if (threadIdx.x == 0) {
        const unsigned x = xb_xcc_id();
        __builtin_amdgcn_s_waitcnt(0);
        unsigned nloc = st[0], nx = st[1];
        if (nloc == 0u) { xcd_barrier_complete(bar, x, nloc, nx); st[0] = nloc; st[1] = nx; }
        const unsigned old = xb_add(&bar[XB_XSUB(x)], 1u);
        const unsigned gen = old / nloc;
        if (old + 1u == (gen + 1u) * nloc) {
            __builtin_amdgcn_fence(__ATOMIC_RELEASE, "agent");
            asm volatile("s_waitcnt vmcnt(0)" ::: "memory");
            const unsigned og = xb_add(&bar[XB_TOP], 1u);
            const unsigned tg = og / nx;
            if (og + 1u == (tg + 1u) * nx) xb_add(&bar[XB_TOPGEN], 1u);
            else XB_SPIN(xb_ld(&bar[XB_TOPGEN]) == tg, bar);
            __builtin_amdgcn_fence(__ATOMIC_ACQUIRE, "agent");
            xb_add(&bar[XB_XGEN(x)], 1u);
            asm volatile("s_waitcnt vmcnt(0)" ::: "memory");
        } else {
            XB_SPIN(xb_ld(&bar[XB_XGEN(x)]) == gen, bar);
            __builtin_amdgcn_fence(__ATOMIC_ACQUIRE, "agent");
            asm volatile("s_waitcnt vmcnt(0)" ::: "memory");
        }
    }
    __syncthreads();
}

DI int launder_i_unused(int x) { asm volatile("" : "+s"(x)); return x; }

__global__ void __launch_bounds__(NTHR, 2) hybrid_fwd(Params p_unused) {
    extern __shared__ __attribute__((aligned(16))) unsigned char smem[];
    LAS unsigned char* lds = (LAS unsigned char*)smem;
    cg::grid_group grid = cg::this_grid();
    const int tid = threadIdx.x, wid = __builtin_amdgcn_readfirstlane(tid >> 6), lane = tid & 63;
    const int vb = blockIdx.x, G = gridDim.x;
    volatile LAS unsigned* xst = (volatile LAS unsigned*)(lds + LDS_BYTES - 16);
    { unsigned* bar0 = (unsigned*)(kparams().ws + WS_BAR); if (tid == 0) { xst[0] = 0u; xst[1] = 0u; (void)xb_add(&bar0[XB_XCNT(xb_xcc_id())], 1u); } }
    __syncthreads();

#if !(PHOFF & 1)
    for (int rep = 0; rep < REP_PREP; ++rep) { const Params p = kparams(); phase_prep(p, lds, tid, wid, lane, vb, G); }
#endif
    if (kparams().out == nullptr) grid.sync();
    GSYNC();

#pragma nounroll
    for (int l0 = 0; l0 < 2; ++l0) {
#if !(PHOFF & 2)
        for (int rep = 0; rep < REP_G1; ++rep) {
            const Params p = kparams(); const int l = launder_i(l0); unsigned char* ws = p.ws;
            gemm_all<FIn>(lds, (const bf16_t*)(ws + WS_YB), (const bf16_t*)(ws + WS_WIN) + (size_t)l * 1536 * 1024, NIN, 1024, l, 0, vb, G, tid);
        }
#endif
        GSYNC();
        for (int rep = 0; rep < REP_MIX; ++rep) {
            const int l = launder_i(l0);
            unsigned* qctr = (unsigned*)(kparams().ws + WS_QCTR) + 64 * l;
            int it = vb;
            for (;;) {
                if (it >= 774) break;
#if !(PHOFF & 4)
                if (it < 256) for (int r2 = 0; r2 < REP_ATT; ++r2) { const Params p = kparams(); attn_item(p, l, it, lds, tid, wid, lane); }
#endif
#if !(PHOFF & 8)
                if (it >= 256 && it < 514) for (int r2 = 0; r2 < REP_RG; ++r2) { const Params p = kparams(); rglru_item(p, l, (it < 258) ? (it) : (it - 258), lds, tid, wid, lane); }
#endif
#if !(PHOFF & 16)
                if (it >= 514 && it < 646) for (int r2 = 0; r2 < REP_POOL; ++r2) { const Params p = kparams(); pool_item(p, l, it - 514, lds, tid, wid, lane); }
#endif
#if !(PHOFF & 32)
                if (it >= 646) for (int r2 = 0; r2 < REP_SATT; ++r2) { const Params p = kparams(); sattn_item(p, l, it - 646, lds, tid, wid, lane); }
#endif
                if (tid == 0) xst[2] = G + xb_add(qctr, 1u);
                __syncthreads();
                it = __builtin_amdgcn_readfirstlane((int)xst[2]);
                __syncthreads();
            }
        }
        GSYNC();
#if !(PHOFF & 64)
        for (int rep = 0; rep < REP_FIX; ++rep) { const Params p = kparams(); const int l = launder_i(l0); for (int it = vb; it < 512; it += G) fixup_item(p, l, it, tid); }
#endif
        {
            const Params p = kparams(); const int l = launder_i(l0); unsigned char* ws = p.ws;
            const int tid2 = launder_v(tid), lane2 = tid2 & 63, gw = vb * 8 + (tid2 >> 6), NGW = G * 8;
            rowsum_rows((const bf16_t*)(ws + WS_W1) + (size_t)l * 4096 * 1024, p.ln1_g + l * 1024, p.ln1_b + l * 1024, 4096, (float*)(ws + WS_CS1) + l * 4096, (float*)(ws + WS_BW1) + l * 4096, gw, NGW, lane2);
            if (l == 0) rowsum_rows((const bf16_t*)(ws + WS_WIN) + (size_t)1536 * 1024, p.ln2_g, p.ln2_b, 1536, (float*)(ws + WS_CSIN) + 1536, (float*)(ws + WS_BWIN) + 1536, gw, NGW, lane2);
        }
        GSYNC();
#if !(PHOFF & 128)
        for (int rep = 0; rep < REP_G2; ++rep) {
            const Params p = kparams(); const int l = launder_i(l0); unsigned char* ws = p.ws;
#if REP_G2 > 1
            if (rep < REP_G2 - 1) gemm_all<FResT<true>>(lds, (const bf16_t*)(ws + WS_MIX), (const bf16_t*)(ws + WS_WOUT) + (size_t)l * 1024 * 1024, 1024, 1024, l, 0, vb, G, tid); else
#endif
            gemm_all<FRes>(lds, (const bf16_t*)(ws + WS_MIX), (const bf16_t*)(ws + WS_WOUT) + (size_t)l * 1024 * 1024, 1024, 1024, l, 0, vb, G, tid);
        }
#endif
        GSYNC();
#if !(PHOFF & 256)
        for (int rep = 0; rep < REP_G3; ++rep) {
            const Params p = kparams(); const int l = launder_i(l0); unsigned char* ws = p.ws;
            gemm_all<FFF1>(lds, (const bf16_t*)(ws + WS_YB), (const bf16_t*)(ws + WS_W1) + (size_t)l * 4096 * 1024, DFF, 1024, l, 0, vb, G, tid);
        }
#endif
        GSYNC();
#if !(PHOFF & 512)
        for (int rep = 0; rep < REP_G4; ++rep) {
            const Params p = kparams(); const int l = launder_i(l0); unsigned char* ws = p.ws;
#if REP_G4 > 1
            if (rep < REP_G4 - 1) gemm_all<FResT<true>>(lds, (const bf16_t*)(ws + WS_HID), (const bf16_t*)(ws + WS_W2) + (size_t)l * 1024 * 4096, 1024, 4096, l, 1, vb, G, tid); else
#endif
            gemm_all<FRes>(lds, (const bf16_t*)(ws + WS_HID), (const bf16_t*)(ws + WS_W2) + (size_t)l * 1024 * 4096, 1024, 4096, l, 1, vb, G, tid);
        }
#endif
        GSYNC();
    }
    { const Params p = kparams(); final_ln(p, vb, G, tid); }
}

extern "C" void kernel_launch(void* const* d_in, const int* in_sizes, int n_in, void* d_out, int out_size, void* d_ws, size_t ws_size, hipStream_t stream) {
    static int grid_blocks = 0;
    if (!grid_blocks) {
        int dev = 0, cus = 0, per_cu = 0;
        hipGetDevice(&dev);
        hipDeviceGetAttribute(&cus, hipDeviceAttributeMultiprocessorCount, dev);
        hipFuncSetAttribute((const void*)hybrid_fwd, hipFuncAttributeMaxDynamicSharedMemorySize, LDS_BYTES);
        hipOccupancyMaxActiveBlocksPerMultiprocessor(&per_cu, (const void*)hybrid_fwd, NTHR, LDS_BYTES);
        if (per_cu < 1) per_cu = 1;
        grid_blocks = cus * per_cu;
        if (ws_size < WS_END) fprintf(stderr, "kernel_launch: workspace too small: %zu < %zu\n", ws_size, (size_t)WS_END);
        fprintf(stderr, "kernel_launch: grid %d (cus %d x %d)\n", grid_blocks, cus, per_cu);
    }
    if (hipMemsetAsync((char*)d_ws + WS_BAR, 0, XCD_BAR_WORDS * 4 + 1024, stream) != hipSuccess) fprintf(stderr, "memset failed\n");
    Params p{};
    const float** pp = (const float**)&p;
    for (int i = 0; i < 25; ++i) pp[i] = (const float*)d_in[i];
    p.out = (float*)d_out; p.ws = (unsigned char*)d_ws;
    void* args[] = {&p};
    hipError_t e = hipLaunchCooperativeKernel((const void*)hybrid_fwd, dim3(grid_blocks), dim3(NTHR), args, LDS_BYTES, stream);
    if (e != hipSuccess) fprintf(stderr, "cooperative launch failed: %s (grid %d)\n", hipGetErrorString(e), grid_blocks);
}
```

```cpp
#include <hip/hip_runtime.h>
#include <hip/hip_cooperative_groups.h>
#include <cstdio>
namespace cg = cooperative_groups;

#define LAS __attribute__((address_space(3)))
typedef unsigned short bf16_t;
typedef short bf16x8 __attribute__((ext_vector_type(8)));
typedef float f32x4 __attribute__((ext_vector_type(4)));
typedef float f32x2 __attribute__((ext_vector_type(2)));
typedef unsigned u32x4 __attribute__((ext_vector_type(4)));
typedef unsigned u32x2 __attribute__((ext_vector_type(2)));
#define DI __device__ __forceinline__
#ifndef PHOFF
#define PHOFF 0
#endif
#ifndef REP_SYNC
#define REP_SYNC 1
#endif
#ifndef REP_MIX
#define REP_MIX 1
#endif
#ifndef REP_G3
#define REP_G3 1
#endif
#ifndef REP_PREP
#define REP_PREP 1
#endif
#ifndef REP_FIX
#define REP_FIX 1
#endif
#ifndef REP_ATT
#define REP_ATT 1
#endif
#ifndef REP_RG
#define REP_RG 1
#endif
#ifndef REP_POOL
#define REP_POOL 1
#endif
#ifndef REP_SATT
#define REP_SATT 1
#endif
#ifndef REP_G2
#define REP_G2 1
#endif
#ifndef REP_G4
#define REP_G4 1
#endif
#ifndef REP_G1
#define REP_G1 1
#endif
#define GSYNC() do { for (int _r = 0; _r < REP_SYNC; ++_r) { unsigned* _bar = (unsigned*)(kparams().ws + WS_BAR); xcd_barrier(_bar, xst); } } while (0)

constexpr int DM = 1024, TP = 16384, TS = 128, MT = TP + TS, NIN = 1536, DFF = 4096;
constexpr int NTHR = 512;
constexpr float LOG2E = 1.4426950408889634f;
constexpr float ALPHA = 1.4142135623730951f;
constexpr float QSCALE = 0.125f * 1.4426950408889634f;
constexpr float LN_EPS = 1e-5f;
constexpr size_t O_YP = 0, O_YS = 16777216, O_PK = 16908288, O_PV = 17039360, O_PH = 17170432, O_PC = 17172480, O_PP = 17178624,
                 O_SK = 17209344, O_SV = 21403648, O_SH = 25597952, O_SC = 25663488, O_SP = 25860096;
constexpr size_t WS_WIN = 0;
constexpr size_t WS_WOUT = WS_WIN + 2ull * 1536 * 1024 * 2;
constexpr size_t WS_W1 = WS_WOUT + 2ull * 1024 * 1024 * 2;
constexpr size_t WS_W2 = WS_W1 + 2ull * 4096 * 1024 * 2;
constexpr size_t WS_YB = WS_W2 + 2ull * 4096 * 1024 * 2;
constexpr size_t WS_MIX = WS_YB + (size_t)MT * 1024 * 2;
constexpr size_t WS_HID = WS_MIX + (size_t)MT * 1024 * 2;
constexpr size_t WS_QKV = WS_HID;
constexpr size_t WS_U2 = WS_QKV + (size_t)MT * 768 * 2;
constexpr size_t WS_HL = WS_U2 + (size_t)MT * 768 * 4;
constexpr size_t WS_CA = WS_HL + (size_t)TP * 256 * 4;
constexpr size_t WS_ST1 = WS_HID + (size_t)MT * 4096 * 2;
constexpr size_t WS_ST2 = WS_ST1 + (size_t)MT * 32 * 4;
constexpr size_t WS_CSIN = WS_ST2 + (size_t)MT * 32 * 4;
constexpr size_t WS_BWIN = WS_CSIN + 2 * 1536 * 4;
constexpr size_t WS_CS1 = WS_BWIN + 2 * 1536 * 4;
constexpr size_t WS_BW1 = WS_CS1 + 2 * 4096 * 4;
constexpr size_t WS_GAT = WS_BW1 + 2 * 4096 * 4;
constexpr size_t WS_GXT = WS_GAT + 2 * 4 * 64 * 64 * 2;
constexpr size_t WS_PWT = WS_GXT + 2 * 4 * 64 * 64 * 2;
constexpr size_t WS_AGA = WS_PWT + 2 * 4 * 64 * 64 * 2;
constexpr size_t WS_AGB = WS_AGA + 128 * 256 * 4;
constexpr size_t WS_STS1 = WS_AGB + 128 * 256 * 4;
constexpr size_t WS_STS2 = WS_STS1 + 128 * 128 * 4;
constexpr size_t WS_BAR = WS_STS2 + 128 * 128 * 4;
constexpr size_t WS_QCTR = WS_BAR + 3456 * 4;
constexpr size_t WS_END = WS_QCTR + 1024;
static_assert(WS_CA + (size_t)TP * 256 * 4 <= WS_ST1, "alias region overflow");
static_assert(WS_END <= 268435456ull, "workspace budget");
constexpr int LDS_BYTES = 163840;

struct Params {
    const float* xp; const float* xs; const float* ck; const float* cv; const float* sh; const float* sc; const float* spool;
    const float* w_in; const float* sinks; const float* conv_w; const float* conv_b; const float* ga_w; const float* ga_b; const float* gx_w; const float* gx_b; const float* lam;
    const float* pool_w; const float* pool_scale; const float* w_out; const float* ln1_g; const float* ln1_b; const float* w_ff1; const float* w_ff2; const float* ln2_g; const float* ln2_b;
    float* out; unsigned char* ws;
};

DI unsigned pk2(float lo, float hi) { unsigned r; asm volatile("v_cvt_pk_bf16_f32 %0, %1, %2" : "=v"(r) : "v"(lo), "v"(hi)); return r; }
DI float bf2f(bf16_t b) { return __uint_as_float(((unsigned)b) << 16); }
DI float bfround(float x) { return __uint_as_float(pk2(x, 0.f) << 16); }
DI f32x4 mfma16(bf16x8 a, bf16x8 b, f32x4 c) { return __builtin_amdgcn_mfma_f32_16x16x32_bf16(a, b, c, 0, 0, 0); }
DI int launder_v(int x) { asm volatile("" : "+v"(x)); return x; }
DI int launder_i(int x) { asm volatile("" : "+s"(x)); return x; }
#define RELAUNDER() do { tid = launder_v(tid); lane = tid & 63; wid = __builtin_amdgcn_readfirstlane(tid >> 6); } while (0)
DI void lds_wait() { asm volatile("s_waitcnt lgkmcnt(0)" ::: "memory"); }
DI float sigmoidf_(float x) { return 1.0f / (1.0f + __expf(-x)); }
DI float gelu_tanh(float x) { const float u = 0.7978845608028654f * (x + 0.044715f * x * x * x); return x * __builtin_amdgcn_rcpf(1.0f + __builtin_amdgcn_exp2f(-2.0f * 1.4426950408889634f * u)); }
DI bf16x8 pack8(f32x4 lo, f32x4 hi) { u32x4 w; w.x = pk2(lo.x, lo.y); w.y = pk2(lo.z, lo.w); w.z = pk2(hi.x, hi.y); w.w = pk2(hi.z, hi.w); return __builtin_bit_cast(bf16x8, w); }
DI f32x4 ld_bf4_nt(const bf16_t* p) { const u32x2 w = __builtin_nontemporal_load((const u32x2*)p); return (f32x4){__uint_as_float(w.x << 16), __uint_as_float(w.x & 0xffff0000u), __uint_as_float(w.y << 16), __uint_as_float(w.y & 0xffff0000u)}; }
DI f32x4 ld_bf4(const bf16_t* p) { const u32x2 w = *(const u32x2*)p; return (f32x4){__uint_as_float(w.x << 16), __uint_as_float(w.x & 0xffff0000u), __uint_as_float(w.y << 16), __uint_as_float(w.y & 0xffff0000u)}; }
DI void st_bf4(bf16_t* dst, f32x4 v) { u32x2 w; w.x = pk2(v.x, v.y); w.y = pk2(v.z, v.w); *(u32x2*)dst = w; }

namespace pg8 {
constexpr int BM = 256, BK = 64, HALF = 128, HTB = HALF * BK * 2, STAGE_BYTES = 8 * HTB, NXCD = 8, WGM = 8;
DI int lds_byte(int r, int c) { const int st = (r >> 4) * 2 + (c >> 5), rr = r & 15, cc = c & 31, ob = rr * 64 + cc * 2; return st * 1024 + (ob ^ (((ob >> 9) & 1) << 5)); }
DI void stage_rc(int b, int& R, int& C) { const int st = b / 1024, sb = b % 1024, swz = sb ^ (((sb >> 9) & 1) << 5); R = (st >> 1) * 16 + swz / 64; C = (st & 1) * 32 + (swz % 64) / 2; }
DI int perm32(int rho) { const int n = rho >> 4, i = rho & 15; return 8 * (i >> 2) + 4 * n + (i & 3); }
struct Unit { int pm, pn; };
struct Gemm { const bf16_t* A; const bf16_t* Bt; int M, N, K; };
struct StaticOrder {
    int nM, nN, nwg, G, c;
    DI void init(int M, int N, int G_, int c_) { nM = M / BM; nN = N / BM; nwg = nM * nN; G = G_; c = c_; }
    DI bool next(int i, Unit& u) const {
        const long L = (long)i * G + c; if (L >= nwg) return false;
        int wgid = (int)L; { const int q = nwg / NXCD, r = nwg % NXCD, xcd = wgid % NXCD, off = wgid / NXCD; wgid = (xcd < r ? xcd * (q + 1) : r * (q + 1) + (xcd - r) * q) + off; }
        const int nig = WGM * nN, gid = wgid / nig, fm = gid * WGM, gsz = (nM - fm) < WGM ? (nM - fm) : WGM;
        u.pm = fm + ((wgid % nig) % gsz); u.pn = (wgid % nig) / gsz; return true;
    }
};

template <class Epi>
DI void gemm_phase(LAS unsigned char* lds, const Gemm g, const StaticOrder& S, const Epi& E, int tid) {
    const int wid = __builtin_amdgcn_readfirstlane(tid >> 6), lane = tid & 63, wr = wid >> 2, wc = wid & 3, fr = lane & 15, fq = lane >> 4;
    const int K = g.K, nt = K / BK;
    unsigned voffA[2], voffB[2];
#pragma unroll
    for (int i = 0; i < 2; ++i) { int R, C; stage_rc(tid * 16 + i * 8192, R, C); const int Rb = (R & ~31) + perm32(R & 31); voffA[i] = (unsigned)(R * K + C) * 2u; voffB[i] = (unsigned)(Rb * K + C) * 2u; }
    const size_t kstep = (size_t)(BK * 2);
    const size_t hstep = (size_t)HALF * K * 2;
    const size_t tstep = 2 * hstep;
    const unsigned ldsw = (unsigned)wid * 1024u;
    const int aoff = lds_byte(wr * 64 + fr, fq * 8), boff = lds_byte(wc * 32 + fr, fq * 8);
#define PG8_SA(b, h) (((b) * 2 + (h)) * HTB)
#define PG8_SB(b, h) ((4 + (b) * 2 + (h)) * HTB)
#define PG8_STAGE(bufoff, gbase, voff) do { _Pragma("unroll") for (int _i = 0; _i < 2; ++_i) \
        __builtin_amdgcn_global_load_lds((const unsigned*)((const char*)(gbase) + (voff)[_i]), (LAS unsigned*)(lds + (bufoff) + ldsw + _i * 8192), 16, 0, 0); } while (0)
#define PG8_LDA(dst, b, h) do { _Pragma("unroll") for (int m = 0; m < 4; ++m) _Pragma("unroll") for (int k = 0; k < 2; ++k) dst[m][k] = *(const LAS bf16x8*)(lds + PG8_SA(b, h) + aoff + m * 2048 + k * 1024); } while (0)
#define PG8_LDB(dst, b, h) do { _Pragma("unroll") for (int n = 0; n < 2; ++n) _Pragma("unroll") for (int k = 0; k < 2; ++k) dst[n][k] = *(const LAS bf16x8*)(lds + PG8_SB(b, h) + boff + n * 2048 + k * 1024); } while (0)
#define PG8_MMA(ai, bj, At, Bt) do { __builtin_amdgcn_s_setprio(1); _Pragma("unroll") for (int m = 0; m < 4; ++m) _Pragma("unroll") for (int n = 0; n < 2; ++n) _Pragma("unroll") for (int k = 0; k < 2; ++k) \
        acc[ai][bj][m][n] = __builtin_amdgcn_mfma_f32_16x16x32_bf16(Bt[n][k], At[m][k], acc[ai][bj][m][n], 0, 0, 0); __builtin_amdgcn_s_setprio(0); } while (0)
#define PG8_WAIT_V(n) asm volatile("s_waitcnt vmcnt(" #n ")" ::: "memory")
#define PG8_WAIT_L(n) asm volatile("s_waitcnt lgkmcnt(" #n ")" ::: "memory")
#define PG8_BAR __builtin_amdgcn_s_barrier()
#define PG8_SCHED __builtin_amdgcn_sched_barrier(0)
    Unit cur, nxt; int ui = 0;
    if (!S.next(0, cur)) return;
    f32x4 acc[2][2][4][2];
#pragma unroll
    for (int a = 0; a < 2; ++a)
#pragma unroll
        for (int b = 0; b < 2; ++b)
#pragma unroll
            for (int m = 0; m < 4; ++m)
#pragma unroll
                for (int n = 0; n < 2; ++n) acc[a][b][m][n] = (f32x4){0.f, 0.f, 0.f, 0.f};
    bf16x8 At[4][2], B0[2][2], B1[2][2];
    const char* cA = (const char*)g.A + (size_t)cur.pm * tstep; const char* cB = (const char*)g.Bt + (size_t)cur.pn * tstep;
    PG8_STAGE(PG8_SB(0, 0), cB, voffB); PG8_STAGE(PG8_SA(0, 0), cA, voffA); PG8_STAGE(PG8_SB(0, 1), cB + hstep, voffB); PG8_STAGE(PG8_SA(0, 1), cA + hstep, voffA);
    if (wr == 1) PG8_BAR;
    PG8_WAIT_V(4); PG8_BAR;
    PG8_STAGE(PG8_SB(1, 0), cB + kstep, voffB); PG8_STAGE(PG8_SA(1, 0), cA + kstep, voffA); PG8_STAGE(PG8_SB(1, 1), cB + hstep + kstep, voffB);
    PG8_WAIT_V(6); PG8_BAR;
    for (;;) {
        const bool has_next = S.next(ui + 1, nxt);
        const char* nA = has_next ? (const char*)g.A + (size_t)nxt.pm * tstep : cA; const char* nB = has_next ? (const char*)g.Bt + (size_t)nxt.pn * tstep : cB;
        for (int t = 0; t < nt; t += 2) {
            const bool last = (t == nt - 2);
            const char* a1 = cA + (size_t)(t + 1) * kstep;
            const char* a2 = last ? nA : cA + (size_t)(t + 2) * kstep; const char* b2 = last ? nB : cB + (size_t)(t + 2) * kstep;
            const char* a3 = a2 + kstep; const char* b3 = b2 + kstep;
            PG8_LDB(B0, 0, 0); PG8_SCHED; PG8_LDA(At, 0, 0); PG8_STAGE(PG8_SA(1, 1), a1 + hstep, voffA);
            PG8_WAIT_L(8); PG8_BAR; PG8_WAIT_L(0); PG8_MMA(0, 0, At, B0); PG8_BAR; PG8_SCHED;
            PG8_LDB(B1, 0, 1); PG8_STAGE(PG8_SB(0, 0), b2, voffB);
            PG8_BAR; PG8_WAIT_L(0); PG8_MMA(0, 1, At, B1); PG8_BAR;
            PG8_LDA(At, 0, 1); PG8_STAGE(PG8_SA(0, 0), a2, voffA);
            PG8_BAR; PG8_WAIT_L(0); PG8_MMA(1, 0, At, B0); PG8_BAR; PG8_SCHED;
            PG8_STAGE(PG8_SB(0, 1), b2 + hstep, voffB);
            PG8_WAIT_V(6); PG8_BAR; PG8_MMA(1, 1, At, B1); PG8_BAR;
            PG8_LDB(B0, 1, 0); PG8_SCHED; PG8_LDA(At, 1, 0); PG8_STAGE(PG8_SA(0, 1), a2 + hstep, voffA);
            PG8_WAIT_L(8); PG8_BAR; PG8_WAIT_L(0); PG8_MMA(0, 0, At, B0); PG8_BAR; PG8_SCHED;
            PG8_LDB(B1, 1, 1); PG8_STAGE(PG8_SB(1, 0), b3, voffB);
            PG8_BAR; PG8_WAIT_L(0); PG8_MMA(0, 1, At, B1); PG8_BAR;
            PG8_LDA(At, 1, 1); PG8_STAGE(PG8_SA(1, 0), a3, voffA);
            PG8_BAR; PG8_WAIT_L(0); PG8_MMA(1, 0, At, B0); PG8_BAR; PG8_SCHED;
            PG8_STAGE(PG8_SB(1, 1), b3 + hstep, voffB);
            PG8_WAIT_V(6); PG8_BAR; PG8_MMA(1, 1, At, B1); PG8_BAR;
        }
        E(acc, cur, ui, wr, wc, fr, fq);
        if (!has_next) break;
#pragma unroll
        for (int a = 0; a < 2; ++a)
#pragma unroll
            for (int b = 0; b < 2; ++b)
#pragma unroll
                for (int m = 0; m < 4; ++m)
#pragma unroll
                    for (int n = 0; n < 2; ++n) acc[a][b][m][n] = (f32x4){0.f, 0.f, 0.f, 0.f};
        cur = nxt; cA = nA; cB = nB; ++ui;
    }
    PG8_WAIT_V(0);
    if (wr == 0) PG8_BAR;
    PG8_BAR;
#undef PG8_SA
#undef PG8_SB
#undef PG8_STAGE
#undef PG8_LDA
#undef PG8_LDB
#undef PG8_MMA
#undef PG8_WAIT_V
#undef PG8_WAIT_L
#undef PG8_BAR
#undef PG8_SCHED
}
}

typedef const __attribute__((address_space(4))) Params* KParamsPtr;
DI Params kparams() {
#if defined(__HIP_DEVICE_COMPILE__)
    const __attribute__((address_space(4))) char* q = (const __attribute__((address_space(4))) char*)__builtin_amdgcn_kernarg_segment_ptr();
    asm volatile("" : "+s"(q));
    KParamsPtr kp = (KParamsPtr)q;
    Params r;
    r.xp = kp->xp; r.xs = kp->xs; r.ck = kp->ck; r.cv = kp->cv; r.sh = kp->sh; r.sc = kp->sc; r.spool = kp->spool;
    r.w_in = kp->w_in; r.sinks = kp->sinks; r.conv_w = kp->conv_w; r.conv_b = kp->conv_b; r.ga_w = kp->ga_w; r.ga_b = kp->ga_b; r.gx_w = kp->gx_w; r.gx_b = kp->gx_b; r.lam = kp->lam;
    r.pool_w = kp->pool_w; r.pool_scale = kp->pool_scale; r.w_out = kp->w_out; r.ln1_g = kp->ln1_g; r.ln1_b = kp->ln1_b; r.w_ff1 = kp->w_ff1; r.w_ff2 = kp->w_ff2; r.ln2_g = kp->ln2_g; r.ln2_b = kp->ln2_b;
    r.out = kp->out; r.ws = kp->ws;
    return r;
#else
    return Params{};
#endif
}

struct RowCtx { float mu, rstd; };
DI void row_stats(const float* part, int row, int fq, float& mu, float& rstd) {
    const f32x4* p = (const f32x4*)(part + (size_t)row * 32 + fq * 8);
    const f32x4 a = p[0], b = p[1];
    float s = (a.x + a.z) + (b.x + b.z), ss = (a.y + a.w) + (b.y + b.w);
    s += __shfl_xor(s, 16); s += __shfl_xor(s, 32); ss += __shfl_xor(ss, 16); ss += __shfl_xor(ss, 32);
    mu = s * (1.0f / 1024.0f); const float var = ss * (1.0f / 1024.0f) - mu * mu; rstd = rsqrtf(fmaxf(var, 0.f) + LN_EPS);
}

DI void row_stats_s(const float* part_s, int srow, int fq, float& mu, float& rstd) {
    const f32x4* p = (const f32x4*)(part_s + (size_t)srow * 128 + fq * 32);
    float s = 0.f, ss = 0.f;
#pragma unroll
    for (int i = 0; i < 8; ++i) { const f32x4 a = p[i]; s += a.x + a.z; ss += a.y + a.w; }
    s += __shfl_xor(s, 16); s += __shfl_xor(s, 32); ss += __shfl_xor(ss, 16); ss += __shfl_xor(ss, 32);
    mu = s * (1.0f / 1024.0f); const float var = ss * (1.0f / 1024.0f) - mu * mu; rstd = rsqrtf(fmaxf(var, 0.f) + LN_EPS);
}
DI void row_stats_any(const float* part, const float* part_s, int row, int fq, float& mu, float& rstd) {
    if (row < TP) row_stats(part, row, fq, mu, rstd); else row_stats_s(part_s, row - TP, fq, mu, rstd);
}

struct ColCtx { f32x4 a, b; };
DI void st_bf8(bf16_t* dst, f32x4 v0, f32x4 v1) { u32x4 w; w.x = pk2(v0.x, v0.y); w.y = pk2(v0.z, v0.w); w.z = pk2(v1.x, v1.y); w.w = pk2(v1.z, v1.w); *(u32x4*)dst = w; }
struct FIn {
    static constexpr bool STATS = false, PRELOAD = false, DEFERRED_PREP = true, STAGGER = false;
    const float* part; const float* part_s; const float* cs; const float* bw; int fold; int layer; bf16_t* QKV; bf16_t* U2; float* out; float* part_out; float* part_out_s;
    DI bool is_dry() const { return false; }
    DI const float* stats_src() const { return fold ? part : nullptr; }
    static DI FIn make(const Params& p, int l, int) { unsigned char* ws = p.ws;
        return FIn{(const float*)(ws + WS_ST2), (const float*)(ws + WS_STS2), (const float*)(ws + WS_CSIN) + l * 1536, (const float*)(ws + WS_BWIN) + l * 1536, l, l, (bf16_t*)(ws + WS_QKV), (bf16_t*)(ws + WS_U2), p.out, nullptr, nullptr}; }
    template <bool SMP> DI RowCtx row_begin(int row, int fq) const { RowCtx r{0.f, 1.f}; if (fold) { if (SMP) row_stats_s(part_s, row - TP, fq, r.mu, r.rstd); else row_stats(part, row, fq, r.mu, r.rstd); } return r; }
    DI ColCtx col_begin(int col) const { ColCtx c; c.a = *(const f32x4*)(cs + col); c.b = *(const f32x4*)(bw + col); return c; }
    DI f32x4 row_load8(int, int) const { return (f32x4){0.f, 0.f, 0.f, 0.f}; }
    DI f32x4 row_load4(int, int) const { return (f32x4){0.f, 0.f, 0.f, 0.f}; }
    DI f32x4 compute(int, int col, f32x4 a, const RowCtx& rc, const ColCtx& cc, float, float) const {
        f32x4 v = a;
        if (fold) v = (a - rc.mu * cc.a) * rc.rstd + cc.b;
        return v;
    }
    DI float* kv_dst(int row, int col) const {
        float* dst = nullptr; const int c7 = (col - 512) & 127; const bool isk = col < 640;
        if (row < TP) { const int t = row & 4095; if (t >= 3968) dst = out + (isk ? O_PK : O_PV) + ((size_t)((layer * 4 + (row >> 12)) * 128 + (t - 3968))) * 128 + c7; }
        else { dst = out + (isk ? O_SK : O_SV) + ((size_t)((layer * 128 + (row - TP)) * 128 + 127)) * 128 + c7; }
        return dst;
    }
    DI void store8(int row, int col, f32x4 v0, f32x4 v1) const {
        if (col < 512) st_bf8(QKV + (size_t)row * 768 + col, v0 * QSCALE, v1 * QSCALE);
        else if (col < 768) { st_bf8(QKV + (size_t)row * 768 + col, v0, v1); float* dst = kv_dst(row, col); if (dst) { *(f32x4*)dst = v0; *(f32x4*)(dst + 4) = v1; } }
        else st_bf8(U2 + (size_t)row * 768 + (col - 768), v0, v1);
    }
    DI void store4(int row, int col, f32x4 v) const {
        if (col < 512) st_bf4(QKV + (size_t)row * 768 + col, v * QSCALE);
        else if (col < 768) { st_bf4(QKV + (size_t)row * 768 + col, v); float* dst = kv_dst(row, col); if (dst) *(f32x4*)dst = v; }
        else st_bf4(U2 + (size_t)row * 768 + (col - 768), v);
    }
};
struct FFF1 {
    static constexpr bool STATS = false, PRELOAD = false, DEFERRED_PREP = false, STAGGER = true;
    const float* part; const float* part_s; const float* cs; const float* bw; bf16_t* HID; float* part_out; float* part_out_s;
    DI bool is_dry() const { return false; }
    DI const float* stats_src() const { return part; }
    static DI FFF1 make(const Params& p, int l, int) { unsigned char* ws = p.ws;
        return FFF1{(const float*)(ws + WS_ST1), (const float*)(ws + WS_STS1), (const float*)(ws + WS_CS1) + l * 4096, (const float*)(ws + WS_BW1) + l * 4096, (bf16_t*)(ws + WS_HID), nullptr, nullptr}; }
    template <bool SMP> DI RowCtx row_begin(int row, int fq) const { RowCtx r; if (SMP) row_stats_s(part_s, row - TP, fq, r.mu, r.rstd); else row_stats(part, row, fq, r.mu, r.rstd); return r; }
    DI ColCtx col_begin(int col) const { ColCtx c; c.a = *(const f32x4*)(cs + col); c.b = *(const f32x4*)(bw + col); return c; }
    DI f32x4 row_load8(int, int) const { return (f32x4){0.f, 0.f, 0.f, 0.f}; }
    DI f32x4 row_load4(int, int) const { return (f32x4){0.f, 0.f, 0.f, 0.f}; }
    DI f32x4 compute(int, int, f32x4 a, const RowCtx& rc, const ColCtx& cc, float, float) const {
        f32x4 v = (a - rc.mu * cc.a) * rc.rstd + cc.b;
        v.x = fmaxf(v.x, 0.f); v.y = fmaxf(v.y, 0.f); v.z = fmaxf(v.z, 0.f); v.w = fmaxf(v.w, 0.f); return v * v;
    }
    DI void store8(int row, int col, f32x4 v0, f32x4 v1) const { st_bf8(HID + (size_t)row * 4096 + col, v0, v1); }
    DI void store4(int row, int col, f32x4 v) const { st_bf4(HID + (size_t)row * 4096 + col, v); }
};
template <bool DRY> struct FResT {
    static constexpr bool STATS = true, PRELOAD = true, DEFERRED_PREP = false, STAGGER = false;
    int raw; const float* part; const float* part_s; const float* g; const float* b; float* Y; bf16_t* YB; float* part_out; float* part_out_s;
    static DI FResT make(const Params& p, int l, int which) { unsigned char* ws = p.ws;
        if (which == 0) return FResT{l == 0 ? 1 : 0, (const float*)(ws + WS_ST2), (const float*)(ws + WS_STS2), p.ln2_g, p.ln2_b, nullptr, (bf16_t*)(ws + WS_YB), (float*)(ws + WS_ST1), (float*)(ws + WS_STS1)};
        return FResT{0, (const float*)(ws + WS_ST1), (const float*)(ws + WS_STS1), p.ln1_g + l * 1024, p.ln1_b + l * 1024, nullptr, (bf16_t*)(ws + WS_YB), (float*)(ws + WS_ST2), (float*)(ws + WS_STS2)}; }
    DI bool is_dry() const { return DRY; }
    DI const float* stats_src() const { return raw ? nullptr : part; }
    template <bool SMP> DI RowCtx row_begin(int row, int fq) const { RowCtx r{0.f, 1.f}; if (!raw) { if (SMP) row_stats_s(part_s, row - TP, fq, r.mu, r.rstd); else row_stats(part, row, fq, r.mu, r.rstd); } return r; }
    DI ColCtx col_begin(int col) const { ColCtx c; c.a = *(const f32x4*)(g + col); c.b = *(const f32x4*)(b + col); return c; }
    DI f32x4 row_load8(int row, int col) const { const u32x4 w = *(const u32x4*)(YB + (size_t)row * 1024 + col); return __builtin_bit_cast(f32x4, w); }
    DI f32x4 row_load4(int row, int col) const { const u32x2 w = *(const u32x2*)(YB + (size_t)row * 1024 + col); return (f32x4){__uint_as_float(w.x), __uint_as_float(w.y), 0.f, 0.f}; }
    DI f32x4 compute(int, int, f32x4 a, const RowCtx& rc, const ColCtx& cc, float p0, float p1) const {
        const unsigned w0 = __float_as_uint(p0), w1 = __float_as_uint(p1);
        const f32x4 x = (f32x4){__uint_as_float(w0 << 16), __uint_as_float(w0 & 0xffff0000u), __uint_as_float(w1 << 16), __uint_as_float(w1 & 0xffff0000u)};
        const f32x4 r = raw ? x : ((x - rc.mu) * rc.rstd * cc.a + cc.b);
        return ALPHA * r + a;
    }
    DI void store8(int row, int col, f32x4 v0, f32x4 v1) const {
        if (!DRY) { st_bf8(YB + (size_t)row * 1024 + col, v0, v1); if (Y) { float* d = Y + (size_t)row * 1024 + col; *(f32x4*)d = v0; *(f32x4*)(d + 4) = v1; } }
    }
    DI void store4(int row, int col, f32x4 v) const {
        if (!DRY) { st_bf4(YB + (size_t)row * 1024 + col, v); if (Y) *(f32x4*)(Y + (size_t)row * 1024 + col) = v; }
    }
};
typedef FResT<false> FRes;

constexpr int STAT_TAB_OFF = 131072;
template <class F> struct EpiWrap {
    int l, which; LAS unsigned char* lds;
    DI void operator()(const f32x4 (&acc)[2][2][4][2], const pg8::Unit& u, int ui, int wr, int wc, int fr, int fq) const {
        const Params p = kparams();
        const F f = F::make(p, launder_i(l), which);
        const bool has_stats = f.stats_src() != nullptr;
        const LAS f32x2* tab = (const LAS f32x2*)(lds + STAT_TAB_OFF) + ui * 256 + wr * 64 + fr;
        const int rbase = u.pm * 256 + wr * 64 + fr, cbase = u.pn * 256 + wc * 32 + 8 * fq;
        ColCtx cc[2][2];
#pragma unroll
        for (int bj = 0; bj < 2; ++bj)
#pragma unroll
            for (int n = 0; n < 2; ++n) cc[bj][n] = f.col_begin(cbase + bj * 128 + 4 * n);
#pragma unroll
        for (int ai = 0; ai < 2; ++ai) {
            RowCtx rc[4]; float s[4], ss[4];
#pragma unroll
            for (int m = 0; m < 4; ++m) { const f32x2 t = has_stats ? tab[ai * 128 + m * 16] : (f32x2){0.f, 1.f}; rc[m].mu = t.x; rc[m].rstd = t.y; s[m] = 0.f; ss[m] = 0.f; }
#pragma unroll
            for (int bj = 0; bj < 2; ++bj) {
                const int col8 = cbase + bj * 128;
                f32x4 pre, nxt = f.row_load8(rbase + ai * 128, col8);
#pragma unroll
                for (int m = 0; m < 4; ++m) {
                    const int row = rbase + ai * 128 + m * 16;
                    pre = nxt;
                    if (F::PRELOAD && m < 3) nxt = f.row_load8(row + 16, col8);
                    const f32x4 y0 = f.compute(row, col8, acc[ai][bj][m][0], rc[m], cc[bj][0], pre.x, pre.y);
                    const f32x4 y1 = f.compute(row, col8 + 4, acc[ai][bj][m][1], rc[m], cc[bj][1], pre.z, pre.w);
                    if (F::STATS) { s[m] += ((y0.x + y0.y) + (y0.z + y0.w)) + ((y1.x + y1.y) + (y1.z + y1.w));
                        ss[m] += ((y0.x * y0.x + y0.y * y0.y) + (y0.z * y0.z + y0.w * y0.w)) + ((y1.x * y1.x + y1.y * y1.y) + (y1.z * y1.z + y1.w * y1.w)); }
                    f.store8(row, col8, y0, y1);
                }
            }
            if (F::STATS) {
#pragma unroll
                for (int m = 0; m < 4; ++m) {
                    float a = s[m], b = ss[m];
                    a += __shfl_xor(a, 16); a += __shfl_xor(a, 32); b += __shfl_xor(b, 16); b += __shfl_xor(b, 32);
                    if (fq == 0 && !f.is_dry()) *(f32x2*)(f.part_out + (size_t)(rbase + ai * 128 + m * 16) * 32 + (u.pn * 4 + wc) * 2) = (f32x2){a, b};
                }
            }
        }
    }
};

template <class F>
DI void sgemm_unit(LAS unsigned char* lds, const bf16_t* A, const bf16_t* Wt, int K, int col0, const F& f, int wid, int lane) {
    const int fr = lane & 15, fq = lane >> 4;
    const int kw = K >> 3;
    const bf16_t* ap = A + (size_t)fr * K + wid * kw + 8 * fq;
    const bf16_t* wp = Wt + (size_t)(col0 + fr) * K + wid * kw + 8 * fq;
    const int row = TP + wid * 16 + fr;
    const RowCtx rc = f.template row_begin<true>(row, fq);
    const ColCtx cc = f.col_begin(col0 + 4 * fq);
    const f32x4 pre = f.row_load4(row, col0 + 4 * fq);
    f32x4 acc[8];
#pragma unroll
    for (int i = 0; i < 8; ++i) acc[i] = (f32x4){0.f, 0.f, 0.f, 0.f};
#pragma unroll 2
    for (int k = 0; k < kw; k += 32) {
        const bf16x8 w = *(const bf16x8*)(wp + k);
#pragma unroll
        for (int mt = 0; mt < 8; ++mt) { const bf16x8 a = *(const bf16x8*)(ap + (size_t)mt * 16 * K + k); acc[mt] = mfma16(w, a, acc[mt]); }
    }
    LAS f32x4* red = (LAS f32x4*)lds;
#pragma unroll
    for (int mt = 0; mt < 8; ++mt) red[(wid * 8 + mt) * 64 + lane] = acc[mt];
    __syncthreads();
    f32x4 tot = (f32x4){0.f, 0.f, 0.f, 0.f};
#pragma unroll
    for (int s = 0; s < 8; ++s) tot += red[(s * 8 + wid) * 64 + lane];
    const f32x4 y = f.compute(row, col0 + 4 * fq, tot, rc, cc, pre.x, pre.y);
    f.store4(row, col0 + 4 * fq, y);
    if (F::STATS) {
        float s = (y.x + y.y) + (y.z + y.w), ss = (y.x * y.x + y.y * y.y) + (y.z * y.z + y.w * y.w);
        s += __shfl_xor(s, 16); s += __shfl_xor(s, 32); ss += __shfl_xor(ss, 16); ss += __shfl_xor(ss, 32);
        if (fq == 0 && !f.is_dry()) *(f32x2*)(f.part_out_s + (size_t)(row - TP) * 128 + (col0 >> 4) * 2) = (f32x2){s, ss};
    }
    __syncthreads();
}

DI void prep_deferred(const Params& p, int slot, LAS unsigned char* lds, int tid, int widx, int NW);
template <class F>
DI void gemm_all(LAS unsigned char* lds, const bf16_t* A, const bf16_t* Wt, int N, int K, int l, int which, int vb, int G, int tid) {
    int wid, lane; RELAUNDER();
    pg8::Gemm g{A, Wt, TP, N, K}; pg8::StaticOrder S; S.init(TP, N, G, vb);
    {
        const Params p = kparams();
        const F f = F::make(p, launder_i(l), which);
        const float* part = f.stats_src();
        if (part) {
            LAS f32x2* tab = (LAS f32x2*)(lds + STAT_TAB_OFF);
            const int r = tid >> 1, hlf = tid & 1;
            f32x4 v[4][4]; bool ok[4];
#pragma unroll
            for (int i = 0; i < 4; ++i) { pg8::Unit u; ok[i] = S.next(i, u); const int row = (ok[i] ? u.pm : 0) * 256 + r;
                const f32x4* pp = (const f32x4*)(part + (size_t)row * 32 + hlf * 16);
#pragma unroll
                for (int j = 0; j < 4; ++j) v[i][j] = pp[j]; }
#pragma unroll
            for (int i = 0; i < 4; ++i) {
                float s = 0.f, ss = 0.f;
#pragma unroll
                for (int j = 0; j < 4; ++j) { s += v[i][j].x + v[i][j].z; ss += v[i][j].y + v[i][j].w; }
                s += __shfl_xor(s, 1); ss += __shfl_xor(ss, 1);
                const float mu = s * (1.0f / 1024.0f), var = ss * (1.0f / 1024.0f) - mu * mu, rstd = rsqrtf(fmaxf(var, 0.f) + LN_EPS);
                if (hlf == 0) tab[i * 256 + r] = (f32x2){mu, rstd};
            }
        }
        __syncthreads();
    }
    const int nsu_ = N / 16;
    const bool s_first = false;
    if (F::STAGGER && (((vb >> 3) & 1) != 0) && (G & 15) == 0) {
        const Params p = kparams();
        prep_deferred(p, launder_i(l) + 1, lds, tid, ((vb >> 4) << 3) | (vb & 7), G >> 1);
        __syncthreads();
    }
    EpiWrap<F> E{l, which, lds};
    pg8::gemm_phase<EpiWrap<F>>(lds, g, S, E, tid);
    if (F::DEFERRED_PREP) {
        const int nwg = (TP / 256) * (N / 256), first = (nwg > G && nwg < 2 * G) ? (nwg - G) : 0;
        if (vb >= first) { const Params p = kparams(); prep_deferred(p, launder_i(l) + 3, lds, tid, vb - first, G - first); __syncthreads(); }
    }
    const int nsu = N / 16;
    const int su0 = G - 1 - vb;
    if (su0 < nsu && !s_first) {
        const Params p = kparams();
        const F f = F::make(p, launder_i(l), which);
        for (int su = su0; su < nsu; su += G) sgemm_unit<F>(lds, A + (size_t)TP * K, Wt, K, su * 16, f, wid, lane);
    }
}

DI void transpose_tile_load(const float* W, const float* gain, int N, int k0, int n0, int tid, f32x4 (&v)[8]) {
#pragma unroll
    for (int i = 0; i < 8; ++i) { const int e = tid + 512 * i, row = e >> 5, c4 = e & 31;
        f32x4 x = __builtin_nontemporal_load((const f32x4*)(W + (size_t)(k0 + row) * N + n0 + 4 * c4));
        if (gain) x = x * gain[k0 + row];
        v[i] = x; }
}
DI void transpose_tile_store(LAS float* T, bf16_t* WT, int K, int k0, int n0, int tid, const f32x4 (&v)[8]) {
#pragma unroll
    for (int i = 0; i < 8; ++i) { const int e = tid + 512 * i, row = e >> 5, c4 = e & 31; LAS float* d = T + row * 129 + 4 * c4; d[0] = v[i].x; d[1] = v[i].y; d[2] = v[i].z; d[3] = v[i].w; }
    __syncthreads();
#pragma unroll
    for (int i = 0; i < 4; ++i) { const int e = tid + 512 * i, n = e >> 4, c8 = e & 15; const LAS float* s = T + (8 * c8) * 129 + n;
        u32x4 o; o.x = pk2(s[0], s[129]); o.y = pk2(s[2 * 129], s[3 * 129]); o.z = pk2(s[4 * 129], s[5 * 129]); o.w = pk2(s[6 * 129], s[7 * 129]);
        *(u32x4*)(WT + (size_t)(n0 + n) * K + k0 + 8 * c8) = o; }
    __syncthreads();
}
struct TrJob { const float* W; const float* gain; bf16_t* WT; int K, N, k0, n0; };
DI TrJob tr_job(const Params& p, int which, int l, int item) {
    unsigned char* ws = p.ws; TrJob j;
    if (which == 0) { j.W = p.w_in + (size_t)l * 1024 * 1536; j.gain = l ? p.ln2_g : nullptr; j.WT = (bf16_t*)(ws + WS_WIN) + (size_t)l * 1536 * 1024; j.K = 1024; j.N = 1536; }
    else if (which == 1) { j.W = p.w_out + (size_t)l * 1024 * 1024; j.gain = nullptr; j.WT = (bf16_t*)(ws + WS_WOUT) + (size_t)l * 1024 * 1024; j.K = 1024; j.N = 1024; }
    else if (which == 2) { j.W = p.w_ff1 + (size_t)l * 1024 * 4096; j.gain = p.ln1_g + l * 1024; j.WT = (bf16_t*)(ws + WS_W1) + (size_t)l * 4096 * 1024; j.K = 1024; j.N = 4096; }
    else { j.W = p.w_ff2 + (size_t)l * 4096 * 1024; j.gain = nullptr; j.WT = (bf16_t*)(ws + WS_W2) + (size_t)l * 1024 * 4096; j.K = 4096; j.N = 1024; }
    const int nb = j.N / 128; j.k0 = (item / nb) * 128; j.n0 = (item % nb) * 128; return j;
}
DI TrJob tr_slot_job(const Params& p, int slot, int it) {
    if (slot == 0) { if (it < 96) return tr_job(p, 0, 0, it); return tr_job(p, 0, 1, it - 96); }
    if (slot <= 2) return tr_job(p, 3, slot - 1, it);
    if (it < 64) return tr_job(p, 1, slot - 3, it);
    return tr_job(p, 2, slot - 3, it - 64);
}
DI void transpose_slot(const Params& p, int slot, LAS unsigned char* lds, int tid, int widx, int NW) {
    const int nit = slot == 0 ? 192 : (slot <= 2 ? 256 : 320);
    LAS float* T = (LAS float*)lds;
    f32x4 v[8];
    int it = widx;
    if (it < nit) { const TrJob j = tr_slot_job(p, slot, it); transpose_tile_load(j.W, j.gain, j.N, j.k0, j.n0, tid, v); }
    for (; it < nit; it += NW) {
        const TrJob j = tr_slot_job(p, slot, it);
#pragma unroll
        for (int i = 0; i < 8; ++i) { const int e = tid + 512 * i, row = e >> 5, c4 = e & 31; LAS float* d = T + row * 129 + 4 * c4; d[0] = v[i].x; d[1] = v[i].y; d[2] = v[i].z; d[3] = v[i].w; }
        __syncthreads();
        if (it + NW < nit) { const TrJob jn = tr_slot_job(p, slot, it + NW); transpose_tile_load(jn.W, jn.gain, jn.N, jn.k0, jn.n0, tid, v); }
#pragma unroll
        for (int i = 0; i < 4; ++i) { const int e = tid + 512 * i, n = e >> 4, c8 = e & 15; const LAS float* s = T + (8 * c8) * 129 + n;
            u32x4 o; o.x = pk2(s[0], s[129]); o.y = pk2(s[2 * 129], s[3 * 129]); o.z = pk2(s[4 * 129], s[5 * 129]); o.w = pk2(s[6 * 129], s[7 * 129]);
            *(u32x4*)(j.WT + (size_t)(j.n0 + n) * j.K + j.k0 + 8 * c8) = o; }
        __syncthreads();
    }
}
DI void colsum_item(const float* W, const float* gain, const float* bias, int N, int c0, float* cs, float* bw, LAS float* red, int wid, int lane) {
    float s1 = 0.f, s2 = 0.f;
    const float* wp = W + (size_t)(wid * 128) * N + c0 + lane;
#pragma unroll 32
    for (int k = 0; k < 128; ++k) { const float w = wp[(size_t)k * N]; const int kk = wid * 128 + k; s1 += bfround(gain[kk] * w); s2 += bias[kk] * w; }
    red[wid * 128 + lane] = s1; red[wid * 128 + 64 + lane] = s2;
    __syncthreads();
    if (wid == 0) { float a = 0.f, b = 0.f;
#pragma unroll
        for (int w = 0; w < 8; ++w) { a += red[w * 128 + lane]; b += red[w * 128 + 64 + lane]; }
        cs[c0 + lane] = a; bw[c0 + lane] = b; }
    __syncthreads();
}
DI void prep_deferred(const Params& p, int slot, LAS unsigned char* lds, int tid, int widx, int NW) {
    tid = launder_v(tid);
    transpose_slot(p, slot, lds, tid, widx, NW);
}
DI void phase_prep(const Params& p, LAS unsigned char* lds, int tid, int wid, int lane, int vb, int G) {
    RELAUNDER();
    unsigned char* ws = p.ws;
    const int gw = vb * 8 + wid, NGW = G * 8;
    transpose_slot(p, 0, lds, tid, vb, G);
    bf16_t* YB = (bf16_t*)(ws + WS_YB);
    for (int m0 = gw; m0 < MT; m0 += 4 * NGW) {
        f32x4 v[4][4];
#pragma unroll
        for (int r = 0; r < 4; ++r) { const int m = m0 + r * NGW; const int mm = m < MT ? m : m0;
            const f32x4* src = (const f32x4*)(mm < TP ? p.xp + (size_t)mm * 1024 : p.xs + (size_t)(mm - TP) * 1024);
#pragma unroll
            for (int j = 0; j < 4; ++j) v[r][j] = __builtin_nontemporal_load(src + lane + 64 * j); }
#pragma unroll
        for (int r = 0; r < 4; ++r) { const int m = m0 + r * NGW;
            if (m < MT) {
#pragma unroll
                for (int j = 0; j < 4; ++j) st_bf4(YB + (size_t)m * 1024 + 4 * (lane + 64 * j), v[r][j]); } }
    }
#pragma unroll
    for (int which = 0; which < 3; ++which) {
        const float* src = which == 0 ? p.ga_w : (which == 1 ? p.gx_w : p.pool_w);
        bf16_t* dst = (bf16_t*)(ws + (which == 0 ? WS_GAT : (which == 1 ? WS_GXT : WS_PWT)));
        for (int r = vb * NTHR + tid; r < 32768; r += G * NTHR) {
            const int ln = r >> 12, d = (r >> 6) & 63, c = r & 63;
            dst[r] = (bf16_t)(pk2(src[(ln << 12) + c * 64 + d], 0.f) & 0xffffu);
        }
    }
    __syncthreads();
}

DI void attn_item(const Params& p, int layer, int item, LAS unsigned char* lds, int tid, int wid, int lane) {
    RELAUNDER();
    const int kvh = item & 1, qb = (item >> 1) & 31, b = item >> 6;
    const bf16_t* QKV = (const bf16_t*)(p.ws + WS_QKV); bf16_t* MIX = (bf16_t*)(p.ws + WS_MIX);
    LAS bf16_t* Ks = (LAS bf16_t*)lds;
    LAS bf16_t* Vt = (LAS bf16_t*)(lds + 36864);
    {
        const int key = tid >> 1, half = tid & 1; const int tok = qb * 128 - 128 + key;
        u32x4 kv[4], vv[4];
        if (tok >= 0) { const bf16_t* src = QKV + ((size_t)b * 4096 + tok) * 768 + 512 + kvh * 64 + half * 32;
#pragma unroll
            for (int i = 0; i < 4; ++i) { kv[i] = ((const u32x4*)src)[i]; vv[i] = ((const u32x4*)(src + 128))[i]; } }
        else {
#pragma unroll
            for (int i = 0; i < 4; ++i) { kv[i] = (u32x4){0u, 0u, 0u, 0u}; vv[i] = (u32x4){0u, 0u, 0u, 0u}; } }
#pragma unroll
        for (int i = 0; i < 4; ++i) *(LAS u32x4*)(Ks + key * 72 + half * 32 + 8 * i) = kv[i];
#pragma unroll
        for (int i = 0; i < 4; ++i)
#pragma unroll
            for (int e = 0; e < 8; ++e) { const int d = half * 32 + 8 * i + e; Vt[d * 264 + key] = (bf16_t)((vv[i][e >> 1] >> (16 * (e & 1))) & 0xffffu); }
    }
    __syncthreads();
    const int g = wid >> 1, qh = wid & 1, h = kvh * 4 + g, fr = lane & 15, fq = lane >> 4;
    const float slope2 = exp2f(-(float)(h + 1)) * LOG2E, sink2 = p.sinks[layer * 8 + h] * LOG2E;
    const size_t rowbase = (size_t)b * 4096 + qb * 128;
    bf16x8 qall[4][2];
#pragma unroll
    for (int qt = 0; qt < 4; ++qt) { const bf16_t* qp = QKV + (rowbase + qh * 64 + qt * 16 + fr) * 768 + h * 64 + 8 * fq; qall[qt][0] = *(const bf16x8*)qp; qall[qt][1] = *(const bf16x8*)(qp + 32); }
#pragma unroll
    for (int qt = 0; qt < 4; ++qt) {
        const int i0 = qh * 64 + qt * 16, jb = 32 * ((qh * 4 + qt) >> 1), iq = i0 + fr;
        const bf16x8 q0 = qall[qt][0], q1 = qall[qt][1];
        f32x4 s[10];
        float mx = sink2;
        const bool odd = (qt & 1) != 0;
        if (qb > 0) {
            const float t0 = -slope2 * (float)(iq + 128 - jb - 4 * fq);
            const float tb0 = t0, tb1 = t0 + slope2, tb2 = t0 + 2.0f * slope2, tb3 = t0 + 3.0f * slope2;
#pragma unroll
            for (int kt = 0; kt < 10; ++kt) {
                const bool dead = odd ? (kt == 0) : (kt == 9);
                if (dead) { s[kt] = (f32x4){0.f, 0.f, 0.f, 0.f}; continue; }
                const float c = slope2 * (float)(16 * kt);
                const LAS bf16_t* kp = Ks + (jb + 16 * kt + fr) * 72 + 8 * fq;
                const bf16x8 k0 = *(const LAS bf16x8*)kp, k1 = *(const LAS bf16x8*)(kp + 32);
                s[kt] = mfma16(k0, q0, (f32x4){tb0 + c, tb1 + c, tb2 + c, tb3 + c}); s[kt] = mfma16(k1, q1, s[kt]);
                const bool lo = odd ? (kt == 1) : (kt == 0), hi = odd ? (kt == 9) : (kt == 8);
#pragma unroll
                for (int i = 0; i < 4; ++i) {
                    if (lo) s[kt][i] = (4 * fq + i >= fr) ? s[kt][i] : -1e30f;
                    if (hi) s[kt][i] = (4 * fq + i <= fr) ? s[kt][i] : -1e30f;
                    mx = fmaxf(mx, s[kt][i]); }
            }
        } else {
#pragma unroll
            for (int kt = 0; kt < 10; ++kt) { const LAS bf16_t* kp = Ks + (jb + 16 * kt + fr) * 72 + 8 * fq;
                const bf16x8 k0 = *(const LAS bf16x8*)kp, k1 = *(const LAS bf16x8*)(kp + 32);
                s[kt] = mfma16(k0, q0, (f32x4){0.f, 0.f, 0.f, 0.f}); s[kt] = mfma16(k1, q1, s[kt]); }
#pragma unroll
            for (int kt = 0; kt < 10; ++kt)
#pragma unroll
                for (int i = 0; i < 4; ++i) { const int j = jb + 16 * kt + 4 * fq + i, delta = iq + 128 - j;
                    const bool valid = (delta >= 0) && (delta <= 128) && (j >= 128);
                    const float v = s[kt][i] - slope2 * (float)delta;
                    s[kt][i] = valid ? v : -1e30f; mx = fmaxf(mx, s[kt][i]); }
        }
        mx = fmaxf(mx, __shfl_xor(mx, 16)); mx = fmaxf(mx, __shfl_xor(mx, 32));
        float sum = 0.f;
#pragma unroll
        for (int kt = 0; kt < 10; ++kt) {
            if (qb > 0 && (odd ? (kt == 0) : (kt == 9))) continue;
#pragma unroll
            for (int i = 0; i < 4; ++i) { const float pv = __builtin_amdgcn_exp2f(s[kt][i] - mx); s[kt][i] = pv; sum += pv; }
        }
        sum += __shfl_xor(sum, 16); sum += __shfl_xor(sum, 32);
        const float inv = 1.0f / (sum + __builtin_amdgcn_exp2f(sink2 - mx));
        bf16x8 pf[5];
#pragma unroll
        for (int G = 0; G < 5; ++G) pf[G] = pack8(s[2 * G], s[2 * G + 1]);
#pragma unroll
        for (int dt = 0; dt < 4; ++dt) {
            f32x4 o = (f32x4){0.f, 0.f, 0.f, 0.f};
#pragma unroll
            for (int G = 0; G < 5; ++G) { const LAS bf16_t* vp = Vt + (16 * dt + fr) * 264 + jb + 32 * G + 4 * fq;
                const u32x2 lo = *(const LAS u32x2*)vp, hi = *(const LAS u32x2*)(vp + 16);
                const u32x4 w = (u32x4){lo.x, lo.y, hi.x, hi.y};
                o = mfma16(__builtin_bit_cast(bf16x8, w), pf[G], o); }
            st_bf4(MIX + (rowbase + iq) * 1024 + h * 64 + 16 * dt + 4 * fq, o * inv);
        }
    }
    __syncthreads();
}

DI void sattn_item(const Params& p, int layer, int j, LAS unsigned char* lds, int tid, int wid, int lane) {
    RELAUNDER();
    LAS float* Kc = (LAS float*)lds;
    LAS float* Vc = Kc + 129 * 132;
    LAS float* Ps = Vc + 129 * 132;
    LAS float* Qs = Ps + 8 * 132;
    const size_t cbase = ((size_t)(layer * 128 + j)) * 128 * 128;
    const f32x4* ck = (const f32x4*)(p.ck + cbase); const f32x4* cv = (const f32x4*)(p.cv + cbase);
    f32x4* sk = (f32x4*)(p.out + O_SK + cbase); f32x4* sv = (f32x4*)(p.out + O_SV + cbase);
    const bf16_t* QKV = (const bf16_t*)(p.ws + WS_QKV);
    const f32x4 newrow = (tid < 32) ? sk[127 * 32 + tid] : ((tid < 64) ? sv[127 * 32 + (tid - 32)] : (f32x4){0.f, 0.f, 0.f, 0.f});
    const bf16_t qraw = QKV[(size_t)(TP + j) * 768 + tid];
#pragma unroll
    for (int i = 0; i < 8; ++i) { const int idx = tid + 512 * i, s = idx >> 5, c4 = idx & 31;
        const f32x4 kv = __builtin_nontemporal_load(ck + idx), vv = __builtin_nontemporal_load(cv + idx);
        *(LAS f32x4*)(Kc + s * 132 + 4 * c4) = kv; *(LAS f32x4*)(Vc + s * 132 + 4 * c4) = vv;
        if (s >= 1) { __builtin_nontemporal_store(kv, sk + (idx - 32)); __builtin_nontemporal_store(vv, sv + (idx - 32)); } }
    if (tid < 32) *(LAS f32x4*)(Kc + 128 * 132 + 4 * tid) = newrow;
    else if (tid < 64) *(LAS f32x4*)(Vc + 128 * 132 + 4 * (tid - 32)) = newrow;
    Qs[tid] = bf2f(qraw);
    __syncthreads();
    const int h = wid, kvh = h >> 2;
    const float slope = exp2f(-(float)(h + 1)), sink2 = p.sinks[layer * 8 + h] * LOG2E;
    float sc[3];
#pragma unroll
    for (int r = 0; r < 3; ++r) {
        const int s = (r < 2) ? lane + 64 * r : 128;
        const LAS f32x4* kp = (const LAS f32x4*)(Kc + s * 132 + kvh * 64); const LAS f32x4* qp = (const LAS f32x4*)(Qs + h * 64);
        float d = 0.f;
#pragma unroll
        for (int i = 0; i < 16; ++i) { const f32x4 a = kp[i], q = qp[i]; d += (a.x * q.x + a.y * q.y) + (a.z * q.z + a.w * q.w); }
        const float delta = (float)(128 - s);
        sc[r] = d - slope * LOG2E * delta;
        if (r == 2 && lane != 0) sc[r] = -1e30f;
    }
    float mx = fmaxf(fmaxf(sc[0], sc[1]), fmaxf(sc[2], sink2));
#pragma unroll
    for (int o = 1; o < 64; o <<= 1) mx = fmaxf(mx, __shfl_xor(mx, o));
    float sum = 0.f;
#pragma unroll
    for (int r = 0; r < 3; ++r) { sc[r] = __builtin_amdgcn_exp2f(sc[r] - mx); sum += sc[r]; }
#pragma unroll
    for (int o = 1; o < 64; o <<= 1) sum += __shfl_xor(sum, o);
    const float inv = 1.0f / (sum + __builtin_amdgcn_exp2f(sink2 - mx));
    Ps[h * 132 + lane] = sc[0]; Ps[h * 132 + 64 + lane] = sc[1]; if (lane == 0) Ps[h * 132 + 128] = sc[2];
    lds_wait();
    float o = 0.f;
#pragma unroll 8
    for (int s = 0; s < 129; ++s) o += Ps[h * 132 + s] * Vc[s * 132 + kvh * 64 + lane];
    bf16_t* MIX = (bf16_t*)(p.ws + WS_MIX);
    MIX[(size_t)(TP + j) * 1024 + h * 64 + lane] = (bf16_t)(pk2(o * inv, 0.f) & 0xffffu);
    __syncthreads();
}

DI float fsigmoid(float x) { return __builtin_amdgcn_rcpf(1.0f + __builtin_amdgcn_exp2f(-LOG2E * x)); }
DI void rglru_item(const Params& p, int layer, int item, LAS unsigned char* lds, int tid, int wid, int lane) {
    RELAUNDER();
    LAS float* XC = (LAS float*)lds;
    const bf16_t* U2 = (const bf16_t*)(p.ws + WS_U2);
    const int ti = item >> 1, chalf = item & 1;
    const bool smp = (ti == 128);
    const int b = ti >> 5, ch = ti & 31;
    const int nl = wid >> 2, n = 2 * chalf + nl, fr = lane & 15, fq = lane >> 4;
    const int d = 16 * (wid & 3) + fr, cl = 64 * nl + d, c = 128 * chalf + cl;
    const bf16_t* GaT = (const bf16_t*)(p.ws + WS_GAT); const bf16_t* GxT = (const bf16_t*)(p.ws + WS_GXT);
    bf16x8 wa[2], wx[2];
#pragma unroll
    for (int ks = 0; ks < 2; ++ks) { const size_t o = ((size_t)((layer * 4 + n) * 64 + d)) * 64 + 32 * ks + 8 * fq; wa[ks] = *(const bf16x8*)(GaT + o); wx[ks] = *(const bf16x8*)(GxT + o); }
    const float ba = p.ga_b[layer * 256 + c], bx = p.gx_b[layer * 256 + c];
    const float spv = -8.0f * LOG2E * log1pf(__expf(-p.lam[layer * 256 + c]));
    {
        const int cq = tid & 31, tg = tid >> 5, cqg = chalf * 32 + cq;
        const f32x4 cb = ((const f32x4*)(p.conv_b + layer * 256))[cqg];
        f32x4 cw[4];
#pragma unroll
        for (int t = 0; t < 4; ++t) cw[t] = ((const f32x4*)(p.conv_w + (layer * 4 + t) * 256))[cqg];
        if (!smp) {
            f32x4 x[11];
#pragma unroll
            for (int k = 0; k < 11; ++k) { const int t = ch * 128 + 8 * tg - 3 + k;
                x[k] = (t >= 0) ? ld_bf4(U2 + ((size_t)b * 4096 + t) * 768 + 4 * cqg) : (f32x4){0.f, 0.f, 0.f, 0.f}; }
#pragma unroll
            for (int k = 0; k < 8; ++k) { const f32x4 xc = cb + cw[0] * x[k] + cw[1] * x[k + 1] + cw[2] * x[k + 2] + cw[3] * x[k + 3];
                *(LAS f32x4*)(XC + (8 * tg + k) * 132 + 4 * cq) = xc; }
            if (ch == 31 && tg == 15) { f32x4* pc = (f32x4*)(p.out + O_PC + (size_t)(layer * 4 + b) * 3 * 256);
                pc[0 * 64 + cqg] = x[8]; pc[1 * 64 + cqg] = x[9]; pc[2 * 64 + cqg] = x[10]; }
        } else {
#pragma unroll 4
            for (int k = 0; k < 8; ++k) { const int j = 8 * tg + k;
                const f32x4* scp = (const f32x4*)(p.sc + (size_t)(layer * 128 + j) * 3 * 256);
                const f32x4 s0 = scp[cqg], s1 = scp[64 + cqg], s2 = scp[128 + cqg], xr = ld_bf4(U2 + (size_t)(TP + j) * 768 + 4 * cqg);
                const f32x4 xc = cb + cw[0] * s0 + cw[1] * s1 + cw[2] * s2 + cw[3] * xr;
                *(LAS f32x4*)(XC + j * 132 + 4 * cq) = xc;
                f32x4* oc = (f32x4*)(p.out + O_SC + (size_t)(layer * 128 + j) * 3 * 256);
                oc[cqg] = s1; oc[64 + cqg] = s2; oc[128 + cqg] = xr; }
        }
    }
    __syncthreads();
    float Ac = 1.f, Bc = 0.f;
    unsigned* HC = (unsigned*)(p.ws + WS_HL);
    bf16_t* MIX = (bf16_t*)(p.ws + WS_MIX);
    float h0n[4] = {0.f, 0.f, 0.f, 0.f}, grn[4] = {0.f, 0.f, 0.f, 0.f};
    if (smp) {
#pragma unroll
        for (int i = 0; i < 4; ++i) { const int j = 4 * fq + i; h0n[i] = p.sh[(size_t)(layer * 128 + j) * 256 + c]; grn[i] = bf2f(U2[(size_t)(TP + j) * 768 + 256 + c]); }
    }
    for (int tt = 0; tt < 8; ++tt) {
        float h0c[4], grc[4];
#pragma unroll
        for (int i = 0; i < 4; ++i) { h0c[i] = h0n[i]; grc[i] = grn[i]; }
        if (smp && tt < 7) {
#pragma unroll
            for (int i = 0; i < 4; ++i) { const int j = 16 * (tt + 1) + 4 * fq + i; h0n[i] = p.sh[(size_t)(layer * 128 + j) * 256 + c]; grn[i] = bf2f(U2[(size_t)(TP + j) * 768 + 256 + c]); }
        }
        bf16x8 af[2];
#pragma unroll
        for (int ks = 0; ks < 2; ++ks) { const LAS f32x4* src = (const LAS f32x4*)(XC + (16 * tt + fr) * 132 + 64 * nl + 32 * ks + 8 * fq); af[ks] = pack8(src[0], src[1]); }
        f32x4 ar = (f32x4){0.f, 0.f, 0.f, 0.f}, ai = (f32x4){0.f, 0.f, 0.f, 0.f};
#pragma unroll
        for (int ks = 0; ks < 2; ++ks) { ar = mfma16(af[ks], wa[ks], ar); ai = mfma16(af[ks], wx[ks], ai); }
        float av[4], bv[4];
#pragma unroll
        for (int i = 0; i < 4; ++i) { const int t = 16 * tt + 4 * fq + i; const float xcv = XC[t * 132 + cl];
            const float r = fsigmoid(ar[i] + ba), ig = fsigmoid(ai[i] + bx);
            const float a = __builtin_amdgcn_exp2f(spv * r);
            av[i] = a; bv[i] = __builtin_amdgcn_sqrtf(fmaxf(1.0f - a * a, 0.f)) * (ig * xcv); }
        if (smp) {
#pragma unroll
            for (int i = 0; i < 4; ++i) { const int j = 16 * tt + 4 * fq + i;
                const float hv = av[i] * h0c[i] + bv[i];
                p.out[O_SH + (size_t)(layer * 128 + j) * 256 + c] = hv;
                MIX[(size_t)(TP + j) * 1024 + 512 + c] = (bf16_t)(pk2(hv * gelu_tanh(grc[i]), 0.f) & 0xffffu); }
        } else {
            float A4 = 1.f, B4 = 0.f;
#pragma unroll
            for (int i = 0; i < 4; ++i) { B4 = av[i] * B4 + bv[i]; A4 *= av[i]; }
            { const float A1 = __shfl_up(A4, 16), B1 = __shfl_up(B4, 16); if (fq >= 1) { B4 = A4 * B1 + B4; A4 = A4 * A1; } }
            { const float A2 = __shfl_up(A4, 32), B2 = __shfl_up(B4, 32); if (fq >= 2) { B4 = A4 * B2 + B4; A4 = A4 * A2; } }
            float Ae = __shfl_up(A4, 16), Be = __shfl_up(B4, 16); if (fq == 0) { Ae = 1.f; Be = 0.f; }
            const float At = __shfl(A4, 48 + fr), Bt = __shfl(B4, 48 + fr);
            float Ain = Ac * Ae, hin = Ae * Bc + Be;
#pragma unroll
            for (int i = 0; i < 4; ++i) { hin = av[i] * hin + bv[i]; Ain *= av[i];
                const size_t o = ((size_t)b * 4096 + ch * 128 + 16 * tt + 4 * fq + i) * 256 + c;
                HC[o] = pk2(hin, Ain); }
            Bc = At * Bc + Bt; Ac *= At;
        }
    }
    if (!smp && fq == 0) { ((float*)(p.ws + WS_AGA))[ti * 256 + c] = Ac; ((float*)(p.ws + WS_AGB))[ti * 256 + c] = Bc; }
    __syncthreads();
}

DI void rowsum_reduce(const u32x4 w0, const u32x4 w1, const f32x4 (&r4)[4], float& s, float& t) {
    s = 0.f; t = 0.f;
    const unsigned ww[8] = {w0.x, w0.y, w0.z, w0.w, w1.x, w1.y, w1.z, w1.w};
#pragma unroll
    for (int q = 0; q < 8; ++q) { const float lo = __uint_as_float(ww[q] << 16), hi = __uint_as_float(ww[q] & 0xffff0000u);
        s += lo + hi; t += lo * r4[q >> 1][(q & 1) * 2] + hi * r4[q >> 1][(q & 1) * 2 + 1]; }
#pragma unroll
    for (int o = 1; o < 64; o <<= 1) { s += __shfl_xor(s, o); t += __shfl_xor(t, o); }
}
DI void rowsum_rows(const bf16_t* WT, const float* gain, const float* bias, int nrows, float* cs, float* bw, int gw, int NGW, int lane) {
    f32x4 r4[4];
#pragma unroll
    for (int j = 0; j < 4; ++j) { const f32x4 g4 = ((const f32x4*)gain)[lane * 4 + j], b4 = ((const f32x4*)bias)[lane * 4 + j]; r4[j] = b4 / g4; }
    for (int n0 = gw; n0 < nrows; n0 += 2 * NGW) {
        const int n1 = n0 + NGW; const bool has1 = n1 < nrows;
        const u32x4* p0 = (const u32x4*)(WT + (size_t)n0 * 1024 + 16 * lane);
        const u32x4* p1 = (const u32x4*)(WT + (size_t)(has1 ? n1 : n0) * 1024 + 16 * lane);
        const u32x4 a0 = p0[0], a1 = p0[1], b0 = p1[0], b1 = p1[1];
        float s0, t0, s1, t1;
        rowsum_reduce(a0, a1, r4, s0, t0); rowsum_reduce(b0, b1, r4, s1, t1);
        if (lane == 0) { cs[n0] = s0; bw[n0] = t0; if (has1) { cs[n1] = s1; bw[n1] = t1; } }
    }
}

DI void fixup_item(const Params& p, int layer, int item, int tid) {
    tid = launder_v(tid);
    const int ti = item >> 2, qr = item & 3;
    const int b = ti >> 5, ch = ti & 31, c = tid & 255, half = tid >> 8;
    const float* AGA = (const float*)(p.ws + WS_AGA); const float* AGB = (const float*)(p.ws + WS_AGB);
    float carry = 0.f;
    {
        float ca[31], cb[31];
#pragma unroll
        for (int j = 0; j < 31; ++j) { const bool on = j < ch; ca[j] = on ? AGA[(b * 32 + j) * 256 + c] : 1.f; cb[j] = on ? AGB[(b * 32 + j) * 256 + c] : 0.f; }
#pragma unroll
        for (int j = 0; j < 31; ++j) carry = ca[j] * carry + cb[j];
    }
    const unsigned* HC = (const unsigned*)(p.ws + WS_HL); const bf16_t* U2 = (const bf16_t*)(p.ws + WS_U2);
    bf16_t* MIX = (bf16_t*)(p.ws + WS_MIX);
    const size_t row0 = (size_t)b * 4096 + ch * 128 + qr * 32 + half * 16;
    unsigned hc[16]; float grv[16];
#pragma unroll
    for (int k = 0; k < 16; ++k) { hc[k] = __builtin_nontemporal_load(HC + (row0 + k) * 256 + c); grv[k] = bf2f(__builtin_nontemporal_load(U2 + (row0 + k) * 768 + 256 + c)); }
    float h = 0.f;
#pragma unroll
    for (int k = 0; k < 16; ++k) { h = __uint_as_float(hc[k] << 16) + __uint_as_float(hc[k] & 0xffff0000u) * carry; MIX[(row0 + k) * 1024 + 512 + c] = (bf16_t)(pk2(h * gelu_tanh(grv[k]), 0.f) & 0xffffu); }
    if (ch == 31 && qr == 3 && half == 1) p.out[O_PH + (size_t)(layer * 4 + b) * 256 + c] = AGA[(b * 32 + 31) * 256 + c] * carry + AGB[(b * 32 + 31) * 256 + c];
}

DI void st_bf4_lds(LAS bf16_t* dst, f32x4 v) { u32x2 w; w.x = pk2(v.x, v.y); w.y = pk2(v.z, v.w); *(LAS u32x2*)dst = w; }
DI void pool_item(const Params& p, int layer, int ti, LAS unsigned char* lds, int tid, int wid, int lane) {
    RELAUNDER();
    LAS float* Zs = (LAS float*)lds;
    LAS bf16_t* Ds = (LAS bf16_t*)(lds + 48128);
    LAS bf16_t* Pw = (LAS bf16_t*)(lds + 115712);
    LAS float* Sc = (LAS float*)(lds + 152576);
    const bf16_t* U2 = (const bf16_t*)(p.ws + WS_U2);
    const bool smp = (ti >= 128);
    const int b = ti >> 5, ch = ti & 31;
    const int cq = tid & 63, gq = cq >> 4, tg = tid >> 6;
    const float wf = (float)(2 << gq);
    {
        const bf16_t* PwT = (const bf16_t*)(p.ws + WS_PWT) + (size_t)layer * 4 * 64 * 64;
#pragma unroll
        for (int i = 0; i < 4; ++i) { const int idx = tid + 512 * i, rowi = idx >> 3, c8 = idx & 7;
            *(LAS u32x4*)(Pw + rowi * 72 + 8 * c8) = *(const u32x4*)(PwT + (size_t)rowi * 64 + 8 * c8); }
        if (tid < 64) *(LAS f32x4*)(Sc + 4 * tid) = ((const f32x4*)(p.pool_scale + layer * 256))[tid];
    }
    if (!smp) {
        if (ch == 31) {
            for (int idx = tid; idx < 15 * 64; idx += NTHR) { const int r = idx >> 6, c4 = idx & 63;
                ((f32x4*)(p.out + O_PP + ((size_t)(layer * 4 + b) * 15 + r) * 256))[c4] = ld_bf4(U2 + ((size_t)b * 4096 + 4081 + r) * 768 + 512 + 4 * c4); }
        }
        f32x4 pf[6];
#pragma unroll
        for (int i = 0; i < 6; ++i) { const int e = tid + 512 * i, r = e >> 6, c4 = e & 63, t = ch * 128 - 15 + r;
            pf[i] = (e < 47 * 64 && t >= 0) ? ld_bf4(U2 + ((size_t)b * 4096 + t) * 768 + 512 + 4 * c4) : (f32x4){0.f, 0.f, 0.f, 0.f}; }
        for (int q = 0; q < 4; ++q) {
#pragma unroll
            for (int i = 0; i < 6; ++i) { const int e = tid + 512 * i; if (e < 47 * 64) *(LAS f32x4*)(Zs + 4 * e) = pf[i]; }
            __syncthreads();
            if (q < 3) {
#pragma unroll
                for (int i = 0; i < 6; ++i) { const int e = tid + 512 * i, r = e >> 6, c4 = e & 63, t = ch * 128 + 32 * (q + 1) - 15 + r;
                    pf[i] = (e < 47 * 64 && t >= 0) ? ld_bf4(U2 + ((size_t)b * 4096 + t) * 768 + 512 + 4 * c4) : (f32x4){0.f, 0.f, 0.f, 0.f}; }
            }
            f32x4 v[19], zs[4], res[4];
#pragma unroll
            for (int k = 0; k < 19; ++k) v[k] = *(const LAS f32x4*)(Zs + (4 * tg + k) * 256 + 4 * cq);
#pragma unroll
            for (int j = 0; j < 4; ++j) zs[j] = v[15 + j];
#pragma unroll
            for (int k = 18; k >= 1; --k) v[k] += v[k - 1];
#pragma unroll
            for (int j = 0; j < 4; ++j) res[j] = v[15 + j];
#pragma unroll
            for (int k = 18; k >= 3; --k) v[k] += v[k - 2];
#pragma unroll
            for (int j = 0; j < 4; ++j) res[j] = (gq >= 1) ? v[15 + j] : res[j];
#pragma unroll
            for (int k = 18; k >= 7; --k) v[k] += v[k - 4];
#pragma unroll
            for (int j = 0; j < 4; ++j) res[j] = (gq >= 2) ? v[15 + j] : res[j];
#pragma unroll
            for (int k = 18; k >= 15; --k) v[k] += v[k - 8];
#pragma unroll
            for (int j = 0; j < 4; ++j) res[j] = (gq >= 3) ? v[15 + j] : res[j];
#pragma unroll
            for (int j = 0; j < 4; ++j) { const int tl = 32 * q + 4 * tg + j; const float rc = __builtin_amdgcn_rcpf(fminf((float)(ch * 128 + tl + 1), wf));
                const f32x4 diff = res[j] * rc - zs[j];
                st_bf4_lds(Ds + tl * 264 + 4 * cq, diff); }
            __syncthreads();
        }
    } else {
        const int j0 = 32 * (ti - 128);
        const float rw = 1.0f / wf;
#pragma unroll 2
        for (int k = 0; k < 4; ++k) { const int jl = 4 * tg + k, j = j0 + jl;
            const f32x4* sp = (const f32x4*)(p.spool + (size_t)(layer * 128 + j) * 15 * 256);
            f32x4 st[15];
#pragma unroll
            for (int r = 0; r < 15; ++r) st[r] = sp[r * 64 + cq];
            const f32x4 z = ld_bf4(U2 + (size_t)(TP + j) * 768 + 512 + 4 * cq);
            const f32x4 s2 = z + st[14];
            const f32x4 s4 = s2 + (st[13] + st[12]);
            const f32x4 s8 = s4 + ((st[11] + st[10]) + (st[9] + st[8]));
            const f32x4 s16 = s8 + (((st[7] + st[6]) + (st[5] + st[4])) + ((st[3] + st[2]) + (st[1] + st[0])));
            const f32x4 rs = (gq == 0) ? s2 : ((gq == 1) ? s4 : ((gq == 2) ? s8 : s16));
            const f32x4 diff = rs * rw - z;
            st_bf4_lds(Ds + jl * 264 + 4 * cq, diff);
            f32x4* op = (f32x4*)(p.out + O_SP + (size_t)(layer * 128 + j) * 15 * 256);
#pragma unroll
            for (int r = 0; r < 14; ++r) op[r * 64 + cq] = st[r + 1];
            op[14 * 64 + cq] = z; }
        __syncthreads();
    }
    const int fr = lane & 15, fq = lane >> 4;
    bf16_t* MIX = (bf16_t*)(p.ws + WS_MIX);
    if (!smp || wid < 2) {
        const size_t row = smp ? (size_t)(TP + 32 * (ti - 128) + 16 * wid + fr) : ((size_t)b * 4096 + ch * 128 + 16 * wid + fr);
#pragma unroll
        for (int g = 0; g < 4; ++g) {
            bf16x8 bfr[2];
#pragma unroll
            for (int ks = 0; ks < 2; ++ks) bfr[ks] = *(const LAS bf16x8*)(Ds + (16 * wid + fr) * 264 + 64 * g + 32 * ks + 8 * fq);
#pragma unroll
            for (int dt = 0; dt < 4; ++dt) {
                f32x4 o = (f32x4){0.f, 0.f, 0.f, 0.f};
#pragma unroll
                for (int ks = 0; ks < 2; ++ks) { const bf16x8 a = *(const LAS bf16x8*)(Pw + (g * 64 + 16 * dt + fr) * 72 + 32 * ks + 8 * fq); o = mfma16(a, bfr[ks], o); }
                const int c = 64 * g + 16 * dt + 4 * fq;
                const f32x4 sc4 = *(const LAS f32x4*)(Sc + c);
                st_bf4(MIX + row * 1024 + 768 + c, o * sc4);
            }
        }
    }
    __syncthreads();
}

DI void final_ln(const Params& p, int vb, int G, int tid) {
    int wid, lane; RELAUNDER();
    const float* part = (const float*)(p.ws + WS_ST2); const float* part_s = (const float*)(p.ws + WS_STS2);
    const bf16_t* YB = (const bf16_t*)(p.ws + WS_YB);
    const f32x4* g = (const f32x4*)(p.ln2_g + 1024); const f32x4* bb = (const f32x4*)(p.ln2_b + 1024);
    f32x4 g4[4], b4[4];
#pragma unroll
    for (int j = 0; j < 4; ++j) { g4[j] = g[lane + 64 * j]; b4[j] = bb[lane + 64 * j]; }
    const int gw = vb * 8 + wid, NGW = G * 8;
    for (int row0 = gw; row0 < MT; row0 += 4 * NGW) {
        f32x4 y[4][4]; float mu[4], rs[4];
#pragma unroll
        for (int r = 0; r < 4; ++r) { const int row = (row0 + r * NGW < MT) ? row0 + r * NGW : row0;
#pragma unroll
            for (int j = 0; j < 4; ++j) y[r][j] = ld_bf4_nt(YB + (size_t)row * 1024 + 4 * (lane + 64 * j));
            row_stats_any(part, part_s, row, lane >> 4, mu[r], rs[r]); }
#pragma unroll
        for (int r = 0; r < 4; ++r) { const int row = row0 + r * NGW;
            if (row < MT) { f32x4* op = (f32x4*)(p.out + (size_t)row * 1024);
#pragma unroll
                for (int j = 0; j < 4; ++j) __builtin_nontemporal_store((y[r][j] - mu[r]) * rs[r] * g4[j] + b4[j], op + lane + 64 * j); } }
    }
}

#define XB_TMO      128
#define XB_XCNT(j)  (256  + 64 * (j))
#define XB_XSUB(j)  (1280 + 64 * (j))
#define XB_XGEN(j)  (2304 + 64 * (j))
#define XB_TOP      3328
#define XB_TOPGEN   3392
#define XCD_BAR_WORDS 3456
#define XB_SPIN_CAP (1u << 22)
DI unsigned xb_ld(unsigned* p)              { return __hip_atomic_load(p, __ATOMIC_RELAXED, __HIP_MEMORY_SCOPE_AGENT); }
DI unsigned xb_add(unsigned* p, unsigned v) { return __hip_atomic_fetch_add(p, v, __ATOMIC_RELAXED, __HIP_MEMORY_SCOPE_AGENT); }
DI unsigned xb_xcc_id() { return (unsigned)__builtin_amdgcn_s_getreg((3 << 11) | 20) & 0xFu; }
#define XB_SPIN(cond, bar) do { unsigned _sp = 0; while (cond) { __builtin_amdgcn_s_sleep(1); \
    if ((++_sp & 255u) == 0u) { if (xb_ld(&(bar)[XB_TMO])) break; if (_sp > XB_SPIN_CAP) { atomicAdd(&(bar)[XB_TMO], 1u); break; } } } } while (0)
DI void xcd_barrier_complete(unsigned* bar, unsigned x, unsigned& nloc, unsigned& nx) {
    const unsigned G = gridDim.x;
    unsigned sum, cnt, mine, sp = 0u;
    for (;;) {
        sum = 0u; cnt = 0u; mine = 0u;
#pragma unroll
        for (unsigned j = 0; j < 16; ++j) { const unsigned c = xb_ld(&bar[XB_XCNT(j)]); sum += c; cnt += (c > 0u) ? 1u : 0u; mine = (j == x) ? c : mine; }
        if (sum == G) break;
        __builtin_amdgcn_s_sleep(1);
        if ((++sp & 255u) == 0u) { if (xb_ld(&bar[XB_TMO])) break; if (sp > XB_SPIN_CAP) { atomicAdd(&bar[XB_TMO], 1u); break; } }
    }
    nloc = mine > 0u ? mine : 1u; nx = cnt > 0u ? cnt : 1u;
}
DI void xcd_barrier(unsigned* bar, volatile LAS unsigned* st) {
    asm volatile("s_waitcnt vmcnt(0)" ::: "memory");
    __syncthreads();
    if (threadIdx.x == 0) {
        const unsigned x = xb_xcc_id();
        __builtin_amdgcn_s_waitcnt(0);
        unsigned nloc = st[0], nx = st[1];
        if (nloc == 0u) { xcd_barrier_complete(bar, x, nloc, nx); st[0] = nloc; st[1] = nx; }
        const unsigned old = xb_add(&bar[XB_XSUB(x)], 1u);
        const unsigned gen = old / nloc;
        if (old + 1u == (gen + 1u) * nloc) {
            __builtin_amdgcn_fence(__ATOMIC_RELEASE, "agent");
            asm volatile("s_waitcnt vmcnt(0)" ::: "memory");
            const unsigned og = xb_add(&bar[XB_TOP], 1u);
            const unsigned tg = og / nx;
            if (og + 1u == (tg + 1u) * nx) xb_add(&bar[XB_TOPGEN], 1u);
            else XB_SPIN(xb_ld(&bar[XB_TOPGEN]) == tg, bar);
            __builtin_amdgcn_fence(__ATOMIC_ACQUIRE, "agent");
            xb_add(&bar[XB_XGEN(x)], 1u);
            asm volatile("s_waitcnt vmcnt(0)" ::: "memory");
        } else {
            XB_SPIN(xb_ld(&bar[XB_XGEN(x)]) == gen, bar);
            __builtin_amdgcn_fence(__ATOMIC_ACQUIRE, "agent");
            asm volatile("s_waitcnt vmcnt(0)" ::: "memory");
        }
    }
    __syncthreads();
}

DI int launder_i_unused(int x) { asm volatile("" : "+s"(x)); return x; }

__global__ void __launch_bounds__(NTHR, 2) hybrid_fwd(Params p_unused) {
    extern __shared__ __attribute__((aligned(16))) unsigned char smem[];
    LAS unsigned char* lds = (LAS unsigned char*)smem;
    cg::grid_group grid = cg::this_grid();
    const int tid = threadIdx.x, wid = __builtin_amdgcn_readfirstlane(tid >> 6), lane = tid & 63;
    const int vb = blockIdx.x, G = gridDim.x;
    volatile LAS unsigned* xst = (volatile LAS unsigned*)(lds + LDS_BYTES - 16);
    { unsigned* bar0 = (unsigned*)(kparams().ws + WS_BAR); if (tid == 0) { xst[0] = 0u; xst[1] = 0u; (void)xb_add(&bar0[XB_XCNT(xb_xcc_id())], 1u); } }
    __syncthreads();

#if !(PHOFF & 1)
    for (int rep = 0; rep < REP_PREP; ++rep) { const Params p = kparams(); phase_prep(p, lds, tid, wid, lane, vb, G); }
#endif
    if (kparams().out == nullptr) grid.sync();
    GSYNC();

#pragma nounroll
    for (int l0 = 0; l0 < 2; ++l0) {
#if !(PHOFF & 2)
        for (int rep = 0; rep < REP_G1; ++rep) {
            const Params p = kparams(); const int l = launder_i(l0); unsigned char* ws = p.ws;
            gemm_all<FIn>(lds, (const bf16_t*)(ws + WS_YB), (const bf16_t*)(ws + WS_WIN) + (size_t)l * 1536 * 1024, NIN, 1024, l, 0, vb, G, tid);
        }
#endif
        GSYNC();
        for (int rep = 0; rep < REP_MIX; ++rep) {
            const int l = launder_i(l0);
            unsigned* qctr = (unsigned*)(kparams().ws + WS_QCTR) + 64 * l;
            int it = vb;
            for (;;) {
                if (it >= 774) break;
#if !(PHOFF & 4)
                if (it < 256) for (int r2 = 0; r2 < REP_ATT; ++r2) { const Params p = kparams(); attn_item(p, l, it, lds, tid, wid, lane); }
#endif
#if !(PHOFF & 8)
                if (it >= 256 && it < 514) for (int r2 = 0; r2 < REP_RG; ++r2) { const Params p = kparams(); rglru_item(p, l, (it < 258) ? (it) : (it - 258), lds, tid, wid, lane); }
#endif
#if !(PHOFF & 16)
                if (it >= 514 && it < 646) for (int r2 = 0; r2 < REP_POOL; ++r2) { const Params p = kparams(); pool_item(p, l, it - 514, lds, tid, wid, lane); }
#endif
#if !(PHOFF & 32)
                if (it >= 646) for (int r2 = 0; r2 < REP_SATT; ++r2) { const Params p = kparams(); sattn_item(p, l, it - 646, lds, tid, wid, lane); }
#endif
                if (tid == 0) xst[2] = G + xb_add(qctr, 1u);
                __syncthreads();
                it = __builtin_amdgcn_readfirstlane((int)xst[2]);
                __syncthreads();
            }
        }
        GSYNC();
#if !(PHOFF & 64)
        for (int rep = 0; rep < REP_FIX; ++rep) { const Params p = kparams(); const int l = launder_i(l0); for (int it = vb; it < 512; it += G) fixup_item(p, l, it, tid); }
#endif
        {
            const Params p = kparams(); const int l = launder_i(l0); unsigned char* ws = p.ws;
            const int tid2 = launder_v(tid), lane2 = tid2 & 63, gw = vb * 8 + (tid2 >> 6), NGW = G * 8;
            rowsum_rows((const bf16_t*)(ws + WS_W1) + (size_t)l * 4096 * 1024, p.ln1_g + l * 1024, p.ln1_b + l * 1024, 4096, (float*)(ws + WS_CS1) + l * 4096, (float*)(ws + WS_BW1) + l * 4096, gw, NGW, lane2);
            if (l == 0) rowsum_rows((const bf16_t*)(ws + WS_WIN) + (size_t)1536 * 1024, p.ln2_g, p.ln2_b, 1536, (float*)(ws + WS_CSIN) + 1536, (float*)(ws + WS_BWIN) + 1536, gw, NGW, lane2);
        }
        GSYNC();
#if !(PHOFF & 128)
        for (int rep = 0; rep < REP_G2; ++rep) {
            const Params p = kparams(); const int l = launder_i(l0); unsigned char* ws = p.ws;
#if REP_G2 > 1
            if (rep < REP_G2 - 1) gemm_all<FResT<true>>(lds, (const bf16_t*)(ws + WS_MIX), (const bf16_t*)(ws + WS_WOUT) + (size_t)l * 1024 * 1024, 1024, 1024, l, 0, vb, G, tid); else
#endif
            gemm_all<FRes>(lds, (const bf16_t*)(ws + WS_MIX), (const bf16_t*)(ws + WS_WOUT) + (size_t)l * 1024 * 1024, 1024, 1024, l, 0, vb, G, tid);
        }
#endif
        GSYNC();
#if !(PHOFF & 256)
        for (int rep = 0; rep < REP_G3; ++rep) {
            const Params p = kparams(); const int l = launder_i(l0); unsigned char* ws = p.ws;
            gemm_all<FFF1>(lds, (const bf16_t*)(ws + WS_YB), (const bf16_t*)(ws + WS_W1) + (size_t)l * 4096 * 1024, DFF, 1024, l, 0, vb, G, tid);
        }
#endif
        GSYNC();
#if !(PHOFF & 512)
        for (int rep = 0; rep < REP_G4; ++rep) {
            const Params p = kparams(); const int l = launder_i(l0); unsigned char* ws = p.ws;
#if REP_G4 > 1
            if (rep < REP_G4 - 1) gemm_all<FResT<true>>(lds, (const bf16_t*)(ws + WS_HID), (const bf16_t*)(ws + WS_W2) + (size_t)l * 1024 * 4096, 1024, 4096, l, 1, vb, G, tid); else
#endif
            gemm_all<FRes>(lds, (const bf16_t*)(ws + WS_HID), (const bf16_t*)(ws + WS_W2) + (size_t)l * 1024 * 4096, 1024, 4096, l, 1, vb, G, tid);
        }
#endif
        GSYNC();
    }
    { const Params p = kparams(); final_ln(p, vb, G, tid); }
}

extern "C" void kernel_launch(void* const* d_in, const int* in_sizes, int n_in, void* d_out, int out_size, void* d_ws, size_t ws_size, hipStream_t stream) {
    static int grid_blocks = 0;
    if (!grid_blocks) {
        int dev = 0, cus = 0, per_cu = 0;
        hipGetDevice(&dev);
        hipDeviceGetAttribute(&cus, hipDeviceAttributeMultiprocessorCount, dev);
        hipFuncSetAttribute((const void*)hybrid_fwd, hipFuncAttributeMaxDynamicSharedMemorySize, LDS_BYTES);
        hipOccupancyMaxActiveBlocksPerMultiprocessor(&per_cu, (const void*)hybrid_fwd, NTHR, LDS_BYTES);
        if (per_cu < 1) per_cu = 1;
        grid_blocks = cus * per_cu;
        if (ws_size < WS_END) fprintf(stderr, "kernel_launch: workspace too small: %zu < %zu\n", ws_size, (size_t)WS_END);
        fprintf(stderr, "kernel_launch: grid %d (cus %d x %d)\n", grid_blocks, cus, per_cu);
    }
    if (hipMemsetAsync((char*)d_ws + WS_BAR, 0, XCD_BAR_WORDS * 4 + 1024, stream) != hipSuccess) fprintf(stderr, "memset failed\n");
    Params p{};
    const float** pp = (const float**)&p;
    for (int i = 0; i < 25; ++i) pp[i] = (const float*)d_in[i];
    p.out = (float*)d_out; p.ws = (unsigned char*)d_ws;
    void* args[] = {&p};
    hipError_t e = hipLaunchCooperativeKernel((const void*)hybrid_fwd, dim3(grid_blocks), dim3(NTHR), args, LDS_BYTES, stream);
    if (e != hipSuccess) fprintf(stderr, "cooperative launch failed: %s (grid %d)\n", hipGetErrorString(e), grid_blocks);
}
```
